# Optimizing an MI355X kernel written in HIP

```python
import numpy as np
import jax
import jax.numpy as jnp
from jax import lax

D_MODEL = 1024
BATCH = 8
SEQ = 2048
DEPTH = 2

HEAD_DIM = 64
N_HEADS_MIX = 4
MIX_WIDTH = N_HEADS_MIX * HEAD_DIM
N_BRANCH = 4
ROPE_THETA = 10000.0
NORM_EPS = 1e-6
Q_BLOCK = 128
GATHER_QBLOCK = 64
NEG_INF = -1e30

NSA_CMP_LEN = 32
NSA_CMP_STRIDE = 16
NSA_CMP_HIDDEN = 256
NSA_SEL_BLOCK = 64
NSA_N_SEL = 16
NSA_WINDOW = 512
NSA_N_GATES = 3
NSA_FORCE_SCORE = 1e4

FOX_BIAS_INIT = 3.0

DSA_KV_RANK = 128
DSA_IDX_HEADS = 4
DSA_IDX_DIM = 64
DSA_TOPK_MAX = 256

SWA_WINDOW = 128
SWA_KV_HEADS = 2

MOE_GROUPS = 8
MOE_EXPERTS_PER_GROUP = 8
MOE_N_EXPERTS = MOE_GROUPS * MOE_EXPERTS_PER_GROUP
MOE_TOPK = 2
MOE_D_EXPERT = 256
MOE_ROW_BLOCK = 256

IN_SPLITS = (
    ('q_a', MIX_WIDTH), ('k_cmp', HEAD_DIM), ('v_cmp', HEAD_DIM),
    ('k_sel', HEAD_DIM), ('v_sel', HEAD_DIM), ('k_win', HEAD_DIM), ('v_win', HEAD_DIM),
    ('g_a', N_HEADS_MIX * NSA_N_GATES),
    ('q_b', MIX_WIDTH), ('k_b', MIX_WIDTH), ('v_b', MIX_WIDTH), ('f_b', N_HEADS_MIX),
    ('q_c', MIX_WIDTH), ('ckv_c', DSA_KV_RANK), ('qi_c', DSA_IDX_HEADS * DSA_IDX_DIM),
    ('ki_c', DSA_IDX_DIM), ('wi_c', DSA_IDX_HEADS),
    ('q_d', MIX_WIDTH), ('k_d', SWA_KV_HEADS * HEAD_DIM), ('v_d', SWA_KV_HEADS * HEAD_DIM),
)
D_IN = sum(w for _, w in IN_SPLITS)

kernel_name = 'hybrid_nsa_fox_dsa_swa_hmoe'


def rms_norm(x, gain):
    xf = x.astype(jnp.float32)
    y = xf * lax.rsqrt(jnp.mean(xf * xf, axis=-1, keepdims=True) + NORM_EPS)
    return (y * gain.astype(jnp.float32)).astype(x.dtype)


def rope(x, positions):
    half = x.shape[-1] // 2
    inv_freq = ROPE_THETA ** (-jnp.arange(half, dtype=jnp.float32) / half)
    ang = positions.astype(jnp.float32)[..., None] * inv_freq
    cos = jnp.cos(ang)[:, :, None, :]
    sin = jnp.sin(ang)[:, :, None, :]
    xf = x.astype(jnp.float32)
    x1, x2 = xf[..., :half], xf[..., half:]
    return jnp.concatenate([x1 * cos - x2 * sin, x2 * cos + x1 * sin], axis=-1).astype(x.dtype)


def masked_softmax(logits, mask):
    p = jax.nn.softmax(jnp.where(mask, logits, NEG_INF), axis=-1)
    return jnp.where(mask, p, 0.0)


def split_in(z):
    out = {}
    off = 0
    for name, width in IN_SPLITS:
        out[name] = z[..., off:off + width]
        off += width
    return out


def banded_attention(q, k, v, window, sinks=None):
    B, S, H, dh = q.shape
    KV = k.shape[2]
    G = H // KV
    nb, nw = S // Q_BLOCK, window // Q_BLOCK
    pad = ((0, 0), (window, 0), (0, 0), (0, 0))
    kp = jnp.pad(k, pad).reshape(B, nb + nw, Q_BLOCK, KV, dh)
    vp = jnp.pad(v, pad).reshape(B, nb + nw, Q_BLOCK, KV, dh)
    k_band = jnp.concatenate([kp[:, j:j + nb] for j in range(nw + 1)], axis=2)
    v_band = jnp.concatenate([vp[:, j:j + nb] for j in range(nw + 1)], axis=2)
    s_all = np.arange(-window, S).reshape(nb + nw, Q_BLOCK)
    s_band = np.concatenate([s_all[j:j + nb] for j in range(nw + 1)], axis=1)
    t_blk = np.arange(S).reshape(nb, Q_BLOCK)
    rel = t_blk[:, :, None] - s_band[:, None, :]
    mask = (rel >= 0) & (rel < window) & (s_band[:, None, :] >= 0)
    qb = q.reshape(B, nb, Q_BLOCK, KV, G, dh)
    s = jnp.einsum('bnqhgd,bnshd->bnhgqs', qb, k_band).astype(jnp.float32) * dh ** -0.5
    s = jnp.where(mask[None, :, None, None], s, NEG_INF)
    if sinks is not None:
        sink = jnp.broadcast_to(sinks.astype(jnp.float32).reshape(1, 1, KV, G, 1, 1), s.shape[:-1] + (1,))
        p = jax.nn.softmax(jnp.concatenate([s, sink], axis=-1), axis=-1)[..., :-1]
    else:
        p = jax.nn.softmax(s, axis=-1)
    o = jnp.einsum('bnhgqs,bnshd->bnqhgd', p.astype(v.dtype), v_band)
    return o.reshape(B, S, H, dh)


def nsa_compress(blocks, pe, w1, w2):
    B, n, L, dh = blocks.shape
    z = (blocks + pe).reshape(B, n, L * dh)
    return jax.nn.gelu(z @ w1) @ w2


def nsa_mixer(q, k_cmp, v_cmp, k_sel, v_sel, k_win, v_win, gate_logits, pe_k, w1_k, w2_k, pe_v, w1_v, w2_v):
    B, S, H, dh = q.shape
    scale = dh ** -0.5
    t = np.arange(S)
    n_cmp = (S - NSA_CMP_LEN) // NSA_CMP_STRIDE + 1
    win = np.arange(n_cmp)[:, None] * NSA_CMP_STRIDE + np.arange(NSA_CMP_LEN)[None, :]
    kc = nsa_compress(k_cmp[:, win], pe_k, w1_k, w2_k)
    vc = nsa_compress(v_cmp[:, win], pe_v, w1_v, w2_v)
    mask_c = win[:, -1][None, :] <= t[:, None]
    s_c = jnp.einsum('bthd,bcd->bhtc', q, kc).astype(jnp.float32) * scale
    p_c = masked_softmax(s_c, mask_c)
    o_cmp = jnp.einsum('bhtc,bcd->bthd', p_c.astype(vc.dtype), vc)
    n_blk = S // NSA_SEL_BLOCK
    c0 = np.arange(n_cmp) * NSA_CMP_STRIDE
    b0 = np.arange(n_blk) * NSA_SEL_BLOCK
    overlap = ((c0[:, None] < b0[None, :] + NSA_SEL_BLOCK) & (c0[:, None] + NSA_CMP_LEN > b0[None, :])).astype(np.float32)
    imp = jnp.einsum('bhtc,cj->btj', p_c, jnp.asarray(overlap))
    cur = (t // NSA_SEL_BLOCK)[:, None]
    j = np.arange(n_blk)[None, :]
    forced = (j == 0) | (j == cur) | (j == cur - 1)
    imp = jnp.where(forced, NSA_FORCE_SCORE, imp)
    imp = jnp.where(j > cur, -NSA_FORCE_SCORE, imp)
    n_sel = min(NSA_N_SEL, n_blk)
    _, sel = lax.top_k(imp, n_sel)
    kb = k_sel.reshape(B, n_blk, NSA_SEL_BLOCK, dh)
    vb = v_sel.reshape(B, n_blk, NSA_SEL_BLOCK, dh)
    ng = S // GATHER_QBLOCK
    q_g = q.reshape(B, ng, GATHER_QBLOCK, H, dh).swapaxes(0, 1)
    sel_g = sel.reshape(B, ng, GATHER_QBLOCK, n_sel).swapaxes(0, 1)
    t_g = jnp.arange(S).reshape(ng, GATHER_QBLOCK)
    offs = jnp.arange(NSA_SEL_BLOCK)
    take = jax.vmap(lambda tbl, idx: tbl[idx])
    n_keys = n_sel * NSA_SEL_BLOCK

    def sel_block(args):
        q_i, idx_i, t_i = args
        k_i = take(kb, idx_i).reshape(B, GATHER_QBLOCK, n_keys, dh)
        v_i = take(vb, idx_i).reshape(B, GATHER_QBLOCK, n_keys, dh)
        pos = (idx_i[..., None] * NSA_SEL_BLOCK + offs).reshape(B, GATHER_QBLOCK, n_keys)
        valid = pos <= t_i[None, :, None]
        s = jnp.einsum('bqhd,bqkd->bhqk', q_i, k_i).astype(jnp.float32) * scale
        p = masked_softmax(s, valid[:, None])
        return jnp.einsum('bhqk,bqkd->bqhd', p.astype(v_i.dtype), v_i)

    o_sel = lax.map(sel_block, (q_g, sel_g, t_g)).swapaxes(0, 1).reshape(B, S, H, dh)
    o_win = banded_attention(q, k_win[:, :, None, :], v_win[:, :, None, :], NSA_WINDOW)
    g = jax.nn.sigmoid(gate_logits.astype(jnp.float32)).astype(q.dtype)
    return g[..., 0:1] * o_cmp + g[..., 1:2] * o_sel + g[..., 2:3] * o_win


def fox_mixer(q, k, v, f_logit, f_bias):
    B, S, H, dh = q.shape
    scale = dh ** -0.5
    logf = jax.nn.log_sigmoid(f_logit.astype(jnp.float32) + f_bias.astype(jnp.float32))
    cum = jnp.cumsum(logf, axis=1).swapaxes(1, 2)
    nb = S // Q_BLOCK
    q_b = q.reshape(B, nb, Q_BLOCK, H, dh).swapaxes(0, 1)
    c_b = cum.reshape(B, H, nb, Q_BLOCK).transpose(2, 0, 1, 3)
    t_b = jnp.arange(S).reshape(nb, Q_BLOCK)
    key_pos = jnp.arange(S)

    def blk(args):
        q_i, c_i, t_i = args
        s = jnp.einsum('bqhd,bshd->bhqs', q_i, k).astype(jnp.float32) * scale
        s = s + (c_i[..., None] - cum[:, :, None, :])
        p = masked_softmax(s, key_pos[None, :] <= t_i[:, None])
        return jnp.einsum('bhqs,bshd->bqhd', p.astype(v.dtype), v)

    return lax.map(blk, (q_b, c_b, t_b)).swapaxes(0, 1).reshape(B, S, H, dh)


def dsa_mixer(q, k, v, q_idx, k_idx, w_idx):
    B, S, H, dh = q.shape
    n_ih, d_i = q_idx.shape[2], q_idx.shape[3]
    scale = dh ** -0.5
    top_k = min(DSA_TOPK_MAX, S // 4)
    ng = S // GATHER_QBLOCK
    w = w_idx.astype(jnp.float32) * n_ih ** -0.5
    q_g = q.reshape(B, ng, GATHER_QBLOCK, H, dh).swapaxes(0, 1)
    qi_g = q_idx.reshape(B, ng, GATHER_QBLOCK, n_ih, d_i).swapaxes(0, 1)
    w_g = w.reshape(B, ng, GATHER_QBLOCK, n_ih).swapaxes(0, 1)
    t_g = jnp.arange(S).reshape(ng, GATHER_QBLOCK)
    key_pos = jnp.arange(S)
    take = jax.vmap(lambda tbl, idx: tbl[idx])

    def blk(args):
        q_i, qi_i, w_i, t_i = args
        logit = jnp.einsum('bqhd,bsd->bqhs', qi_i, k_idx).astype(jnp.float32) * d_i ** -0.5
        score = jnp.einsum('bqh,bqhs->bqs', w_i, jax.nn.relu(logit))
        score = jnp.where(key_pos[None, None, :] <= t_i[None, :, None], score, NEG_INF)
        _, idx = lax.top_k(score, top_k)
        valid = idx <= t_i[None, :, None]
        k_i = take(k, idx)
        v_i = take(v, idx)
        s = jnp.einsum('bqhd,bqkhd->bhqk', q_i, k_i).astype(jnp.float32) * scale
        p = masked_softmax(s, valid[:, None])
        return jnp.einsum('bhqk,bqkhd->bqhd', p.astype(v_i.dtype), v_i)

    return lax.map(blk, (q_g, qi_g, w_g, t_g)).swapaxes(0, 1).reshape(B, S, H, dh)


def hier_moe(x, w_group, b_group, w_expert, b_expert, w_gate, w_up, w_down):
    B, S, D = x.shape
    T = B * S
    N = T * MOE_TOPK
    xf = x.reshape(T, D)
    g_logits = (xf @ w_group).astype(jnp.float32) + b_group.astype(jnp.float32)
    grp = jnp.argmax(g_logits, axis=-1)
    p_grp = jnp.take_along_axis(jax.nn.softmax(g_logits, axis=-1), grp[:, None], axis=1)[:, 0]
    e_logits = ((xf @ w_expert).astype(jnp.float32) + b_expert.astype(jnp.float32)).reshape(T, MOE_GROUPS, MOE_EXPERTS_PER_GROUP)
    e_in_grp = jnp.take_along_axis(e_logits, grp[:, None, None], axis=1)[:, 0]
    top_val, top_loc = lax.top_k(e_in_grp, MOE_TOPK)
    weights = (p_grp[:, None] * jax.nn.softmax(top_val, axis=-1)).reshape(N)
    expert_id = (grp[:, None] * MOE_EXPERTS_PER_GROUP + top_loc).reshape(N)
    token_id = jnp.repeat(jnp.arange(T, dtype=jnp.int32), MOE_TOPK)
    order = jnp.argsort(expert_id)
    e_sorted = expert_id[order]
    counts = jnp.bincount(expert_id, length=MOE_N_EXPERTS)
    padded = (counts + MOE_ROW_BLOCK - 1) // MOE_ROW_BLOCK * MOE_ROW_BLOCK
    start = jnp.cumsum(counts) - counts
    p_end = jnp.cumsum(padded)
    p_start = p_end - padded
    dest = p_start[e_sorted] + jnp.arange(N) - start[e_sorted]
    n_blocks = -(-(N + MOE_N_EXPERTS * (MOE_ROW_BLOCK - 1)) // MOE_ROW_BLOCK)
    rows = n_blocks * MOE_ROW_BLOCK
    row_tok = jnp.zeros((rows,), jnp.int32).at[dest].set(token_id[order])
    row_w = jnp.zeros((rows,), jnp.float32).at[dest].set(weights[order])
    blk_expert = jnp.minimum(jnp.searchsorted(p_end, jnp.arange(n_blocks) * MOE_ROW_BLOCK, side='right'), MOE_N_EXPERTS - 1)

    def expert_block(args):
        tok, e = args
        xt = xf[tok]
        return (jax.nn.silu(xt @ w_gate[e]) * (xt @ w_up[e])) @ w_down[e]

    y = lax.map(expert_block, (row_tok.reshape(n_blocks, MOE_ROW_BLOCK), blk_expert)).reshape(rows, D)
    out = jnp.zeros((T, D), x.dtype).at[row_tok].add(y * row_w[:, None].astype(y.dtype))
    return out.reshape(B, S, D)


def setup_inputs(seed: int = 0) -> dict:
    key = jax.random.key(seed)
    ks = iter(jax.random.split(key, 40))
    nrm = lambda shape, scale: jax.random.normal(next(ks), shape, jnp.float32) * scale
    L, D, dh, W = DEPTH, D_MODEL, HEAD_DIM, MIX_WIDTH
    E, DE = MOE_N_EXPERTS, MOE_D_EXPERT
    return {
        'x': nrm((BATCH, SEQ, D), 1.0),
        'positions': jnp.broadcast_to(jnp.arange(SEQ, dtype=jnp.int32), (BATCH, SEQ)),
        'attn_norm': 1.0 + nrm((L, D), 0.02),
        'w_in': nrm((L, D, D_IN), D ** -0.5),
        'nsa_pe_k': nrm((L, NSA_CMP_LEN, dh), 0.02),
        'nsa_w1_k': nrm((L, NSA_CMP_LEN * dh, NSA_CMP_HIDDEN), (NSA_CMP_LEN * dh) ** -0.5),
        'nsa_w2_k': nrm((L, NSA_CMP_HIDDEN, dh), NSA_CMP_HIDDEN ** -0.5),
        'nsa_pe_v': nrm((L, NSA_CMP_LEN, dh), 0.02),
        'nsa_w1_v': nrm((L, NSA_CMP_LEN * dh, NSA_CMP_HIDDEN), (NSA_CMP_LEN * dh) ** -0.5),
        'nsa_w2_v': nrm((L, NSA_CMP_HIDDEN, dh), NSA_CMP_HIDDEN ** -0.5),
        'fox_forget_bias': FOX_BIAS_INIT + nrm((L, N_HEADS_MIX), 0.1),
        'dsa_kv_norm': 1.0 + nrm((L, DSA_KV_RANK), 0.02),
        'dsa_w_ukv': nrm((L, DSA_KV_RANK, 2 * W), DSA_KV_RANK ** -0.5),
        'swa_sinks': nrm((L, N_HEADS_MIX), 0.5),
        'w_branch': nrm((L, N_BRANCH, W, D), W ** -0.5),
        'w_gate': nrm((L, N_BRANCH, D, D), D ** -0.5),
        'w_out': nrm((L, D, D), D ** -0.5),
        'ffn_norm': 1.0 + nrm((L, D), 0.02),
        'moe_w_group': nrm((L, D, MOE_GROUPS), D ** -0.5),
        'moe_b_group': nrm((L, MOE_GROUPS), 0.01),
        'moe_w_expert': nrm((L, D, E), D ** -0.5),
        'moe_b_expert': nrm((L, E), 0.01),
        'moe_w_gate': nrm((L, E, D, DE), D ** -0.5),
        'moe_w_up': nrm((L, E, D, DE), D ** -0.5),
        'moe_w_down': nrm((L, E, DE, D), DE ** -0.5),
        'final_norm': 1.0 + nrm((D,), 0.02),
    }


def reference(x, positions, attn_norm, w_in, nsa_pe_k, nsa_w1_k, nsa_w2_k, nsa_pe_v, nsa_w1_v, nsa_w2_v,
              fox_forget_bias, dsa_kv_norm, dsa_w_ukv, swa_sinks, w_branch, w_gate, w_out, ffn_norm,
              moe_w_group, moe_b_group, moe_w_expert, moe_b_expert, moe_w_gate, moe_w_up, moe_w_down,
              final_norm):
    B, S, D = x.shape
    H = N_HEADS_MIX
    heads = lambda a, n: a.reshape(B, S, n, HEAD_DIM)
    rope1 = lambda a: rope(a[:, :, None, :], positions)[:, :, 0, :]
    h = x
    for l in range(DEPTH):
        hn = rms_norm(h, attn_norm[l])
        z = split_in(hn @ w_in[l])
        o_a = nsa_mixer(
            rope(heads(z['q_a'], H), positions),
            rope1(z['k_cmp']), z['v_cmp'], rope1(z['k_sel']), z['v_sel'], rope1(z['k_win']), z['v_win'],
            z['g_a'].reshape(B, S, H, NSA_N_GATES),
            nsa_pe_k[l], nsa_w1_k[l], nsa_w2_k[l], nsa_pe_v[l], nsa_w1_v[l], nsa_w2_v[l])
        o_b = fox_mixer(heads(z['q_b'], H), heads(z['k_b'], H), heads(z['v_b'], H), z['f_b'], fox_forget_bias[l])
        kv_c = rms_norm(z['ckv_c'], dsa_kv_norm[l]) @ dsa_w_ukv[l]
        o_c = dsa_mixer(
            rope(heads(z['q_c'], H), positions),
            rope(heads(kv_c[..., :MIX_WIDTH], H), positions),
            heads(kv_c[..., MIX_WIDTH:], H),
            rope(z['qi_c'].reshape(B, S, DSA_IDX_HEADS, DSA_IDX_DIM), positions),
            rope1(z['ki_c']), z['wi_c'])
        o_d = banded_attention(
            rope(heads(z['q_d'], H), positions),
            rope(heads(z['k_d'], SWA_KV_HEADS), positions),
            heads(z['v_d'], SWA_KV_HEADS), SWA_WINDOW, swa_sinks[l])
        merged = jnp.zeros_like(h)
        for i, o in enumerate((o_a, o_b, o_c, o_d)):
            gate = jax.nn.sigmoid((hn @ w_gate[l, i]).astype(jnp.float32)).astype(h.dtype)
            merged = merged + gate * (o.reshape(B, S, MIX_WIDTH) @ w_branch[l, i])
        h = h + merged @ w_out[l]
        h = h + hier_moe(rms_norm(h, ffn_norm[l]), moe_w_group[l], moe_b_group[l], moe_w_expert[l],
                         moe_b_expert[l], moe_w_gate[l], moe_w_up[l], moe_w_down[l])
    return rms_norm(h, final_norm)
```

```cpp
#include <hip/hip_runtime.h>
#include <hip/hip_cooperative_groups.h>
#include <stdint.h>
namespace cg = cooperative_groups;

#define B_ 8
#define S_ 2048
#define D_ 1024
#define T_ (B_ * S_)
#define DIN 2644
#define O_QA 0
#define O_KCMP 256
#define O_VCMP 320
#define O_KSEL 384
#define O_VSEL 448
#define O_KWIN 512
#define O_VWIN 576
#define O_GA 640
#define O_QB 652
#define O_KB 908
#define O_VB 1164
#define O_FB 1420
#define O_QC 1424
#define O_CKV 1680
#define O_QI 1808
#define O_KI 2064
#define O_WI 2128
#define O_QD 2132
#define O_KD 2388
#define O_VD 2516
#define NCMP 127

__global__ void k_rope_table(const int* __restrict__ pos, float* __restrict__ cs, float* __restrict__ sn) {
    int idx = blockIdx.x * blockDim.x + threadIdx.x;
    if (idx >= T_ * 32) return;
    int i = idx & 31, t = idx >> 5;
    float inv = powf(10000.f, -(float)i / 32.f);
    float ang = (float)pos[t] * inv;
    double a = (double)ang;
    double n = rint(a * 0.15915494309189535);
    double r = a - n * 6.283185307179586;
    float rf = (float)r;
    cs[idx] = cosf(rf);
    sn[idx] = sinf(rf);
}

__global__ __launch_bounds__(256) void k_rmsnorm(const float* __restrict__ in, int ldin, const float* __restrict__ gain,
                                                 float* __restrict__ out, int ldout, int width) {
    __shared__ float red[4];
    int row = blockIdx.x, tid = threadIdx.x;
    const float* x = in + (long)row * ldin;
    float ss = 0.f;
    for (int i = tid; i < width; i += 256) { float v = x[i]; ss += v * v; }
    for (int o = 32; o > 0; o >>= 1) ss += __shfl_xor(ss, o);
    if ((tid & 63) == 0) red[tid >> 6] = ss;
    __syncthreads();
    float tot = red[0] + red[1] + red[2] + red[3];
    float rs = rsqrtf(tot / (float)width + 1e-6f);
    for (int i = tid; i < width; i += 256) out[(long)row * ldout + i] = x[i] * rs * gain[i];
}

__device__ __forceinline__ void tile_mm(const float* __restrict__ A, int lda, const float* __restrict__ W, int ldw, int N, int K,
                                        int m0, int n0, float (&acc)[4][4], float (*As)[68], float (*Ws)[68]) {
    int tid = threadIdx.x, ty = tid >> 4, tx = tid & 15;
    for (int k0 = 0; k0 < K; k0 += 16) {
        {
            int r = tid >> 2, kc = (tid & 3) * 4;
            float4 v = *(const float4*)(A + (long)(m0 + r) * lda + k0 + kc);
            As[kc + 0][r] = v.x; As[kc + 1][r] = v.y; As[kc + 2][r] = v.z; As[kc + 3][r] = v.w;
        }
        {
            int kr = tid >> 4, nc = (tid & 15) * 4;
            float4 v = make_float4(0.f, 0.f, 0.f, 0.f);
            if (n0 + nc < N) v = *(const float4*)(W + (long)(k0 + kr) * ldw + n0 + nc);
            *(float4*)&Ws[kr][nc] = v;
        }
        __syncthreads();
#pragma unroll
        for (int k = 0; k < 16; ++k) {
            float4 a = *(const float4*)&As[k][ty * 4];
            float4 b = *(const float4*)&Ws[k][tx * 4];
            float av[4] = {a.x, a.y, a.z, a.w}, bv[4] = {b.x, b.y, b.z, b.w};
#pragma unroll
            for (int i = 0; i < 4; ++i)
#pragma unroll
                for (int j = 0; j < 4; ++j) acc[i][j] += av[i] * bv[j];
        }
        __syncthreads();
    }
}

template <int EPI>
__global__ __launch_bounds__(256) void k_gemm(const float* __restrict__ A, int lda, const float* __restrict__ W, int ldw,
                                              float* C, int ldc, int N, int K, const float* R) {
    __shared__ float As[16][68];
    __shared__ float Ws[16][68];
    int m0 = blockIdx.y * 64, n0 = blockIdx.x * 64;
    float acc[4][4] = {};
    tile_mm(A, lda, W, ldw, N, K, m0, n0, acc, As, Ws);
    int ty = threadIdx.x >> 4, tx = threadIdx.x & 15;
#pragma unroll
    for (int i = 0; i < 4; ++i)
#pragma unroll
        for (int j = 0; j < 4; ++j) {
            int r = m0 + ty * 4 + i, c = n0 + tx * 4 + j;
            if (c < N) {
                float v = acc[i][j];
                if (EPI == 1) v += R[(long)r * ldc + c];
                C[(long)r * ldc + c] = v;
            }
        }
}

__global__ __launch_bounds__(256) void k_merge(const float* __restrict__ hn, const float* __restrict__ o, const float* __restrict__ wg,
                                               const float* __restrict__ wb, float* __restrict__ merged) {
    __shared__ float As[16][68];
    __shared__ float Ws[16][68];
    int m0 = blockIdx.y * 64, n0 = blockIdx.x * 64;
    float tot[4][4] = {};
    for (int i = 0; i < 4; ++i) {
        float ag[4][4] = {}, ab[4][4] = {};
        tile_mm(hn, D_, wg + (long)i * D_ * D_, D_, D_, D_, m0, n0, ag, As, Ws);
        tile_mm(o + i * 256, D_, wb + (long)i * 256 * D_, D_, D_, 256, m0, n0, ab, As, Ws);
#pragma unroll
        for (int a = 0; a < 4; ++a)
#pragma unroll
            for (int b = 0; b < 4; ++b) tot[a][b] += ab[a][b] / (1.f + __expf(-ag[a][b]));
    }
    int ty = threadIdx.x >> 4, tx = threadIdx.x & 15;
#pragma unroll
    for (int a = 0; a < 4; ++a)
#pragma unroll
        for (int b = 0; b < 4; ++b) merged[(long)(m0 + ty * 4 + a) * D_ + n0 + tx * 4 + b] = tot[a][b];
}

struct RopeP { int off[24]; int nh; };
__global__ void k_rope(float* __restrict__ buf, int ld, RopeP rp, const float* __restrict__ cs, const float* __restrict__ sn) {
    long idx = (long)blockIdx.x * blockDim.x + threadIdx.x;
    long total = (long)T_ * rp.nh * 32;
    if (idx >= total) return;
    int i = idx & 31; long r = idx >> 5; int hh = r % rp.nh; long t = r / rp.nh;
    float c = cs[t * 32 + i], s = sn[t * 32 + i];
    float* p = buf + t * ld + rp.off[hh];
    float x1 = p[i], x2 = p[i + 32];
    p[i] = x1 * c - x2 * s;
    p[i + 32] = x2 * c + x1 * s;
}

__device__ __forceinline__ float gelu_tanh(float x) {
    float u = 0.7978845608028654f * (x + 0.044715f * x * x * x);
    return 0.5f * x * (1.f + tanhf(u));
}
__global__ __launch_bounds__(256) void k_compress(const float* __restrict__ z, const float* __restrict__ pe_k, const float* __restrict__ w1_k,
                                                  const float* __restrict__ w2_k, const float* __restrict__ pe_v, const float* __restrict__ w1_v,
                                                  const float* __restrict__ w2_v, float* __restrict__ kc, float* __restrict__ vc) {
    __shared__ float zin[2048];
    __shared__ float hid[256];
    int blk = blockIdx.x; int kv = blk / (B_ * NCMP); int rem = blk % (B_ * NCMP); int b = rem / NCMP, c = rem % NCMP;
    const float* pe = kv ? pe_v : pe_k; const float* w1 = kv ? w1_v : w1_k; const float* w2 = kv ? w2_v : w2_k;
    int coff = kv ? O_VCMP : O_KCMP; float* dst = kv ? vc : kc;
    int tid = threadIdx.x;
    for (int i = tid; i < 2048; i += 256) {
        int p = i >> 6, d = i & 63;
        zin[i] = z[((long)b * S_ + 16 * c + p) * DIN + coff + d] + pe[i];
    }
    __syncthreads();
    float acc = 0.f;
    for (int i = 0; i < 2048; ++i) acc += zin[i] * w1[(long)i * 256 + tid];
    hid[tid] = gelu_tanh(acc);
    __syncthreads();
    if (tid < 64) {
        float a = 0.f;
        for (int j = 0; j < 256; ++j) a += hid[j] * w2[j * 64 + tid];
        dst[((long)b * NCMP + c) * 64 + tid] = a;
    }
}

__global__ void k_cumsum(const float* __restrict__ z, const float* __restrict__ fbias, float* __restrict__ cum) {
    int tid = threadIdx.x; if (tid >= 32) return;
    int b = tid >> 2, h = tid & 3;
    float bias = fbias[h], c = 0.f;
    for (int s = 0; s < S_; ++s) {
        float x = z[((long)b * S_ + s) * DIN + O_FB + h] + bias;
        float ls = fminf(x, 0.f) - log1pf(expf(-fabsf(x)));
        c += ls;
        cum[((long)b * S_ + s) * 4 + h] = c;
    }
}

__global__ __launch_bounds__(64) void k_nsa_cmp(const float* __restrict__ z, const float* __restrict__ kc, const float* __restrict__ vc,
                                                float* __restrict__ pc, float* __restrict__ out) {
    int lane = threadIdx.x, blk = blockIdx.x;
    int tb = blk & 31, h = (blk >> 5) & 3, b = blk >> 7;
    int t = tb * 64 + lane; long row = (long)b * S_ + t;
    float q[64];
#pragma unroll
    for (int d = 0; d < 64; ++d) q[d] = z[row * DIN + O_QA + h * 64 + d];
    int nc = (t >= 31) ? ((t - 31) / 16 + 1) : 0; if (nc > NCMP) nc = NCMP;
    int tmax = tb * 64 + 63; int ncw = (tmax >= 31) ? ((tmax - 31) / 16 + 1) : 0; if (ncw > NCMP) ncw = NCMP;
    float m = -1e30f, l = 0.f;
    for (int c = 0; c < ncw; ++c) {
        const float* kr = kc + ((long)b * NCMP + c) * 64;
        float sc = 0.f;
#pragma unroll
        for (int d = 0; d < 64; ++d) sc += q[d] * kr[d];
        sc *= 0.125f;
        if (c < nc) { float mn = fmaxf(m, sc); l = l * __expf(m - mn) + __expf(sc - mn); m = mn; }
    }
    float inv = (nc > 0) ? 1.f / l : 0.f;
    float o[64];
#pragma unroll
    for (int d = 0; d < 64; ++d) o[d] = 0.f;
    for (int c = 0; c < 128; ++c) {
        float p = 0.f;
        if (c < ncw) {
            const float* kr = kc + ((long)b * NCMP + c) * 64;
            const float* vr = vc + ((long)b * NCMP + c) * 64;
            float sc = 0.f;
#pragma unroll
            for (int d = 0; d < 64; ++d) sc += q[d] * kr[d];
            sc *= 0.125f;
            if (c < nc) p = __expf(sc - m) * inv;
#pragma unroll
            for (int d = 0; d < 64; ++d) o[d] += p * vr[d];
        }
        pc[(row * 4 + h) * 128 + c] = p;
    }
    float g = 1.f / (1.f + __expf(-z[row * DIN + O_GA + h * 3 + 0]));
#pragma unroll
    for (int d = 0; d < 64; ++d) out[row * D_ + h * 64 + d] = g * o[d];
}

__global__ __launch_bounds__(64) void k_nsa_select(const float* __restrict__ pc, unsigned* __restrict__ selmask) {
    __shared__ float imp[64][33];
    int lane = threadIdx.x; long row = (long)blockIdx.x * 64 + lane;
    int t = (int)(row % S_); int cur = t >> 6;
    for (int j = 0; j < 32; ++j) {
        float a = 0.f;
        int c0 = 4 * j - 1; if (c0 < 0) c0 = 0; int c1 = 4 * j + 3; if (c1 > NCMP - 1) c1 = NCMP - 1;
        for (int h = 0; h < 4; ++h)
            for (int c = c0; c <= c1; ++c) a += pc[(row * 4 + h) * 128 + c];
        if (j == 0 || j == cur || j == cur - 1) a = 1e4f;
        if (j > cur) a = -1e4f;
        imp[lane][j] = a;
    }
    unsigned m = 0;
    for (int j = 0; j < 32; ++j) {
        float v = imp[lane][j]; int rank = 0;
        for (int j2 = 0; j2 < 32; ++j2) { float u = imp[lane][j2]; rank += (u > v) || (u == v && j2 < j); }
        if (rank < 16) m |= 1u << j;
    }
    selmask[row] = m;
}

struct AttnP {
    const float* q; int ldq; int qoff;
    const float* k; int ldk; int koff;
    const float* v; int ldv; int voff;
    int kvdiv;
    float* out; int ooff;
    const float* aux;
    const unsigned* mask;
    const float* gate; int gate_idx;
};
enum { M_SEL = 0, M_WIN = 1, M_FOX = 2, M_DSA = 3, M_SWA = 4 };
template <int MODE>
__global__ __launch_bounds__(64) void k_attn(AttnP p) {
    int lane = threadIdx.x, blk = blockIdx.x;
    int tb = blk & 31, h = (blk >> 5) & 3, b = blk >> 7;
    int t = tb * 64 + lane; long row = (long)b * S_ + t;
    float q[64], o[64];
#pragma unroll
    for (int d = 0; d < 64; ++d) { q[d] = p.q[row * p.ldq + p.qoff + h * 64 + d]; o[d] = 0.f; }
    float m = -1e30f, l = 0.f;
    int s_lo = 0, s_hi = tb * 64 + 63;
    if (MODE == M_WIN) { s_lo = tb * 64 - 511; if (s_lo < 0) s_lo = 0; }
    if (MODE == M_SWA) { s_lo = tb * 64 - 127; if (s_lo < 0) s_lo = 0; }
    int kvh = h / p.kvdiv;
    unsigned selm = 0, dw = 0;
    if (MODE == M_SEL) selm = p.mask[row];
    for (int s = s_lo; s <= s_hi; ++s) {
        const float* kr = p.k + ((long)b * S_ + s) * p.ldk + p.koff + kvh * 64;
        const float* vr = p.v + ((long)b * S_ + s) * p.ldv + p.voff + kvh * 64;
        bool ok = s <= t;
        if (MODE == M_WIN) ok = ok && (s > t - 512);
        if (MODE == M_SWA) ok = ok && (s > t - 128);
        if (MODE == M_SEL) ok = ok && ((selm >> (s >> 6)) & 1u);
        if (MODE == M_DSA) { if ((s & 31) == 0) dw = p.mask[row * 64 + (s >> 5)]; ok = (dw >> (s & 31)) & 1u; }
        float sc = 0.f;
#pragma unroll
        for (int d = 0; d < 64; ++d) sc += q[d] * kr[d];
        sc *= 0.125f;
        if (MODE == M_FOX) sc -= p.aux[((long)b * S_ + s) * 4 + h];
        if (ok) {
            float mn = fmaxf(m, sc);
            float a = __expf(m - mn), pe = __expf(sc - mn);
            l = l * a + pe;
#pragma unroll
            for (int d = 0; d < 64; ++d) o[d] = o[d] * a + pe * vr[d];
            m = mn;
        }
    }
    float scale;
    if (MODE == M_SWA) {
        float sk = p.aux[h]; float mn = fmaxf(m, sk);
        float a = __expf(m - mn);
        scale = a / (l * a + __expf(sk - mn));
    } else scale = (l > 0.f) ? 1.f / l : 0.f;
    if (p.gate) {
        float g = 1.f / (1.f + __expf(-p.gate[row * DIN + O_GA + h * 3 + p.gate_idx]));
#pragma unroll
        for (int d = 0; d < 64; ++d) p.out[row * D_ + p.ooff + h * 64 + d] += g * scale * o[d];
    } else {
#pragma unroll
        for (int d = 0; d < 64; ++d) p.out[row * D_ + p.ooff + h * 64 + d] = scale * o[d];
    }
}

__global__ __launch_bounds__(256) void k_dsa_topk(const float* __restrict__ z, unsigned* __restrict__ mask) {
    __shared__ float sc[2048];
    __shared__ float qi[256];
    __shared__ float w[4];
    __shared__ unsigned bits[64];
    int row = blockIdx.x, b = row / S_, t = row % S_, tid = threadIdx.x;
    qi[tid] = z[(long)row * DIN + O_QI + tid];
    if (tid < 4) w[tid] = z[(long)row * DIN + O_WI + tid] * 0.5f;
    if (tid < 64) bits[tid] = 0u;
    __syncthreads();
    int n = t + 1;
    for (int s = tid; s < n; s += 256) {
        const float* ki = z + ((long)b * S_ + s) * DIN + O_KI;
        float acc = 0.f;
        for (int h = 0; h < 4; ++h) {
            float dot = 0.f;
            for (int d = 0; d < 64; ++d) dot += qi[h * 64 + d] * ki[d];
            acc += w[h] * fmaxf(dot * 0.125f, 0.f);
        }
        sc[s] = acc;
    }
    __syncthreads();
    if (n <= 256) {
        if (tid < n) atomicOr(&bits[tid >> 5], 1u << (tid & 31));
    } else {
        float v[8]; int rank[8];
#pragma unroll
        for (int i = 0; i < 8; ++i) { int s = tid + 256 * i; v[i] = (s < n) ? sc[s] : 0.f; rank[i] = 0; }
        for (int s2 = 0; s2 < n; ++s2) {
            float u = sc[s2];
#pragma unroll
            for (int i = 0; i < 8; ++i) { int s = tid + 256 * i; rank[i] += (u > v[i]) || (u == v[i] && s2 < s); }
        }
#pragma unroll
        for (int i = 0; i < 8; ++i) { int s = tid + 256 * i; if (s < n && rank[i] < 256) atomicOr(&bits[s >> 5], 1u << (s & 31)); }
    }
    __syncthreads();
    if (tid < 64) mask[(long)row * 64 + tid] = bits[tid];
}

__global__ void k_route(const float* __restrict__ lg, const float* __restrict__ le, const float* __restrict__ bg, const float* __restrict__ be,
                        int* __restrict__ eid, float* __restrict__ ew) {
    int t = blockIdx.x * blockDim.x + threadIdx.x; if (t >= T_) return;
    float g[8]; float mx = -1e30f; int gi = 0;
#pragma unroll
    for (int i = 0; i < 8; ++i) { g[i] = lg[t * 8 + i] + bg[i]; if (g[i] > mx) { mx = g[i]; gi = i; } }
    float den = 0.f;
#pragma unroll
    for (int i = 0; i < 8; ++i) den += expf(g[i] - mx);
    float pg = 1.f / den;
    float e[8];
#pragma unroll
    for (int i = 0; i < 8; ++i) e[i] = le[t * 64 + gi * 8 + i] + be[gi * 8 + i];
    float v0 = -1e30f; int i0 = 0;
#pragma unroll
    for (int i = 0; i < 8; ++i) if (e[i] > v0) { v0 = e[i]; i0 = i; }
    float v1 = -1e30f; int i1 = 0;
#pragma unroll
    for (int i = 0; i < 8; ++i) if (i != i0 && e[i] > v1) { v1 = e[i]; i1 = i; }
    float x = expf(v1 - v0);
    float w0 = 1.f / (1.f + x), w1 = x / (1.f + x);
    eid[t * 2 + 0] = gi * 8 + i0; eid[t * 2 + 1] = gi * 8 + i1;
    ew[t * 2 + 0] = pg * w0; ew[t * 2 + 1] = pg * w1;
}

__global__ __launch_bounds__(256) void k_moe_hid(const float* __restrict__ xn, const int* __restrict__ eid, const float* __restrict__ wgate,
                                                 const float* __restrict__ wup, float* __restrict__ hid) {
    __shared__ float x[1024];
    int slot = blockIdx.x, t = slot >> 1, tid = threadIdx.x;
    int e = eid[slot];
    for (int i = tid; i < 1024; i += 256) x[i] = xn[(long)t * D_ + i];
    __syncthreads();
    const float* wg = wgate + (long)e * 1024 * 256 + tid;
    const float* wu = wup + (long)e * 1024 * 256 + tid;
    float g = 0.f, u = 0.f;
#pragma unroll 8
    for (int k = 0; k < 1024; ++k) { g += x[k] * wg[(long)k * 256]; u += x[k] * wu[(long)k * 256]; }
    hid[(long)slot * 256 + tid] = (g / (1.f + __expf(-g))) * u;
}

__global__ __launch_bounds__(256) void k_moe_down(const float* __restrict__ hid, const int* __restrict__ eid, const float* __restrict__ ew,
                                                  const float* __restrict__ wdown, float* __restrict__ h) {
    __shared__ float hh[512];
    int t = blockIdx.x, tid = threadIdx.x;
    hh[tid] = hid[(long)t * 512 + tid]; hh[tid + 256] = hid[(long)t * 512 + 256 + tid];
    __syncthreads();
    float4 tot = make_float4(0.f, 0.f, 0.f, 0.f);
    for (int k = 0; k < 2; ++k) {
        int e = eid[t * 2 + k]; float w = ew[t * 2 + k];
        const float* wd = wdown + (long)e * 256 * 1024 + tid * 4;
        float4 a = make_float4(0.f, 0.f, 0.f, 0.f);
#pragma unroll 8
        for (int i = 0; i < 256; ++i) {
            float4 wv = *(const float4*)(wd + (long)i * 1024); float x = hh[k * 256 + i];
            a.x += x * wv.x; a.y += x * wv.y; a.z += x * wv.z; a.w += x * wv.w;
        }
        tot.x += w * a.x; tot.y += w * a.y; tot.z += w * a.z; tot.w += w * a.w;
    }
    float4* hp = (float4*)(h + (long)t * D_ + tid * 4);
    float4 hv = *hp; hv.x += tot.x; hv.y += tot.y; hv.z += tot.z; hv.w += tot.w; *hp = hv;
}

#define XB_TMO 128
#define XB_XCNT(j) (256 + 64 * (j))
#define XB_XSUB(j) (1280 + 64 * (j))
#define XB_XGEN(j) (2304 + 64 * (j))
#define XB_TOP 3328
#define XB_TOPGEN 3392
#define XCD_BAR_WORDS 3456
#define XB_SPIN_CAP (1u << 18)
#define LAS __attribute__((address_space(3)))
__device__ __forceinline__ unsigned xb_ld(unsigned* p) { return __hip_atomic_load(p, __ATOMIC_RELAXED, __HIP_MEMORY_SCOPE_AGENT); }
__device__ __forceinline__ unsigned xb_add(unsigned* p, unsigned v) { return __hip_atomic_fetch_add(p, v, __ATOMIC_RELAXED, __HIP_MEMORY_SCOPE_AGENT); }
__device__ __forceinline__ unsigned xb_xcc_id() { return (unsigned)__builtin_amdgcn_s_getreg((3 << 11) | 20) & 0xFu; }
#define XB_SPIN(cond, bar) do { unsigned _sp = 0; while (cond) { __builtin_amdgcn_s_sleep(1); \
    if ((++_sp & 255u) == 0u) { if (xb_ld(&(bar)[XB_TMO])) break; if (_sp > XB_SPIN_CAP) { atomicAdd(&(bar)[XB_TMO], 1u); break; } } } } while (0)
struct XcdBarrier { unsigned* bar; unsigned x; volatile LAS unsigned* st; };
__device__ __forceinline__ XcdBarrier xcd_barrier_post(unsigned* bar, volatile LAS unsigned* st) {
    XcdBarrier b; b.bar = bar; b.x = xb_xcc_id(); b.st = st;
    if (threadIdx.x == 0) (void)xb_add(&bar[XB_XCNT(b.x)], 1u);
    return b;
}
__device__ __forceinline__ void xcd_barrier_complete(unsigned* bar, unsigned x, unsigned& nloc, unsigned& nx) {
    const unsigned G = gridDim.x * gridDim.y * gridDim.z;
    unsigned sum, cnt, mine, sp = 0u;
    for (;;) {
        sum = 0u; cnt = 0u; mine = 0u;
#pragma unroll
        for (unsigned j = 0; j < 16; ++j) { const unsigned c = xb_ld(&bar[XB_XCNT(j)]); sum += c; cnt += (c > 0u) ? 1u : 0u; mine = (j == x) ? c : mine; }
        if (sum == G) break;
        __builtin_amdgcn_s_sleep(1);
        if ((++sp & 255u) == 0u) { if (xb_ld(&bar[XB_TMO])) break; if (sp > XB_SPIN_CAP) { atomicAdd(&bar[XB_TMO], 1u); break; } }
    }
    nloc = mine > 0u ? mine : 1u; nx = cnt > 0u ? cnt : 1u;
}
__device__ __forceinline__ void xcd_barrier(const XcdBarrier& b) {
    asm volatile("s_waitcnt vmcnt(0)" ::: "memory");
    __syncthreads();
    if (threadIdx.x == 0) {
        unsigned* bar = b.bar;
        __builtin_amdgcn_s_waitcnt(0);
        unsigned nloc = b.st[0], nx = b.st[1];
        if (nloc == 0u) { xcd_barrier_complete(bar, b.x, nloc, nx); b.st[0] = nloc; b.st[1] = nx; }
        const unsigned old = xb_add(&bar[XB_XSUB(b.x)], 1u);
        const unsigned gen = old / nloc;
        if (old + 1u == (gen + 1u) * nloc) {
            __builtin_amdgcn_fence(__ATOMIC_RELEASE, "agent");
            asm volatile("s_waitcnt vmcnt(0)" ::: "memory");
            const unsigned og = xb_add(&bar[XB_TOP], 1u);
            const unsigned tg = og / nx;
            if (og + 1u == (tg + 1u) * nx) xb_add(&bar[XB_TOPGEN], 1u);
            else XB_SPIN(xb_ld(&bar[XB_TOPGEN]) == tg, bar);
            __builtin_amdgcn_fence(__ATOMIC_ACQUIRE, "agent");
            xb_add(&bar[XB_XGEN(b.x)], 1u);
            asm volatile("s_waitcnt vmcnt(0)" ::: "memory");
        } else {
            XB_SPIN(xb_ld(&bar[XB_XGEN(b.x)]) == gen, bar);
            __builtin_amdgcn_fence(__ATOMIC_ACQUIRE, "agent");
            asm volatile("s_waitcnt vmcnt(0)" ::: "memory");
        }
    }
    __syncthreads();
}

__global__ __launch_bounds__(256) void k_final(const float* __restrict__ h, const float* __restrict__ gain, float* __restrict__ tmp,
                                               float* __restrict__ out, unsigned* bar) {
    __shared__ uint4 xbw;
    __shared__ float red[4];
    cg::grid_group grid = cg::this_grid();
    int tid = threadIdx.x;
    if (tid == 0) xbw = make_uint4(0u, 0u, 0u, 0u);
    __syncthreads();
    XcdBarrier xb = xcd_barrier_post(bar, (volatile LAS unsigned*)&xbw);
    for (int row = blockIdx.x; row < T_; row += gridDim.x) {
        const float* x = h + (long)row * D_;
        float4 v = *(const float4*)(x + tid * 4);
        float ss = v.x * v.x + v.y * v.y + v.z * v.z + v.w * v.w;
        for (int o = 32; o > 0; o >>= 1) ss += __shfl_xor(ss, o);
        __syncthreads();
        if ((tid & 63) == 0) red[tid >> 6] = ss;
        __syncthreads();
        float rs = rsqrtf((red[0] + red[1] + red[2] + red[3]) / (float)D_ + 1e-6f);
        float4 g = *(const float4*)(gain + tid * 4);
        *(float4*)(tmp + (long)row * D_ + tid * 4) = make_float4(v.x * rs * g.x, v.y * rs * g.y, v.z * rs * g.z, v.w * rs * g.w);
    }
    xcd_barrier(xb);
    int shift = (blockIdx.x + gridDim.x / 2 + 3) % gridDim.x;
    for (int row = shift; row < T_; row += gridDim.x)
        *(float4*)(out + (long)row * D_ + tid * 4) = *(const float4*)(tmp + (long)row * D_ + tid * 4);
    grid.sync();
}

extern "C" void kernel_launch(void* const* d_in, const int* in_sizes, int n_in, void* d_out, int out_size, void* d_ws, size_t ws_size,
                              hipStream_t stream) {
    const float* x = (const float*)d_in[0];
    const int* positions = (const int*)d_in[1];
    const float* attn_norm = (const float*)d_in[2];
    const float* w_in = (const float*)d_in[3];
    const float* nsa_pe_k = (const float*)d_in[4];
    const float* nsa_w1_k = (const float*)d_in[5];
    const float* nsa_w2_k = (const float*)d_in[6];
    const float* nsa_pe_v = (const float*)d_in[7];
    const float* nsa_w1_v = (const float*)d_in[8];
    const float* nsa_w2_v = (const float*)d_in[9];
    const float* fox_bias = (const float*)d_in[10];
    const float* dsa_kv_norm = (const float*)d_in[11];
    const float* dsa_w_ukv = (const float*)d_in[12];
    const float* swa_sinks = (const float*)d_in[13];
    const float* w_branch = (const float*)d_in[14];
    const float* w_gate = (const float*)d_in[15];
    const float* w_out = (const float*)d_in[16];
    const float* ffn_norm = (const float*)d_in[17];
    const float* moe_w_group = (const float*)d_in[18];
    const float* moe_b_group = (const float*)d_in[19];
    const float* moe_w_expert = (const float*)d_in[20];
    const float* moe_b_expert = (const float*)d_in[21];
    const float* moe_w_gate = (const float*)d_in[22];
    const float* moe_w_up = (const float*)d_in[23];
    const float* moe_w_down = (const float*)d_in[24];
    const float* final_norm = (const float*)d_in[25];
    float* out = (float*)d_out;

    float* ws = (float*)d_ws;
    size_t off = 0;
    auto alloc = [&](size_t n) { float* p = ws + off; off += (n + 63) & ~(size_t)63; return p; };
    unsigned* bar = (unsigned*)alloc(XCD_BAR_WORDS);
    float* h = alloc((size_t)T_ * D_);
    float* hn = alloc((size_t)T_ * D_);
    float* z = alloc((size_t)T_ * DIN);
    float* merged = z;
    float* o = alloc((size_t)T_ * D_);
    float* ckvn = o;
    float* kvc = alloc((size_t)T_ * 512);
    float* pc = alloc((size_t)T_ * 512);
    float* cum = alloc((size_t)T_ * 4);
    float* kc = alloc((size_t)B_ * NCMP * 64);
    float* vc = alloc((size_t)B_ * NCMP * 64);
    unsigned* dmask = (unsigned*)alloc((size_t)T_ * 64);
    unsigned* selmask = (unsigned*)alloc((size_t)T_);
    float* cs = alloc((size_t)T_ * 32);
    float* sn = alloc((size_t)T_ * 32);
    float* lg = alloc((size_t)T_ * 8);
    float* le = alloc((size_t)T_ * 64);
    int* eid = (int*)alloc((size_t)T_ * 2);
    float* ew = alloc((size_t)T_ * 2);
    float* hid = alloc((size_t)T_ * 512);
    float* tmpo = hn;

    hipMemsetAsync(bar, 0, XCD_BAR_WORDS * 4, stream);
    k_rope_table<<<(T_ * 32 + 255) / 256, 256, 0, stream>>>(positions, cs, sn);
    hipMemcpyAsync(h, x, (size_t)T_ * D_ * 4, hipMemcpyDeviceToDevice, stream);

    RopeP rz{}; {
        int n = 0;
        for (int i = 0; i < 4; ++i) rz.off[n++] = O_QA + 64 * i;
        rz.off[n++] = O_KCMP; rz.off[n++] = O_KSEL; rz.off[n++] = O_KWIN;
        for (int i = 0; i < 4; ++i) rz.off[n++] = O_QC + 64 * i;
        for (int i = 0; i < 4; ++i) rz.off[n++] = O_QI + 64 * i;
        rz.off[n++] = O_KI;
        for (int i = 0; i < 4; ++i) rz.off[n++] = O_QD + 64 * i;
        for (int i = 0; i < 2; ++i) rz.off[n++] = O_KD + 64 * i;
        rz.nh = n;
    }
    RopeP rk{}; { for (int i = 0; i < 4; ++i) rk.off[i] = 64 * i; rk.nh = 4; }

    for (int l = 0; l < 2; ++l) {
        k_rmsnorm<<<T_, 256, 0, stream>>>(h, D_, attn_norm + l * D_, hn, D_, D_);
        k_gemm<0><<<dim3((DIN + 63) / 64, T_ / 64), 256, 0, stream>>>(hn, D_, w_in + (size_t)l * D_ * DIN, DIN, z, DIN, DIN, D_, nullptr);
        { long tot = (long)T_ * rz.nh * 32; k_rope<<<(unsigned)((tot + 255) / 256), 256, 0, stream>>>(z, DIN, rz, cs, sn); }
        k_rmsnorm<<<T_, 256, 0, stream>>>(z + O_CKV, DIN, dsa_kv_norm + l * 128, ckvn, 128, 128);
        k_gemm<0><<<dim3(512 / 64, T_ / 64), 256, 0, stream>>>(ckvn, 128, dsa_w_ukv + (size_t)l * 128 * 512, 512, kvc, 512, 512, 128, nullptr);
        { long tot = (long)T_ * 4 * 32; k_rope<<<(unsigned)((tot + 255) / 256), 256, 0, stream>>>(kvc, 512, rk, cs, sn); }
        k_compress<<<2 * B_ * NCMP, 256, 0, stream>>>(z, nsa_pe_k + l * 2048, nsa_w1_k + (size_t)l * 2048 * 256, nsa_w2_k + (size_t)l * 256 * 64,
                                                      nsa_pe_v + l * 2048, nsa_w1_v + (size_t)l * 2048 * 256, nsa_w2_v + (size_t)l * 256 * 64, kc, vc);
        k_nsa_cmp<<<B_ * 4 * 32, 64, 0, stream>>>(z, kc, vc, pc, o);
        k_nsa_select<<<T_ / 64, 64, 0, stream>>>(pc, selmask);
        {
            AttnP p{}; p.q = z; p.ldq = DIN; p.qoff = O_QA; p.k = z; p.ldk = DIN; p.koff = O_KSEL; p.v = z; p.ldv = DIN; p.voff = O_VSEL;
            p.kvdiv = 4; p.out = o; p.ooff = 0; p.aux = nullptr; p.mask = selmask; p.gate = z; p.gate_idx = 1;
            k_attn<M_SEL><<<B_ * 4 * 32, 64, 0, stream>>>(p);
            p.koff = O_KWIN; p.voff = O_VWIN; p.gate_idx = 2; p.mask = nullptr;
            k_attn<M_WIN><<<B_ * 4 * 32, 64, 0, stream>>>(p);
        }
        k_cumsum<<<1, 64, 0, stream>>>(z, fox_bias + l * 4, cum);
        {
            AttnP p{}; p.q = z; p.ldq = DIN; p.qoff = O_QB; p.k = z; p.ldk = DIN; p.koff = O_KB; p.v = z; p.ldv = DIN; p.voff = O_VB;
            p.kvdiv = 1; p.out = o; p.ooff = 256; p.aux = cum; p.mask = nullptr; p.gate = nullptr; p.gate_idx = 0;
            k_attn<M_FOX><<<B_ * 4 * 32, 64, 0, stream>>>(p);
        }
        k_dsa_topk<<<T_, 256, 0, stream>>>(z, dmask);
        {
            AttnP p{}; p.q = z; p.ldq = DIN; p.qoff = O_QC; p.k = kvc; p.ldk = 512; p.koff = 0; p.v = kvc; p.ldv = 512; p.voff = 256;
            p.kvdiv = 1; p.out = o; p.ooff = 512; p.aux = nullptr; p.mask = dmask; p.gate = nullptr; p.gate_idx = 0;
            k_attn<M_DSA><<<B_ * 4 * 32, 64, 0, stream>>>(p);
        }
        {
            AttnP p{}; p.q = z; p.ldq = DIN; p.qoff = O_QD; p.k = z; p.ldk = DIN; p.koff = O_KD; p.v = z; p.ldv = DIN; p.voff = O_VD;
            p.kvdiv = 2; p.out = o; p.ooff = 768; p.aux = swa_sinks + l * 4; p.mask = nullptr; p.gate = nullptr; p.gate_idx = 0;
            k_attn<M_SWA><<<B_ * 4 * 32, 64, 0, stream>>>(p);
        }
        k_merge<<<dim3(D_ / 64, T_ / 64), 256, 0, stream>>>(hn, o, w_gate + (size_t)l * 4 * D_ * D_, w_branch + (size_t)l * 4 * 256 * D_, merged);
        k_gemm<1><<<dim3(D_ / 64, T_ / 64), 256, 0, stream>>>(merged, D_, w_out + (size_t)l * D_ * D_, D_, h, D_, D_, D_, h);
        k_rmsnorm<<<T_, 256, 0, stream>>>(h, D_, ffn_norm + l * D_, hn, D_, D_);
        k_gemm<0><<<dim3(1, T_ / 64), 256, 0, stream>>>(hn, D_, moe_w_group + (size_t)l * D_ * 8, 8, lg, 8, 8, D_, nullptr);
        k_gemm<0><<<dim3(1, T_ / 64), 256, 0, stream>>>(hn, D_, moe_w_expert + (size_t)l * D_ * 64, 64, le, 64, 64, D_, nullptr);
        k_route<<<T_ / 256, 256, 0, stream>>>(lg, le, moe_b_group + l * 8, moe_b_expert + l * 64, eid, ew);
        k_moe_hid<<<T_ * 2, 256, 0, stream>>>(hn, eid, moe_w_gate + (size_t)l * 64 * 1024 * 256, moe_w_up + (size_t)l * 64 * 1024 * 256, hid);
        k_moe_down<<<T_, 256, 0, stream>>>(hid, eid, ew, moe_w_down + (size_t)l * 64 * 256 * 1024, h);
    }
    {
        static int grid_blocks = 0;
        if (!grid_blocks) {
            int dev = 0, cus = 0, per_cu = 0;
            hipGetDevice(&dev);
            hipDeviceGetAttribute(&cus, hipDeviceAttributeMultiprocessorCount, dev);
            hipOccupancyMaxActiveBlocksPerMultiprocessor(&per_cu, k_final, 256, 0);
            if (per_cu > 2) per_cu = 2;
            if (per_cu < 1) per_cu = 1;
            grid_blocks = cus * per_cu;
        }
        const float* hc = h; const float* fn = final_norm; float* tp = tmpo; float* op = out; unsigned* bp = bar;
        void* args[] = {(void*)&hc, (void*)&fn, (void*)&tp, (void*)&op, (void*)&bp};
        hipLaunchCooperativeKernel((void*)k_final, dim3(grid_blocks), dim3(256), args, 0, stream);
    }
}
```

```cpp
#include <hip/hip_runtime.h>
#include <hip/hip_cooperative_groups.h>
#include <stdint.h>
namespace cg = cooperative_groups;

typedef unsigned short bf16_t;
__device__ __forceinline__ float bf2f(bf16_t b) { return __uint_as_float((unsigned)b << 16); }
__device__ __forceinline__ float ldf(const float* p, long i) { return p[i]; }
__device__ __forceinline__ float ldf(const bf16_t* p, long i) { return bf2f(p[i]); }
__device__ __forceinline__ int vtpos(int t) { int x = t & 15; int sub = x >> 2; int ns = ((sub & 1) << 1) | (sub >> 1); return (t & ~15) | (ns << 2) | (x & 3); }
#define LOG2E 1.4426950408889634f
__device__ __forceinline__ bf16_t f2bf_host_dev(float x) { unsigned u = __float_as_uint(x); u += 0x7fffu + ((u >> 16) & 1u); return (bf16_t)(u >> 16); }

#define B_ 8
#define S_ 2048
#define D_ 1024
#define T_ (B_ * S_)
#define DIN 2644
#define O_QA 0
#define O_KCMP 256
#define O_VCMP 320
#define O_KSEL 384
#define O_VSEL 448
#define O_KWIN 512
#define O_VWIN 576
#define O_GA 640
#define O_QB 652
#define O_KB 908
#define O_VB 1164
#define O_FB 1420
#define O_QC 1424
#define O_CKV 1680
#define O_QI 1808
#define O_KI 2064
#define O_WI 2128
#define O_QD 2132
#define O_KD 2388
#define O_VD 2516
#define NCMP 127

__global__ void k_rope_table(const int* __restrict__ pos, float* __restrict__ cs, float* __restrict__ sn) {
    int idx = blockIdx.x * blockDim.x + threadIdx.x;
    if (idx >= T_ * 32) return;
    int i = idx & 31, t = idx >> 5;
    float inv = powf(10000.f, -(float)i / 32.f);
    float ang = (float)pos[t] * inv;
    double a = (double)ang;
    double n = rint(a * 0.15915494309189535);
    double r = a - n * 6.283185307179586;
    float rf = (float)r;
    cs[idx] = cosf(rf);
    sn[idx] = sinf(rf);
}

__global__ __launch_bounds__(256) void k_rmsnorm(const float* __restrict__ in, int ldin, const float* __restrict__ gain,
                                                 float* __restrict__ out, int ldout, int width) {
    __shared__ float red[4];
    int row = blockIdx.x, tid = threadIdx.x;
    const float* x = in + (long)row * ldin;
    float ss = 0.f;
    for (int i = tid; i < width; i += 256) { float v = x[i]; ss += v * v; }
    for (int o = 32; o > 0; o >>= 1) ss += __shfl_xor(ss, o);
    if ((tid & 63) == 0) red[tid >> 6] = ss;
    __syncthreads();
    float tot = red[0] + red[1] + red[2] + red[3];
    float rs = rsqrtf(tot / (float)width + 1e-6f);
    for (int i = tid; i < width; i += 256) out[(long)row * ldout + i] = x[i] * rs * gain[i];
}

__device__ __forceinline__ float4 ld4f(const float* p) { return *(const float4*)p; }
__device__ __forceinline__ float4 ld4f(const bf16_t* p) { uint2 u = *(const uint2*)p; return make_float4(__uint_as_float(u.x << 16), __uint_as_float(u.x & 0xffff0000u), __uint_as_float(u.y << 16), __uint_as_float(u.y & 0xffff0000u)); }
template <typename AT>
__device__ __forceinline__ void tile_mm(const AT* __restrict__ A, int lda, const float* __restrict__ W, int ldw, int N, int K,
                                        int m0, int n0, float (&acc)[4][4], float (*As)[68], float (*Ws)[68]) {
    int tid = threadIdx.x, ty = tid >> 4, tx = tid & 15;
    for (int k0 = 0; k0 < K; k0 += 16) {
        {
            int r = tid >> 2, kc = (tid & 3) * 4;
            float4 v = ld4f(A + (long)(m0 + r) * lda + k0 + kc);
            As[kc + 0][r] = v.x; As[kc + 1][r] = v.y; As[kc + 2][r] = v.z; As[kc + 3][r] = v.w;
        }
        {
            int kr = tid >> 4, nc = (tid & 15) * 4;
            float4 v = make_float4(0.f, 0.f, 0.f, 0.f);
            if (n0 + nc < N) v = *(const float4*)(W + (long)(k0 + kr) * ldw + n0 + nc);
            *(float4*)&Ws[kr][nc] = v;
        }
        __syncthreads();
#pragma unroll
        for (int k = 0; k < 16; ++k) {
            float4 a = *(const float4*)&As[k][ty * 4];
            float4 b = *(const float4*)&Ws[k][tx * 4];
            float av[4] = {a.x, a.y, a.z, a.w}, bv[4] = {b.x, b.y, b.z, b.w};
#pragma unroll
            for (int i = 0; i < 4; ++i)
#pragma unroll
                for (int j = 0; j < 4; ++j) acc[i][j] += av[i] * bv[j];
        }
        __syncthreads();
    }
}

template <int EPI>
__global__ __launch_bounds__(256) void k_gemm(const float* __restrict__ A, int lda, const float* __restrict__ W, int ldw,
                                              float* C, int ldc, int N, int K, const float* R) {
    __shared__ float As[16][68];
    __shared__ float Ws[16][68];
    int m0 = blockIdx.y * 64, n0 = blockIdx.x * 64;
    float acc[4][4] = {};
    tile_mm(A, lda, W, ldw, N, K, m0, n0, acc, As, Ws);
    int ty = threadIdx.x >> 4, tx = threadIdx.x & 15;
#pragma unroll
    for (int i = 0; i < 4; ++i)
#pragma unroll
        for (int j = 0; j < 4; ++j) {
            int r = m0 + ty * 4 + i, c = n0 + tx * 4 + j;
            if (c < N) {
                float v = acc[i][j];
                if (EPI == 1) v += R[(long)r * ldc + c];
                C[(long)r * ldc + c] = v;
            }
        }
}

__global__ __launch_bounds__(256) void k_merge(const bf16_t* __restrict__ gates, const bf16_t* __restrict__ o, const float* __restrict__ wb, float* __restrict__ merged) {
    __shared__ float As[16][68];
    __shared__ float Ws[16][68];
    int m0 = blockIdx.y * 64, n0 = blockIdx.x * 64;
    float tot[4][4] = {};
    int ty = threadIdx.x >> 4, tx = threadIdx.x & 15;
    for (int i = 0; i < 4; ++i) {
        float ab[4][4] = {};
        tile_mm(o + i * 256, D_, wb + (long)i * 256 * D_, D_, D_, 256, m0, n0, ab, As, Ws);
#pragma unroll
        for (int a = 0; a < 4; ++a)
#pragma unroll
            for (int b = 0; b < 4; ++b) tot[a][b] += ab[a][b] * bf2f(gates[(long)(m0 + ty * 4 + a) * 4096 + i * 1024 + n0 + tx * 4 + b]);
    }
#pragma unroll
    for (int a = 0; a < 4; ++a)
#pragma unroll
        for (int b = 0; b < 4; ++b) merged[(long)(m0 + ty * 4 + a) * D_ + n0 + tx * 4 + b] = tot[a][b];
}

struct RopeP { int off[24]; int nh; };
__global__ void k_rope(float* __restrict__ buf, int ld, RopeP rp, const float* __restrict__ cs, const float* __restrict__ sn) {
    long idx = (long)blockIdx.x * blockDim.x + threadIdx.x;
    long total = (long)T_ * rp.nh * 32;
    if (idx >= total) return;
    int i = idx & 31; long r = idx >> 5; int hh = r % rp.nh; long t = r / rp.nh;
    float c = cs[t * 32 + i], s = sn[t * 32 + i];
    float* p = buf + t * ld + rp.off[hh];
    float x1 = p[i], x2 = p[i + 32];
    p[i] = x1 * c - x2 * s;
    p[i + 32] = x2 * c + x1 * s;
}

__device__ __forceinline__ float gelu_tanh(float x) {
    float u = 0.7978845608028654f * (x + 0.044715f * x * x * x);
    return 0.5f * x * (1.f + tanhf(u));
}
__global__ __launch_bounds__(256) void k_compress(const bf16_t* __restrict__ kcmp, const bf16_t* __restrict__ vcmp, const float* __restrict__ pe_k,
                                                  const float* __restrict__ w1_k, const float* __restrict__ w2_k, const float* __restrict__ pe_v,
                                                  const float* __restrict__ w1_v, const float* __restrict__ w2_v, float* __restrict__ kc, float* __restrict__ vc) {
    __shared__ float zin[2048];
    __shared__ float hid[256];
    int blk = blockIdx.x; int kv = blk / (B_ * NCMP); int rem = blk % (B_ * NCMP); int b = rem / NCMP, c = rem % NCMP;
    const float* pe = kv ? pe_v : pe_k; const float* w1 = kv ? w1_v : w1_k; const float* w2 = kv ? w2_v : w2_k;
    const bf16_t* src = kv ? vcmp : kcmp; float* dst = kv ? vc : kc;
    int tid = threadIdx.x;
    for (int i = tid; i < 2048; i += 256) zin[i] = bf2f(src[((long)b * S_ + 16 * c) * 64 + i]) + pe[i];
    __syncthreads();
    float acc = 0.f;
    for (int i = 0; i < 2048; ++i) acc += zin[i] * w1[(long)i * 256 + tid];
    hid[tid] = gelu_tanh(acc);
    __syncthreads();
    if (tid < 64) {
        float a = 0.f;
        for (int j = 0; j < 256; ++j) a += hid[j] * w2[j * 64 + tid];
        dst[((long)b * NCMP + c) * 64 + tid] = a;
    }
}

__global__ void k_cumsum(const float* __restrict__ logf_, float* __restrict__ cum) {
    int tid = threadIdx.x; if (tid >= 32) return;
    int b = tid >> 2, h = tid & 3;
    float c = 0.f;
    for (int s = 0; s < S_; ++s) { c += logf_[((long)b * S_ + s) * 4 + h]; cum[((long)b * S_ + s) * 4 + h] = c; }
}

__global__ __launch_bounds__(64) void k_nsa_cmp(const bf16_t* __restrict__ qa, const float* __restrict__ ga, const float* __restrict__ kc,
                                                const float* __restrict__ vc, float* __restrict__ pc, float* __restrict__ out) {
    int lane = threadIdx.x, blk = blockIdx.x;
    int tb = blk & 31, h = (blk >> 5) & 3, b = blk >> 7;
    int t = tb * 64 + lane; long row = (long)b * S_ + t;
    float q[64];
#pragma unroll
    for (int d = 0; d < 64; ++d) q[d] = bf2f(qa[row * 256 + h * 64 + d]);
    int nc = (t >= 31) ? ((t - 31) / 16 + 1) : 0; if (nc > NCMP) nc = NCMP;
    int tmax = tb * 64 + 63; int ncw = (tmax >= 31) ? ((tmax - 31) / 16 + 1) : 0; if (ncw > NCMP) ncw = NCMP;
    float m = -1e30f, l = 0.f;
    for (int c = 0; c < ncw; ++c) {
        const float* kr = kc + ((long)b * NCMP + c) * 64;
        float sc = 0.f;
#pragma unroll
        for (int d = 0; d < 64; ++d) sc += q[d] * kr[d];
        if (c < nc) { float mn = fmaxf(m, sc); l = l * exp2f(m - mn) + exp2f(sc - mn); m = mn; }
    }
    float inv = (nc > 0) ? 1.f / l : 0.f;
    float o[64];
#pragma unroll
    for (int d = 0; d < 64; ++d) o[d] = 0.f;
    for (int c = 0; c < 128; ++c) {
        float p = 0.f;
        if (c < ncw) {
            const float* kr = kc + ((long)b * NCMP + c) * 64;
            const float* vr = vc + ((long)b * NCMP + c) * 64;
            float sc = 0.f;
#pragma unroll
            for (int d = 0; d < 64; ++d) sc += q[d] * kr[d];
            if (c < nc) p = exp2f(sc - m) * inv;
#pragma unroll
            for (int d = 0; d < 64; ++d) o[d] += p * vr[d];
        }
        pc[(row * 4 + h) * 128 + c] = p;
    }
    float g = ga[row * 12 + h * 3 + 0];
#pragma unroll
    for (int d = 0; d < 64; ++d) out[row * 256 + h * 64 + d] = g * o[d];
}

__global__ __launch_bounds__(64) void k_nsa_select(const float* __restrict__ pc, unsigned* __restrict__ selmask) {
    __shared__ float imp[64][33];
    int lane = threadIdx.x; long row = (long)blockIdx.x * 64 + lane;
    int t = (int)(row % S_); int cur = t >> 6;
    for (int j = 0; j < 32; ++j) {
        float a = 0.f;
        int c0 = 4 * j - 1; if (c0 < 0) c0 = 0; int c1 = 4 * j + 3; if (c1 > NCMP - 1) c1 = NCMP - 1;
        for (int h = 0; h < 4; ++h)
            for (int c = c0; c <= c1; ++c) a += pc[(row * 4 + h) * 128 + c];
        if (j == 0 || j == cur || j == cur - 1) a = 1e4f;
        if (j > cur) a = -1e4f;
        imp[lane][j] = a;
    }
    unsigned m = 0;
    for (int j = 0; j < 32; ++j) {
        float v = imp[lane][j]; int rank = 0;
        for (int j2 = 0; j2 < 32; ++j2) { float u = imp[lane][j2]; rank += (u > v) || (u == v && j2 < j); }
        if (rank < 16) m |= 1u << j;
    }
    selmask[row] = m;
}

struct AttnP {
    const bf16_t* q; int qoff;
    const void* k; int ldk; int koff;
    const void* v; int ldv; int voff; int nkv;
    int kvdiv;
    float* out; bf16_t* obf; int ooff;
    const float* aux;
    const unsigned* mask;
    const float* gate; int gate_idx;
};
enum { M_SEL = 0, M_WIN = 1, M_FOX = 2, M_DSA = 3, M_SWA = 4 };
template <int MODE, typename KT, int VTL>
__global__ __launch_bounds__(64) void k_attn(AttnP p) {
    int lane = threadIdx.x, blk = blockIdx.x;
    int tb = blk & 31, h = (blk >> 5) & 3, b = blk >> 7;
    int t = tb * 64 + lane; long row = (long)b * S_ + t;
    float q[64], o[64];
#pragma unroll
    for (int d = 0; d < 64; ++d) { q[d] = bf2f(p.q[row * 256 + h * 64 + d]); o[d] = 0.f; }
    float m = -1e30f, l = 0.f;
    int s_lo = 0, s_hi = tb * 64 + 63;
    if (MODE == M_WIN) { s_lo = tb * 64 - 511; if (s_lo < 0) s_lo = 0; }
    if (MODE == M_SWA) { s_lo = tb * 64 - 127; if (s_lo < 0) s_lo = 0; }
    int kvh = h / p.kvdiv;
    unsigned selm = 0, dw = 0;
    if (MODE == M_SEL) selm = p.mask[row];
    const KT* kbase = (const KT*)p.k;
    for (int s = s_lo; s <= s_hi; ++s) {
        const KT* kr = kbase + ((long)b * S_ + s) * p.ldk + p.koff + kvh * 64;
        bool ok = s <= t;
        if (MODE == M_WIN) ok = ok && (s > t - 512);
        if (MODE == M_SWA) ok = ok && (s > t - 128);
        if (MODE == M_SEL) ok = ok && ((selm >> (s >> 6)) & 1u);
        if (MODE == M_DSA) { if ((s & 31) == 0) dw = p.mask[row * 64 + (s >> 5)]; ok = (dw >> (s & 31)) & 1u; }
        float sc = 0.f;
#pragma unroll
        for (int d = 0; d < 64; ++d) sc += q[d] * ldf(kr, d);
        if (MODE == M_FOX) sc -= p.aux[((long)b * S_ + s) * 4 + h] * LOG2E;
        if (ok) {
            float mn = fmaxf(m, sc);
            float a = exp2f(m - mn), pe = exp2f(sc - mn);
            l = l * a + pe;
            if (VTL) {
                const bf16_t* vb = (const bf16_t*)p.v + ((long)(b * p.nkv + kvh) * 64) * S_ + vtpos(s);
#pragma unroll
                for (int d = 0; d < 64; ++d) o[d] = o[d] * a + pe * bf2f(vb[(long)d * S_]);
            } else {
                const KT* vr = (const KT*)p.v + ((long)b * S_ + s) * p.ldv + p.voff + kvh * 64;
#pragma unroll
                for (int d = 0; d < 64; ++d) o[d] = o[d] * a + pe * ldf(vr, d);
            }
            m = mn;
        }
    }
    float scale;
    if (MODE == M_SWA) {
        float sk = p.aux[h] * LOG2E; float mn = fmaxf(m, sk);
        float a = exp2f(m - mn);
        scale = a / (l * a + exp2f(sk - mn));
    } else scale = (l > 0.f) ? 1.f / l : 0.f;
    if (p.gate) {
        float g = p.gate[row * 12 + h * 3 + p.gate_idx];
#pragma unroll
        for (int d = 0; d < 64; ++d) p.out[row * 256 + h * 64 + d] += g * scale * o[d];
    } else {
#pragma unroll
        for (int d = 0; d < 64; ++d) p.obf[row * D_ + p.ooff + h * 64 + d] = f2bf_host_dev(scale * o[d]);
    }
}

__global__ __launch_bounds__(256) void k_dsa_topk(const bf16_t* __restrict__ qi_, const bf16_t* __restrict__ ki_, const float* __restrict__ wi_, unsigned* __restrict__ mask) {
    __shared__ float sc[2048];
    __shared__ float qi[256];
    __shared__ float w[4];
    __shared__ unsigned bits[64];
    int row = blockIdx.x, b = row / S_, t = row % S_, tid = threadIdx.x;
    qi[tid] = bf2f(qi_[(long)row * 256 + tid]);
    if (tid < 4) w[tid] = wi_[(long)row * 4 + tid];
    if (tid < 64) bits[tid] = 0u;
    __syncthreads();
    int n = t + 1;
    for (int s = tid; s < n; s += 256) {
        const bf16_t* ki = ki_ + ((long)b * S_ + s) * 64;
        float acc = 0.f;
        for (int h = 0; h < 4; ++h) {
            float dot = 0.f;
            for (int d = 0; d < 64; ++d) dot += qi[h * 64 + d] * bf2f(ki[d]);
            acc += w[h] * fmaxf(dot, 0.f);
        }
        sc[s] = acc;
    }
    __syncthreads();
    if (n <= 256) {
        if (tid < n) atomicOr(&bits[tid >> 5], 1u << (tid & 31));
    } else {
        float v[8]; int rank[8];
#pragma unroll
        for (int i = 0; i < 8; ++i) { int s = tid + 256 * i; v[i] = (s < n) ? sc[s] : 0.f; rank[i] = 0; }
        for (int s2 = 0; s2 < n; ++s2) {
            float u = sc[s2];
#pragma unroll
            for (int i = 0; i < 8; ++i) { int s = tid + 256 * i; rank[i] += (u > v[i]) || (u == v[i] && s2 < s); }
        }
#pragma unroll
        for (int i = 0; i < 8; ++i) { int s = tid + 256 * i; if (s < n && rank[i] < 256) atomicOr(&bits[s >> 5], 1u << (s & 31)); }
    }
    __syncthreads();
    if (tid < 64) mask[(long)row * 64 + tid] = bits[tid];
}

__global__ void k_route(const float* __restrict__ lg, const float* __restrict__ le, const float* __restrict__ bg, const float* __restrict__ be,
                        int* __restrict__ eid, float* __restrict__ ew) {
    int t = blockIdx.x * blockDim.x + threadIdx.x; if (t >= T_) return;
    float g[8]; float mx = -1e30f; int gi = 0;
#pragma unroll
    for (int i = 0; i < 8; ++i) { g[i] = lg[t * 8 + i] + bg[i]; if (g[i] > mx) { mx = g[i]; gi = i; } }
    float den = 0.f;
#pragma unroll
    for (int i = 0; i < 8; ++i) den += expf(g[i] - mx);
    float pg = 1.f / den;
    float e[8];
#pragma unroll
    for (int i = 0; i < 8; ++i) e[i] = le[t * 64 + gi * 8 + i] + be[gi * 8 + i];
    float v0 = -1e30f; int i0 = 0;
#pragma unroll
    for (int i = 0; i < 8; ++i) if (e[i] > v0) { v0 = e[i]; i0 = i; }
    float v1 = -1e30f; int i1 = 0;
#pragma unroll
    for (int i = 0; i < 8; ++i) if (i != i0 && e[i] > v1) { v1 = e[i]; i1 = i; }
    float x = expf(v1 - v0);
    float w0 = 1.f / (1.f + x), w1 = x / (1.f + x);
    eid[t * 2 + 0] = gi * 8 + i0; eid[t * 2 + 1] = gi * 8 + i1;
    ew[t * 2 + 0] = pg * w0; ew[t * 2 + 1] = pg * w1;
}

__global__ __launch_bounds__(256) void k_moe_hid(const float* __restrict__ xn, const int* __restrict__ eid, const float* __restrict__ wgate,
                                                 const float* __restrict__ wup, float* __restrict__ hid) {
    __shared__ float x[1024];
    int slot = blockIdx.x, t = slot >> 1, tid = threadIdx.x;
    int e = eid[slot];
    for (int i = tid; i < 1024; i += 256) x[i] = xn[(long)t * D_ + i];
    __syncthreads();
    const float* wg = wgate + (long)e * 1024 * 256 + tid;
    const float* wu = wup + (long)e * 1024 * 256 + tid;
    float g = 0.f, u = 0.f;
#pragma unroll 8
    for (int k = 0; k < 1024; ++k) { g += x[k] * wg[(long)k * 256]; u += x[k] * wu[(long)k * 256]; }
    hid[(long)slot * 256 + tid] = (g / (1.f + __expf(-g))) * u;
}

__global__ __launch_bounds__(256) void k_moe_down(const float* __restrict__ hid, const int* __restrict__ eid, const float* __restrict__ ew,
                                                  const float* __restrict__ wdown, float* __restrict__ h) {
    __shared__ float hh[512];
    int t = blockIdx.x, tid = threadIdx.x;
    hh[tid] = hid[(long)t * 512 + tid]; hh[tid + 256] = hid[(long)t * 512 + 256 + tid];
    __syncthreads();
    float4 tot = make_float4(0.f, 0.f, 0.f, 0.f);
    for (int k = 0; k < 2; ++k) {
        int e = eid[t * 2 + k]; float w = ew[t * 2 + k];
        const float* wd = wdown + (long)e * 256 * 1024 + tid * 4;
        float4 a = make_float4(0.f, 0.f, 0.f, 0.f);
#pragma unroll 8
        for (int i = 0; i < 256; ++i) {
            float4 wv = *(const float4*)(wd + (long)i * 1024); float x = hh[k * 256 + i];
            a.x += x * wv.x; a.y += x * wv.y; a.z += x * wv.z; a.w += x * wv.w;
        }
        tot.x += w * a.x; tot.y += w * a.y; tot.z += w * a.z; tot.w += w * a.w;
    }
    float4* hp = (float4*)(h + (long)t * D_ + tid * 4);
    float4 hv = *hp; hv.x += tot.x; hv.y += tot.y; hv.z += tot.z; hv.w += tot.w; *hp = hv;
}

#define XB_TMO 128
#define XB_XCNT(j) (256 + 64 * (j))
#define XB_XSUB(j) (1280 + 64 * (j))
#define XB_XGEN(j) (2304 + 64 * (j))
#define XB_TOP 3328
#define XB_TOPGEN 3392
#define XCD_BAR_WORDS 3456
#define XB_SPIN_CAP (1u << 18)
#define LAS __attribute__((address_space(3)))
__device__ __forceinline__ unsigned xb_ld(unsigned* p) { return __hip_atomic_load(p, __ATOMIC_RELAXED, __HIP_MEMORY_SCOPE_AGENT); }
__device__ __forceinline__ unsigned xb_add(unsigned* p, unsigned v) { return __hip_atomic_fetch_add(p, v, __ATOMIC_RELAXED, __HIP_MEMORY_SCOPE_AGENT); }
__device__ __forceinline__ unsigned xb_xcc_id() { return (unsigned)__builtin_amdgcn_s_getreg((3 << 11) | 20) & 0xFu; }
#define XB_SPIN(cond, bar) do { unsigned _sp = 0; while (cond) { __builtin_amdgcn_s_sleep(1); \
    if ((++_sp & 255u) == 0u) { if (xb_ld(&(bar)[XB_TMO])) break; if (_sp > XB_SPIN_CAP) { atomicAdd(&(bar)[XB_TMO], 1u); break; } } } } while (0)
struct XcdBarrier { unsigned* bar; unsigned x; volatile LAS unsigned* st; };
__device__ __forceinline__ XcdBarrier xcd_barrier_post(unsigned* bar, volatile LAS unsigned* st) {
    XcdBarrier b; b.bar = bar; b.x = xb_xcc_id(); b.st = st;
    if (threadIdx.x == 0) (void)xb_add(&bar[XB_XCNT(b.x)], 1u);
    return b;
}
__device__ __forceinline__ void xcd_barrier_complete(unsigned* bar, unsigned x, unsigned& nloc, unsigned& nx) {
    const unsigned G = gridDim.x * gridDim.y * gridDim.z;
    unsigned sum, cnt, mine, sp = 0u;
    for (;;) {
        sum = 0u; cnt = 0u; mine = 0u;
#pragma unroll
        for (unsigned j = 0; j < 16; ++j) { const unsigned c = xb_ld(&bar[XB_XCNT(j)]); sum += c; cnt += (c > 0u) ? 1u : 0u; mine = (j == x) ? c : mine; }
        if (sum == G) break;
        __builtin_amdgcn_s_sleep(1);
        if ((++sp & 255u) == 0u) { if (xb_ld(&bar[XB_TMO])) break; if (sp > XB_SPIN_CAP) { atomicAdd(&bar[XB_TMO], 1u); break; } }
    }
    nloc = mine > 0u ? mine : 1u; nx = cnt > 0u ? cnt : 1u;
}
__device__ __forceinline__ void xcd_barrier(const XcdBarrier& b) {
    asm volatile("s_waitcnt vmcnt(0)" ::: "memory");
    __syncthreads();
    if (threadIdx.x == 0) {
        unsigned* bar = b.bar;
        __builtin_amdgcn_s_waitcnt(0);
        unsigned nloc = b.st[0], nx = b.st[1];
        if (nloc == 0u) { xcd_barrier_complete(bar, b.x, nloc, nx); b.st[0] = nloc; b.st[1] = nx; }
        const unsigned old = xb_add(&bar[XB_XSUB(b.x)], 1u);
        const unsigned gen = old / nloc;
        if (old + 1u == (gen + 1u) * nloc) {
            __builtin_amdgcn_fence(__ATOMIC_RELEASE, "agent");
            asm volatile("s_waitcnt vmcnt(0)" ::: "memory");
            const unsigned og = xb_add(&bar[XB_TOP], 1u);
            const unsigned tg = og / nx;
            if (og + 1u == (tg + 1u) * nx) xb_add(&bar[XB_TOPGEN], 1u);
            else XB_SPIN(xb_ld(&bar[XB_TOPGEN]) == tg, bar);
            __builtin_amdgcn_fence(__ATOMIC_ACQUIRE, "agent");
            xb_add(&bar[XB_XGEN(b.x)], 1u);
            asm volatile("s_waitcnt vmcnt(0)" ::: "memory");
        } else {
            XB_SPIN(xb_ld(&bar[XB_XGEN(b.x)]) == gen, bar);
            __builtin_amdgcn_fence(__ATOMIC_ACQUIRE, "agent");
            asm volatile("s_waitcnt vmcnt(0)" ::: "memory");
        }
    }
    __syncthreads();
}

__global__ __launch_bounds__(256) void k_final(const float* __restrict__ h, const float* __restrict__ gain, float* __restrict__ tmp,
                                               float* __restrict__ out, unsigned* bar) {
    __shared__ uint4 xbw;
    __shared__ float red[4];
    cg::grid_group grid = cg::this_grid();
    int tid = threadIdx.x;
    if (tid == 0) xbw = make_uint4(0u, 0u, 0u, 0u);
    __syncthreads();
    XcdBarrier xb = xcd_barrier_post(bar, (volatile LAS unsigned*)&xbw);
    for (int row = blockIdx.x; row < T_; row += gridDim.x) {
        const float* x = h + (long)row * D_;
        float4 v = *(const float4*)(x + tid * 4);
        float ss = v.x * v.x + v.y * v.y + v.z * v.z + v.w * v.w;
        for (int o = 32; o > 0; o >>= 1) ss += __shfl_xor(ss, o);
        __syncthreads();
        if ((tid & 63) == 0) red[tid >> 6] = ss;
        __syncthreads();
        float rs = rsqrtf((red[0] + red[1] + red[2] + red[3]) / (float)D_ + 1e-6f);
        float4 g = *(const float4*)(gain + tid * 4);
        *(float4*)(tmp + (long)row * D_ + tid * 4) = make_float4(v.x * rs * g.x, v.y * rs * g.y, v.z * rs * g.z, v.w * rs * g.w);
    }
    xcd_barrier(xb);
    int shift = (blockIdx.x + gridDim.x / 2 + 3) % gridDim.x;
    for (int row = shift; row < T_; row += gridDim.x)
        *(float4*)(out + (long)row * D_ + tid * 4) = *(const float4*)(tmp + (long)row * D_ + tid * 4);
    grid.sync();
}


typedef short bf16x8 __attribute__((ext_vector_type(8)));
typedef float f32x16 __attribute__((ext_vector_type(16)));
typedef float f32x4 __attribute__((ext_vector_type(4)));
typedef unsigned u32x4 __attribute__((ext_vector_type(4)));
typedef unsigned u32x2 __attribute__((ext_vector_type(2)));
#define MFMA32(a, b, c) __builtin_amdgcn_mfma_f32_32x32x16_bf16(a, b, c, 0, 0, 0)
__device__ __forceinline__ unsigned cvtpk(float lo, float hi) { unsigned r; asm("v_cvt_pk_bf16_f32 %0, %1, %2" : "=v"(r) : "v"(lo), "v"(hi)); return r; }
__device__ __forceinline__ bf16_t f2bf(float x) { return (bf16_t)(cvtpk(x, x) & 0xffffu); }
__device__ __forceinline__ int crow(int r, int hi) { return (r & 3) + 8 * (r >> 2) + 4 * hi; }
__device__ __forceinline__ float sigmoidf_(float x) { return 1.f / (1.f + __expf(-x)); }

#define NG_IN 106
#define NCAT (NG_IN * 64)
#define QSCALE 0.18033688011112042f

struct Params {
    const float* x; const int* positions; const float* attn_norm; const float* w_in;
    const float* nsa_pe_k; const float* nsa_w1_k; const float* nsa_w2_k; const float* nsa_pe_v; const float* nsa_w1_v; const float* nsa_w2_v;
    const float* fox_bias; const float* dsa_kv_norm; const float* dsa_w_ukv; const float* swa_sinks; const float* w_branch; const float* w_gate;
    const float* w_out; const float* ffn_norm; const float* moe_w_group; const float* moe_b_group; const float* moe_w_expert; const float* moe_b_expert;
    const float* moe_w_gate; const float* moe_w_up; const float* moe_w_down; const float* final_norm;
    float* out;
    unsigned* bar;
    float* cs; float* sn;
    bf16_t* Wcat;
    bf16_t* Wukv;
    bf16_t* W1t;
    bf16_t* W2t;
    float* peb;
    bf16_t* Wbt;
    bf16_t* Wot;
    float* Wrt;
    float* h;
    bf16_t* hn;
    bf16_t* qa; bf16_t* kcmp; bf16_t* vcmp; bf16_t* ksel; bf16_t* vselT; bf16_t* kwin; bf16_t* vwinT;
    bf16_t* qb; bf16_t* kb; bf16_t* vbT; bf16_t* qc; bf16_t* ckv; bf16_t* qi; bf16_t* ki; bf16_t* qd; bf16_t* kd; bf16_t* vdT;
    float* ga; float* logf; float* wi;
    bf16_t* gates;
    bf16_t* kcc; bf16_t* vcT;
    bf16_t* o;
    float* kbias;
    float* ocmp; float* owin;
    unsigned* selmask; unsigned* dmask;
    float* sc;
    bf16_t* kcb; bf16_t* vcbT;
    bf16_t* merged;
    unsigned* ecnt; int* elist; float* slotw;
    bf16_t* hid; bf16_t* y;
};

#define TSTR 144
enum { BMODE_BF16_NK = 0, BMODE_F32_KN = 1 };

struct NoHook { __device__ __forceinline__ void operator()(int) const {} };
template <int BM, int BN, int BMODE, class AROW, class BSRC, class HOOK = NoHook>
__device__ __forceinline__ void gemm_core(f32x16 (&acc)[2][2], AROW arow, BSRC bsrc, int K, char* lds, HOOK hook = HOOK()) {
    constexpr int WM = BM / 64;
    constexpr int NA = BM / 32, NB = BN / 32;
    const int tid = threadIdx.x, lane = tid & 63, w = tid >> 6, r32 = lane & 31, hi = lane >> 5;
    const int wm = w % WM, wn = w / WM;
    char* ldsA = lds; char* ldsB = lds + BM * TSTR;
    const bf16_t* ap[NA];
#pragma unroll
    for (int i = 0; i < NA; ++i) ap[i] = arow((tid >> 3) + 32 * i) + (tid & 7) * 8;
    const bf16_t* bp[NB];
    if constexpr (BMODE == BMODE_BF16_NK) {
#pragma unroll
        for (int i = 0; i < NB; ++i) bp[i] = (const bf16_t*)bsrc((tid >> 3) + 32 * i) + (tid & 7) * 8;
    }
    u32x4 ra[NA]; u32x4 rb[NB]; f32x4 rf[8];
    const int kg = tid >> 5, ng = tid & 31;
    const float* bfp = nullptr; int bld = 0;
    if constexpr (BMODE == BMODE_F32_KN) { bfp = (const float*)bsrc(ng * 4, bld); }
    auto load_regs = [&](int k0) {
#pragma unroll
        for (int i = 0; i < NA; ++i) ra[i] = *(const u32x4*)(ap[i] + k0);
        if (BMODE == BMODE_BF16_NK) {
#pragma unroll
            for (int i = 0; i < NB; ++i) rb[i] = *(const u32x4*)(bp[i] + k0);
        } else {
#pragma unroll
            for (int j = 0; j < 8; ++j) rf[j] = *(const f32x4*)(bfp + (long)(k0 + kg * 8 + j) * bld);
        }
    };
    auto store_lds = [&]() {
#pragma unroll
        for (int i = 0; i < NA; ++i) *(u32x4*)(ldsA + ((tid >> 3) + 32 * i) * TSTR + (tid & 7) * 16) = ra[i];
        if (BMODE == BMODE_BF16_NK) {
#pragma unroll
            for (int i = 0; i < NB; ++i) *(u32x4*)(ldsB + ((tid >> 3) + 32 * i) * TSTR + (tid & 7) * 16) = rb[i];
        } else {
#pragma unroll
            for (int i = 0; i < 4; ++i) {
                u32x4 v;
                v.x = cvtpk(rf[0][i], rf[1][i]); v.y = cvtpk(rf[2][i], rf[3][i]); v.z = cvtpk(rf[4][i], rf[5][i]); v.w = cvtpk(rf[6][i], rf[7][i]);
                *(u32x4*)(ldsB + (ng * 4 + i) * TSTR + kg * 16) = v;
            }
        }
    };
    const int nk = K / 64;
    load_regs(0);
    for (int kt = 0; kt < nk; ++kt) {
        __syncthreads();
        store_lds();
        __syncthreads();
        if (kt + 1 < nk) load_regs((kt + 1) * 64);
#pragma unroll
        for (int ks = 0; ks < 4; ++ks) {
            bf16x8 bf[2], af[2];
#pragma unroll
            for (int ni = 0; ni < 2; ++ni) bf[ni] = *(const bf16x8*)(ldsB + (wn * 64 + ni * 32 + r32) * TSTR + ks * 32 + hi * 16);
#pragma unroll
            for (int mi = 0; mi < 2; ++mi) af[mi] = *(const bf16x8*)(ldsA + (wm * 64 + mi * 32 + r32) * TSTR + ks * 32 + hi * 16);
#pragma unroll
            for (int ni = 0; ni < 2; ++ni)
#pragma unroll
                for (int mi = 0; mi < 2; ++mi) acc[ni][mi] = MFMA32(bf[ni], af[mi], acc[ni][mi]);
        }
        hook(kt);
    }
}

__device__ __forceinline__ void tconv_tile(const float* __restrict__ src, int lds_, bf16_t* __restrict__ dst, int ldd, const float* kscale, bool zero, char* lds) {
    float (*tile)[65] = (float (*)[65])lds;
    const int tid = threadIdx.x;
    __syncthreads();
#pragma unroll
    for (int i = 0; i < 16; ++i) {
        int kk = i * 4 + (tid >> 6), nn = tid & 63;
        float v = zero ? 0.f : src[(long)kk * lds_ + nn];
        if (kscale) v *= kscale[kk];
        tile[kk][nn] = v;
    }
    __syncthreads();
#pragma unroll
    for (int i = 0; i < 2; ++i) {
        int c = tid + 256 * i; int nn = c >> 3, kc = (c & 7) * 8;
        u32x4 v;
        v.x = cvtpk(tile[kc + 0][nn], tile[kc + 1][nn]); v.y = cvtpk(tile[kc + 2][nn], tile[kc + 3][nn]);
        v.z = cvtpk(tile[kc + 4][nn], tile[kc + 5][nn]); v.w = cvtpk(tile[kc + 6][nn], tile[kc + 7][nn]);
        *(u32x4*)(dst + (long)nn * ldd + kc) = v;
    }
}
__device__ __forceinline__ int in_group_src(int g) {
    if (g < 10) return g * 64;
    if (g < 22) return O_QB + (g - 10) * 64;
    if (g < 33) return O_QC + (g - 22) * 64;
    return O_QD + (g - 33) * 64;
}
__device__ void phase_prep(const Params& p, int bid, int nblk, char* lds) {
    const int tid = threadIdx.x;
    if (bid == 0 && tid < 128) p.ecnt[tid] = 0u;
    for (int idx = bid * 256 + tid; idx < T_ * 32; idx += nblk * 256) {
        int i = idx & 31, t = idx >> 5;
        float inv = powf(10000.f, -(float)i / 32.f);
        float ang = (float)p.positions[t] * inv;
        double a = (double)ang; double n = rint(a * 0.15915494309189535); float rf = (float)(a - n * 6.283185307179586);
        p.cs[idx] = cosf(rf); p.sn[idx] = sinf(rf);
    }
    const int J_CAT = 2 * NG_IN * 16;
    const int J_UKV = 2 * 8 * 2;
    const int J_W1 = 2 * 2 * 4 * 32;
    const int J_W2 = 2 * 2 * 1 * 4;
    const int J_WB = 2 * 4 * 16 * 4;
    const int J_WO = 2 * 16 * 16;
    const int total = J_CAT + J_UKV + J_W1 + J_W2 + J_WB + J_WO;
    for (int j = bid; j < total; j += nblk) {
        int q = j;
        if (q < J_CAT) {
            int kt = q & 15; int g = (q >> 4) % NG_IN; int l = (q >> 4) / NG_IN;
            bf16_t* dst = p.Wcat + ((long)l * NCAT + g * 64) * 1024 + kt * 64;
            if (g < 41) tconv_tile(p.w_in + (long)l * D_ * DIN + (long)kt * 64 * DIN + in_group_src(g), DIN, dst, 1024, nullptr, false, lds);
            else if (g == 41) {
                __syncthreads();
                float (*tile)[65] = (float (*)[65])lds;
                const float* src = p.w_in + (long)l * D_ * DIN + (long)kt * 64 * DIN;
#pragma unroll
                for (int i = 0; i < 16; ++i) {
                    int kk = i * 4 + (tid >> 6), nn = tid & 63;
                    float v = 0.f;
                    if (nn < 12) v = src[(long)kk * DIN + O_GA + nn];
                    else if (nn < 16) v = src[(long)kk * DIN + O_FB + nn - 12];
                    else if (nn < 20) v = src[(long)kk * DIN + O_WI + nn - 16];
                    tile[kk][nn] = v;
                }
                __syncthreads();
#pragma unroll
                for (int i = 0; i < 2; ++i) {
                    int c = tid + 256 * i; int nn = c >> 3, kc = (c & 7) * 8;
                    u32x4 v;
                    v.x = cvtpk(tile[kc + 0][nn], tile[kc + 1][nn]); v.y = cvtpk(tile[kc + 2][nn], tile[kc + 3][nn]);
                    v.z = cvtpk(tile[kc + 4][nn], tile[kc + 5][nn]); v.w = cvtpk(tile[kc + 6][nn], tile[kc + 7][nn]);
                    *(u32x4*)(dst + (long)nn * 1024 + kc) = v;
                }
            } else {
                int gg = g - 42; int i = gg >> 4, nt = gg & 15;
                tconv_tile(p.w_gate + ((long)(l * 4 + i) * D_ + kt * 64) * D_ + nt * 64, D_, dst, 1024, nullptr, false, lds);
            }
            continue;
        }
        q -= J_CAT;
        if (q < J_UKV) {
            int kt = q & 1, nt = (q >> 1) & 7, l = q >> 4;
            tconv_tile(p.dsa_w_ukv + (long)l * 128 * 512 + (long)kt * 64 * 512 + nt * 64, 512, p.Wukv + ((long)l * 512 + nt * 64) * 128 + kt * 64, 128,
                       p.dsa_kv_norm + l * 128 + kt * 64, false, lds);
            continue;
        }
        q -= J_UKV;
        if (q < J_W1) {
            int kt = q & 31, nt = (q >> 5) & 3, kv = (q >> 7) & 1, l = q >> 8;
            const float* src = (kv ? p.nsa_w1_v : p.nsa_w1_k) + (long)l * 2048 * 256 + (long)kt * 64 * 256 + nt * 64;
            tconv_tile(src, 256, p.W1t + ((long)(l * 2 + kv) * 256 + nt * 64) * 2048 + kt * 64, 2048, nullptr, false, lds);
            continue;
        }
        q -= J_W1;
        if (q < J_W2) {
            int kt = q & 3, kv = (q >> 2) & 1, l = q >> 3;
            const float* src = (kv ? p.nsa_w2_v : p.nsa_w2_k) + (long)l * 256 * 64 + (long)kt * 64 * 64;
            tconv_tile(src, 64, p.W2t + ((long)(l * 2 + kv) * 64) * 256 + kt * 64, 256, nullptr, false, lds);
            continue;
        }
        q -= J_W2;
        if (q < J_WB) {
            int kt = q & 3, nt = (q >> 2) & 15, i = (q >> 6) & 3, l = q >> 8;
            tconv_tile(p.w_branch + ((long)(l * 4 + i) * 256 + kt * 64) * D_ + nt * 64, D_, p.Wbt + ((long)l * 1024 + nt * 64) * 1024 + i * 256 + kt * 64, 1024,
                       nullptr, false, lds);
            continue;
        }
        q -= J_WB;
        {
            int kt = q & 15, nt = (q >> 4) & 15, l = q >> 8;
            tconv_tile(p.w_out + ((long)l * D_ + kt * 64) * D_ + nt * 64, D_, p.Wot + ((long)l * 1024 + nt * 64) * 1024 + kt * 64, 1024, nullptr, false, lds);
        }
    }
    for (int idx = bid * 256 + tid; idx < 2 * 2 * 256; idx += nblk * 256) {
        int jn = idx & 255, kv = (idx >> 8) & 1, l = idx >> 9;
        const float* pe = (kv ? p.nsa_pe_v : p.nsa_pe_k) + l * 2048;
        const float* w1 = (kv ? p.nsa_w1_v : p.nsa_w1_k) + (long)l * 2048 * 256 + jn;
        float a = 0.f;
        for (int i = 0; i < 2048; ++i) a += pe[i] * w1[(long)i * 256];
        p.peb[idx] = a;
    }
    for (int idx = bid * 256 + tid; idx < 2 * 80 * 1024; idx += nblk * 256) {
        int k = idx & 1023, jn = (idx >> 10) % 80, l = idx / (80 * 1024);
        float v = 0.f;
        if (jn < 8) v = p.moe_w_group[((long)l * D_ + k) * 8 + jn];
        else if (jn < 72) v = p.moe_w_expert[((long)l * D_ + k) * 64 + jn - 8];
        p.Wrt[idx] = v * p.ffn_norm[l * D_ + k];
    }
}

__device__ void phase_norm(const Params& p, int l, int bid, int nblk) {
    const int tid = threadIdx.x, lane = tid & 63, w = tid >> 6;
    for (int row = bid * 4 + w; row < T_; row += nblk * 4) {
        const float* x = (l == 0 ? p.x : (const float*)p.h) + (long)row * D_;
        f32x4 v[4]; float ss = 0.f;
#pragma unroll
        for (int i = 0; i < 4; ++i) { v[i] = *(const f32x4*)(x + i * 256 + lane * 4); ss += v[i][0] * v[i][0] + v[i][1] * v[i][1] + v[i][2] * v[i][2] + v[i][3] * v[i][3]; }
        for (int o = 32; o > 0; o >>= 1) ss += __shfl_xor(ss, o);
        float rs = rsqrtf(ss / (float)D_ + 1e-6f);
#pragma unroll
        for (int i = 0; i < 4; ++i) {
            f32x4 g = *(const f32x4*)(p.attn_norm + l * D_ + i * 256 + lane * 4);
            if (l == 0) *(f32x4*)(p.h + (long)row * D_ + i * 256 + lane * 4) = v[i];
            u32x2 o2; o2.x = cvtpk(v[i][0] * rs * g[0], v[i][1] * rs * g[1]); o2.y = cvtpk(v[i][2] * rs * g[2], v[i][3] * rs * g[3]);
            *(u32x2*)(p.hn + (long)row * D_ + i * 256 + lane * 4) = o2;
        }
    }
}

__device__ __forceinline__ void st4(bf16_t* dst, float a, float b, float c, float d) { u32x2 v; v.x = cvtpk(a, b); v.y = cvtpk(c, d); *(u32x2*)dst = v; }

__device__ __forceinline__ void epi_tok(const f32x16 (&acc)[2][2], int m_base, int kind, float scale, bf16_t* dst, int ld, int col0, const float* cs, const float* sn) {
    const int lane = threadIdx.x & 63, r32 = lane & 31, hi = lane >> 5;
#pragma unroll
    for (int mi = 0; mi < 2; ++mi) {
        const long m = m_base + mi * 32 + r32;
#pragma unroll
        for (int rg = 0; rg < 4; ++rg) {
            float x1[4], x2[4];
#pragma unroll
            for (int j = 0; j < 4; ++j) { x1[j] = acc[0][mi][rg * 4 + j]; x2[j] = acc[1][mi][rg * 4 + j]; }
            const int i0 = 8 * rg + 4 * hi;
            if (kind == 1) {
                f32x4 c = *(const f32x4*)(cs + m * 32 + i0), s = *(const f32x4*)(sn + m * 32 + i0);
#pragma unroll
                for (int j = 0; j < 4; ++j) { float a = x1[j] * c[j] - x2[j] * s[j]; float b = x2[j] * c[j] + x1[j] * s[j]; x1[j] = a; x2[j] = b; }
            }
            st4(dst + m * ld + col0 + i0, x1[0] * scale, x1[1] * scale, x1[2] * scale, x1[3] * scale);
            st4(dst + m * ld + col0 + 32 + i0, x2[0] * scale, x2[1] * scale, x2[2] * scale, x2[3] * scale);
        }
    }
}
__device__ __forceinline__ void epi_vt(const f32x16 (&acc)[2][2], int m_base, bf16_t* dst, int nh, int hh) {
    const int lane = threadIdx.x & 63, r32 = lane & 31, hi = lane >> 5;
#pragma unroll
    for (int mi = 0; mi < 2; ++mi) {
        const int m = m_base + mi * 32 + r32; const int b = m / S_, t = m % S_;
        bf16_t* base = dst + ((long)(b * nh + hh) * 64) * S_ + vtpos(t);
#pragma unroll
        for (int ni = 0; ni < 2; ++ni)
#pragma unroll
            for (int r = 0; r < 16; ++r) base[(long)(ni * 32 + crow(r, hi)) * S_] = f2bf(acc[ni][mi][r]);
    }
}

__device__ void phase_inproj(const Params& p, int l, int bid, int nblk, char* lds) {
    const int tid = threadIdx.x, lane = tid & 63, w = tid >> 6, r32 = lane & 31, hi = lane >> 5;
    const int wm = w & 1, wn = w >> 1;
    const bf16_t* Wc = p.Wcat + (long)l * NCAT * 1024;
    const int NT_N = NCAT / 128, NT_M = T_ / 128;
    for (int tile = bid; tile < NT_N * NT_M; tile += nblk) {
        const int tn = tile / NT_M, tm = tile % NT_M;
        const int m0 = tm * 128, n0 = tn * 128;
        f32x16 acc[2][2];
#pragma unroll
        for (int a = 0; a < 2; ++a)
#pragma unroll
            for (int b = 0; b < 2; ++b)
#pragma unroll
                for (int r = 0; r < 16; ++r) acc[a][b][r] = 0.f;
        const bf16_t* A = p.hn + (long)m0 * D_;
        const bf16_t* Bt = Wc + (long)n0 * 1024;
        gemm_core<128, 128, BMODE_BF16_NK>(acc, [&](int r) { return A + (long)r * D_; }, [&](int r) { return Bt + (long)r * 1024; }, D_, lds);
        const int g = tn * 2 + wn;
        const int mb = m0 + wm * 64;
        if (g < 4) epi_tok(acc, mb, 1, QSCALE, p.qa, 256, g * 64, p.cs, p.sn);
        else if (g == 4) epi_tok(acc, mb, 1, 1.f, p.kcmp, 64, 0, p.cs, p.sn);
        else if (g == 5) epi_tok(acc, mb, 0, 1.f, p.vcmp, 64, 0, p.cs, p.sn);
        else if (g == 6) epi_tok(acc, mb, 1, 1.f, p.ksel, 64, 0, p.cs, p.sn);
        else if (g == 7) epi_vt(acc, mb, p.vselT, 1, 0);
        else if (g == 8) epi_tok(acc, mb, 1, 1.f, p.kwin, 64, 0, p.cs, p.sn);
        else if (g == 9) epi_vt(acc, mb, p.vwinT, 1, 0);
        else if (g < 14) epi_tok(acc, mb, 0, QSCALE, p.qb, 256, (g - 10) * 64, p.cs, p.sn);
        else if (g < 18) epi_tok(acc, mb, 0, 1.f, p.kb, 256, (g - 14) * 64, p.cs, p.sn);
        else if (g < 22) epi_vt(acc, mb, p.vbT, 4, g - 18);
        else if (g < 26) epi_tok(acc, mb, 1, QSCALE, p.qc, 256, (g - 22) * 64, p.cs, p.sn);
        else if (g < 28) epi_tok(acc, mb, 0, 1.f, p.ckv, 128, (g - 26) * 64, p.cs, p.sn);
        else if (g < 32) epi_tok(acc, mb, 1, 1.f, p.qi, 256, (g - 28) * 64, p.cs, p.sn);
        else if (g == 32) epi_tok(acc, mb, 1, 1.f, p.ki, 64, 0, p.cs, p.sn);
        else if (g < 37) epi_tok(acc, mb, 1, QSCALE, p.qd, 256, (g - 33) * 64, p.cs, p.sn);
        else if (g < 39) epi_tok(acc, mb, 1, 1.f, p.kd, 128, (g - 37) * 64, p.cs, p.sn);
        else if (g < 41) epi_vt(acc, mb, p.vdT, 2, g - 39);
        else if (g == 41) {
#pragma unroll
            for (int mi = 0; mi < 2; ++mi) {
                const long m = mb + mi * 32 + r32;
#pragma unroll
                for (int r = 0; r < 16; ++r) {
                    const int c = crow(r, hi); const float v = acc[0][mi][r];
                    if (c < 12) p.ga[m * 12 + c] = sigmoidf_(v);
                    else if (c < 16) { float xx = v + p.fox_bias[l * 4 + c - 12]; p.logf[m * 4 + c - 12] = fminf(xx, 0.f) - log1pf(__expf(-fabsf(xx))); }
                    else if (c < 20) p.wi[m * 4 + c - 16] = v * 0.0625f;
                }
            }
        } else {
            const int col0 = (g - 42) * 64;
#pragma unroll
            for (int mi = 0; mi < 2; ++mi) {
                const long m = mb + mi * 32 + r32;
#pragma unroll
                for (int ni = 0; ni < 2; ++ni)
#pragma unroll
                    for (int rg = 0; rg < 4; ++rg)
                        st4(p.gates + m * 4096 + col0 + ni * 32 + 8 * rg + 4 * hi, sigmoidf_(acc[ni][mi][rg * 4 + 0]), sigmoidf_(acc[ni][mi][rg * 4 + 1]),
                            sigmoidf_(acc[ni][mi][rg * 4 + 2]), sigmoidf_(acc[ni][mi][rg * 4 + 3]));
            }
        }
    }
}

enum { A_FOX = 0, A_DSA = 1, A_SEL = 2, A_WIN = 3, A_SWA = 4, A_CMP = 5 };
struct AttnDesc {
    const bf16_t* q;
    const bf16_t* k; int ldk;
    const bf16_t* vt; int ldvt;
    int kt_lo, kt_hi;
    int wkt_lo, wkt_hi;
    int tq;
    unsigned tilemask;
    unsigned selm;
    const unsigned* dmask;
    const float* kbias;
    int window;
};
__device__ __forceinline__ float hswap_max(float v) { auto rr = __builtin_amdgcn_permlane32_swap(__float_as_uint(v), __float_as_uint(v), false, false); return fmaxf(__uint_as_float(rr[0]), __uint_as_float(rr[1])); }
__device__ __forceinline__ float hswap_sum(float v) { auto rr = __builtin_amdgcn_permlane32_swap(__float_as_uint(v), __float_as_uint(v), false, false); return __uint_as_float(rr[0]) + __uint_as_float(rr[1]); }

template <int MODE>
__device__ __forceinline__ void attn_core(const AttnDesc& u, f32x16 (&o)[2], float& m_out, float& l_out, char* lds) {
    const int tid = threadIdx.x, lane = tid & 63, r32 = lane & 31, hi = lane >> 5;
    char* ldsK = lds; char* ldsV = lds + 64 * TSTR; float* ldsB = (float*)(lds + 2 * 64 * TSTR);
    bf16x8 qf[4];
#pragma unroll
    for (int ds = 0; ds < 4; ++ds) qf[ds] = *(const bf16x8*)(u.q + ds * 16 + hi * 8);
#pragma unroll
    for (int r = 0; r < 16; ++r) { o[0][r] = 0.f; o[1][r] = 0.f; }
    float m = -1e30f, l = 0.f;
    const int lrow = tid >> 3, lch = tid & 7;
    u32x4 rk[2], rv[2]; float rbias = 0.f; u32x2 dm_next = {0u, 0u};
    auto skip_tile = [&](int kt) -> bool { return (MODE == A_SEL) && !((u.tilemask >> kt) & 1u); };
    auto load_regs = [&](int kt) {
#pragma unroll
        for (int i = 0; i < 2; ++i) {
            rk[i] = *(const u32x4*)(u.k + (long)(kt * 64 + lrow + 32 * i) * u.ldk + lch * 8);
            rv[i] = *(const u32x4*)(u.vt + (long)(lrow + 32 * i) * u.ldvt + kt * 64 + lch * 8);
        }
        if (MODE == A_FOX) { if (tid < 64) rbias = u.kbias[kt * 64 + tid]; }
        if (MODE == A_DSA) dm_next = *(const u32x2*)(u.dmask + kt * 2);
    };
    int kt = u.kt_lo;
    while (kt <= u.kt_hi && skip_tile(kt)) ++kt;
    if (kt <= u.kt_hi) load_regs(kt);
    while (kt <= u.kt_hi) {
        __syncthreads();
#pragma unroll
        for (int i = 0; i < 2; ++i) {
            *(u32x4*)(ldsK + (lrow + 32 * i) * TSTR + lch * 16) = rk[i];
            *(u32x4*)(ldsV + (lrow + 32 * i) * TSTR + lch * 16) = rv[i];
        }
        if (MODE == A_FOX) { if (tid < 64) ldsB[tid] = rbias; }
        u32x2 dm = dm_next;
        __syncthreads();
        int ktn = kt + 1;
        while (ktn <= u.kt_hi && skip_tile(ktn)) ++ktn;
        if (ktn <= u.kt_hi) load_regs(ktn);
        if (kt >= u.wkt_lo && kt <= u.wkt_hi) {
            f32x16 p[2];
            if (MODE == A_FOX) {
#pragma unroll
                for (int sub = 0; sub < 2; ++sub)
#pragma unroll
                    for (int rg = 0; rg < 4; ++rg) {
                        f32x4 bv = *(const f32x4*)(ldsB + 32 * sub + 8 * rg + 4 * hi);
                        p[sub][rg * 4 + 0] = bv[0]; p[sub][rg * 4 + 1] = bv[1]; p[sub][rg * 4 + 2] = bv[2]; p[sub][rg * 4 + 3] = bv[3];
                    }
            } else {
#pragma unroll
                for (int r = 0; r < 16; ++r) { p[0][r] = 0.f; p[1][r] = 0.f; }
            }
#pragma unroll
            for (int ds = 0; ds < 4; ++ds) {
                bf16x8 k0 = *(const bf16x8*)(ldsK + r32 * TSTR + ds * 32 + hi * 16);
                bf16x8 k1 = *(const bf16x8*)(ldsK + (32 + r32) * TSTR + ds * 32 + hi * 16);
                p[0] = MFMA32(k0, qf[ds], p[0]);
                p[1] = MFMA32(k1, qf[ds], p[1]);
            }
            const int key0 = kt * 64 + 4 * hi;
            if (MODE == A_FOX || MODE == A_SEL || MODE == A_WIN || MODE == A_SWA || MODE == A_CMP) {
                if (MODE == A_CMP || kt * 64 + 63 > u.tq - r32) {
#pragma unroll
                    for (int sub = 0; sub < 2; ++sub)
#pragma unroll
                        for (int r = 0; r < 16; ++r) { int key = key0 + 32 * sub + (r & 3) + 8 * (r >> 2); if (key > u.tq) p[sub][r] = -INFINITY; }
                }
            }
            if (MODE == A_WIN || MODE == A_SWA) {
                if (kt * 64 <= u.tq - r32 + 31 - u.window) {
#pragma unroll
                    for (int sub = 0; sub < 2; ++sub)
#pragma unroll
                        for (int r = 0; r < 16; ++r) { int key = key0 + 32 * sub + (r & 3) + 8 * (r >> 2); if (key <= u.tq - u.window) p[sub][r] = -INFINITY; }
                }
            }
            if (MODE == A_SEL) {
                if (!((u.selm >> kt) & 1u)) {
#pragma unroll
                    for (int r = 0; r < 16; ++r) { p[0][r] = -INFINITY; p[1][r] = -INFINITY; }
                }
            }
            if (MODE == A_DSA) {
                const unsigned w0 = dm.x >> (4 * hi), w1 = dm.y >> (4 * hi);
#pragma unroll
                for (int r = 0; r < 16; ++r) {
                    const unsigned bit = 1u << ((r & 3) + 8 * (r >> 2));
                    if (!(w0 & bit)) p[0][r] = -INFINITY;
                    if (!(w1 & bit)) p[1][r] = -INFINITY;
                }
            }
            float mloc = p[0][0];
#pragma unroll
            for (int r = 1; r < 16; ++r) mloc = fmaxf(mloc, p[0][r]);
#pragma unroll
            for (int r = 0; r < 16; ++r) mloc = fmaxf(mloc, p[1][r]);
            mloc = hswap_max(mloc);
            const float mn = fmaxf(m, mloc);
            const float alpha = exp2f(m - mn);
            m = mn;
            float ls = 0.f;
#pragma unroll
            for (int sub = 0; sub < 2; ++sub)
#pragma unroll
                for (int r = 0; r < 16; ++r) { float e = exp2f(p[sub][r] - mn); p[sub][r] = e; ls += e; }
            l = l * alpha + ls;
#pragma unroll
            for (int r = 0; r < 16; ++r) { o[0][r] *= alpha; o[1][r] *= alpha; }
#pragma unroll
            for (int ks = 0; ks < 4; ++ks) {
                const int sub = ks >> 1, rb = 8 * (ks & 1);
                u32x4 pw;
                pw.x = cvtpk(p[sub][rb + 0], p[sub][rb + 1]); pw.y = cvtpk(p[sub][rb + 2], p[sub][rb + 3]);
                pw.z = cvtpk(p[sub][rb + 4], p[sub][rb + 5]); pw.w = cvtpk(p[sub][rb + 6], p[sub][rb + 7]);
                const bf16x8 pf = __builtin_bit_cast(bf16x8, pw);
                bf16x8 v0 = *(const bf16x8*)(ldsV + r32 * TSTR + ks * 32 + hi * 16);
                bf16x8 v1 = *(const bf16x8*)(ldsV + (32 + r32) * TSTR + ks * 32 + hi * 16);
                o[0] = MFMA32(v0, pf, o[0]);
                o[1] = MFMA32(v1, pf, o[1]);
            }
        }
        kt = ktn;
    }
    m_out = m; l_out = hswap_sum(l);
    __syncthreads();
}

__device__ void phase_fox(const Params& p, int bid, int nblk, char* lds) {
    const int tid = threadIdx.x, lane = tid & 63, w = tid >> 6, r32 = lane & 31, hi = lane >> 5;
    for (int unit = bid; unit < B_ * 4 * 16; unit += nblk) {
        const int qb = 15 - (unit & 15), h = (unit >> 4) & 3, b = unit >> 6;
        const int q0 = qb * 128 + w * 32;
        AttnDesc u{};
        const long row = (long)b * S_ + q0 + r32;
        u.q = p.qb + row * 256 + h * 64;
        u.k = p.kb + (long)b * S_ * 256 + h * 64; u.ldk = 256;
        u.vt = p.vbT + ((long)(b * 4 + h) * 64) * S_; u.ldvt = S_;
        u.kt_lo = 0; u.kt_hi = (qb * 128 + 127) >> 6; u.wkt_lo = 0; u.wkt_hi = (q0 + 31) >> 6;
        u.tq = q0 + r32;
        u.kbias = p.kbias + (long)(b * 4 + h) * S_;
        f32x16 o[2]; float m, l;
        attn_core<A_FOX>(u, o, m, l, lds);
        const float inv = 1.f / l;
        bf16_t* dst = p.o + row * D_ + 256 + h * 64;
#pragma unroll
        for (int dh = 0; dh < 2; ++dh)
#pragma unroll
            for (int rg = 0; rg < 4; ++rg)
                st4(dst + dh * 32 + 8 * rg + 4 * hi, o[dh][rg * 4 + 0] * inv, o[dh][rg * 4 + 1] * inv, o[dh][rg * 4 + 2] * inv, o[dh][rg * 4 + 3] * inv);
    }
}
__device__ void phase_cumsum(const Params& p, int bid, int nblk) {
    const int tid = threadIdx.x, lane = tid & 63, w = tid >> 6;
    for (int seq = bid * 4 + w; seq < B_ * 4; seq += nblk * 4) {
        const int b = seq >> 2, h = seq & 3;
        float v[32]; float tot = 0.f;
#pragma unroll
        for (int i = 0; i < 32; ++i) { v[i] = p.logf[((long)b * S_ + lane * 32 + i) * 4 + h]; tot += v[i]; }
        float inc = tot;
#pragma unroll
        for (int o = 1; o < 64; o <<= 1) { float t = __shfl_up(inc, o); if (lane >= o) inc += t; }
        float run = inc - tot;
#pragma unroll
        for (int i = 0; i < 32; ++i) { run += v[i]; p.kbias[(long)(b * 4 + h) * S_ + lane * 32 + i] = -run * LOG2E; }
    }
}

__device__ void phase_swa(const Params& p, int l, int bid, int nblk, char* lds) {
    const int tid = threadIdx.x, lane = tid & 63, w = tid >> 6, r32 = lane & 31, hi = lane >> 5;
    for (int unit = bid; unit < B_ * 2 * 32; unit += nblk) {
        const int qb = unit & 31, kvh = (unit >> 5) & 1, b = unit >> 6;
        const int h = kvh * 2 + (w & 1);
        const int q0 = qb * 64 + 32 * (w >> 1);
        AttnDesc u{};
        const long row = (long)b * S_ + q0 + r32;
        u.q = p.qd + row * 256 + h * 64;
        u.k = p.kd + (long)b * S_ * 128 + kvh * 64; u.ldk = 128;
        u.vt = p.vdT + ((long)(b * 2 + kvh) * 64) * S_; u.ldvt = S_;
        int lo = qb * 64 - 127; if (lo < 0) lo = 0;
        u.kt_lo = lo >> 6; u.kt_hi = qb;
        int wlo = q0 - 127; if (wlo < 0) wlo = 0;
        u.wkt_lo = wlo >> 6; u.wkt_hi = (q0 + 31) >> 6;
        u.tq = q0 + r32; u.window = 128;
        f32x16 o[2]; float m, lsum;
        attn_core<A_SWA>(u, o, m, lsum, lds);
        const float sk = p.swa_sinks[l * 4 + h] * LOG2E;
        const float mn = fmaxf(m, sk); const float a = exp2f(m - mn);
        const float sc = a / (lsum * a + exp2f(sk - mn));
        bf16_t* dst = p.o + row * D_ + 768 + h * 64;
#pragma unroll
        for (int dh = 0; dh < 2; ++dh)
#pragma unroll
            for (int rg = 0; rg < 4; ++rg)
                st4(dst + dh * 32 + 8 * rg + 4 * hi, o[dh][rg * 4 + 0] * sc, o[dh][rg * 4 + 1] * sc, o[dh][rg * 4 + 2] * sc, o[dh][rg * 4 + 3] * sc);
    }
}
__device__ void phase_win(const Params& p, int bid, int nblk, char* lds) {
    const int tid = threadIdx.x, lane = tid & 63, w = tid >> 6, r32 = lane & 31, hi = lane >> 5;
    for (int unit = bid; unit < B_ * 64; unit += nblk) {
        const int qb = unit & 63, b = unit >> 6;
        const int h = w, q0 = qb * 32;
        AttnDesc u{};
        const long row = (long)b * S_ + q0 + r32;
        u.q = p.qa + row * 256 + h * 64;
        u.k = p.kwin + (long)b * S_ * 64; u.ldk = 64;
        u.vt = p.vwinT + ((long)b * 64) * S_; u.ldvt = S_;
        int lo = q0 - 511; if (lo < 0) lo = 0;
        u.kt_lo = lo >> 6; u.kt_hi = (q0 + 31) >> 6; u.wkt_lo = u.kt_lo; u.wkt_hi = u.kt_hi;
        u.tq = q0 + r32; u.window = 512;
        f32x16 o[2]; float m, lsum;
        attn_core<A_WIN>(u, o, m, lsum, lds);
        const float sc = p.ga[row * 12 + h * 3 + 2] / lsum;
        float* dst = p.owin + row * 256 + h * 64;
#pragma unroll
        for (int dh = 0; dh < 2; ++dh)
#pragma unroll
            for (int rg = 0; rg < 4; ++rg) {
                f32x4 v = {o[dh][rg * 4 + 0] * sc, o[dh][rg * 4 + 1] * sc, o[dh][rg * 4 + 2] * sc, o[dh][rg * 4 + 3] * sc};
                *(f32x4*)(dst + dh * 32 + 8 * rg + 4 * hi) = v;
            }
    }
}
__device__ void phase_sel(const Params& p, int bid, int nblk, char* lds) {
    const int tid = threadIdx.x, lane = tid & 63, w = tid >> 6, r32 = lane & 31, hi = lane >> 5;
    unsigned* lds_or = (unsigned*)(lds + 2 * 64 * TSTR + 512);
    for (int unit = bid; unit < B_ * 32 * 2; unit += nblk) {
        const int hp = unit & 1, qb = 31 - ((unit >> 1) & 31), b = unit >> 6;
        const int h = hp * 2 + (w & 1);
        const int q0 = qb * 64 + 32 * (w >> 1);
        AttnDesc u{};
        const long row = (long)b * S_ + q0 + r32;
        u.q = p.qa + row * 256 + h * 64;
        u.k = p.ksel + (long)b * S_ * 64; u.ldk = 64;
        u.vt = p.vselT + ((long)b * 64) * S_; u.ldvt = S_;
        u.kt_lo = 0; u.kt_hi = qb; u.wkt_lo = 0; u.wkt_hi = qb;
        u.tq = q0 + r32;
        u.selm = p.selmask[row];
        unsigned orv = u.selm;
#pragma unroll
        for (int o_ = 32; o_ > 0; o_ >>= 1) orv |= (unsigned)__shfl_xor((int)orv, o_);
        __syncthreads();
        if (tid == 0) *lds_or = 0u;
        __syncthreads();
        if (lane == 0) atomicOr(lds_or, orv);
        __syncthreads();
        u.tilemask = *lds_or;
        f32x16 o[2]; float m, lsum;
        attn_core<A_SEL>(u, o, m, lsum, lds);
        const float sc = p.ga[row * 12 + h * 3 + 1] / lsum;
        const float* oc = p.ocmp + row * 256 + h * 64; const float* ow = p.owin + row * 256 + h * 64;
        bf16_t* dst = p.o + row * D_ + h * 64;
#pragma unroll
        for (int dh = 0; dh < 2; ++dh)
#pragma unroll
            for (int rg = 0; rg < 4; ++rg) {
                const int c = dh * 32 + 8 * rg + 4 * hi;
                f32x4 a = *(const f32x4*)(oc + c), bb = *(const f32x4*)(ow + c);
                st4(dst + c, o[dh][rg * 4 + 0] * sc + a[0] + bb[0], o[dh][rg * 4 + 1] * sc + a[1] + bb[1], o[dh][rg * 4 + 2] * sc + a[2] + bb[2],
                    o[dh][rg * 4 + 3] * sc + a[3] + bb[3]);
            }
    }
}
__device__ void phase_dsa(const Params& p, int bid, int nblk, char* lds) {
    const int tid = threadIdx.x, lane = tid & 63, w = tid >> 6, r32 = lane & 31, hi = lane >> 5;
    for (int unit = bid; unit < B_ * 4 * 16; unit += nblk) {
        const int qb = 15 - (unit & 15), h = (unit >> 4) & 3, b = unit >> 6;
        const int q0 = qb * 128 + w * 32;
        AttnDesc u{};
        const long row = (long)b * S_ + q0 + r32;
        u.q = p.qc + row * 256 + h * 64;
        u.k = p.kcc + (long)b * S_ * 256 + h * 64; u.ldk = 256;
        u.vt = p.vcT + ((long)(b * 4 + h) * 64) * S_; u.ldvt = S_;
        u.kt_lo = 0; u.kt_hi = (qb * 128 + 127) >> 6; u.wkt_lo = 0; u.wkt_hi = (q0 + 31) >> 6;
        u.tq = q0 + r32;
        u.dmask = p.dmask + row * 64;
        f32x16 o[2]; float m, lsum;
        attn_core<A_DSA>(u, o, m, lsum, lds);
        const float inv = 1.f / lsum;
        bf16_t* dst = p.o + row * D_ + 512 + h * 64;
#pragma unroll
        for (int dh = 0; dh < 2; ++dh)
#pragma unroll
            for (int rg = 0; rg < 4; ++rg)
                st4(dst + dh * 32 + 8 * rg + 4 * hi, o[dh][rg * 4 + 0] * inv, o[dh][rg * 4 + 1] * inv, o[dh][rg * 4 + 2] * inv, o[dh][rg * 4 + 3] * inv);
    }
}
__device__ void phase_kvc(const Params& p, int l, int bid, int nblk, char* lds) {
    const int tid = threadIdx.x, lane = tid & 63, w = tid >> 6, r32 = lane & 31;
    const int wm = w & 1, wn = w >> 1;
    float* rsv = (float*)(lds + 2 * 128 * TSTR);
    for (int unit = bid; unit < (T_ / 128) * 4; unit += nblk) {
        const int tn = unit & 3, tm = unit >> 2;
        const int m0 = tm * 128;
        __syncthreads();
        {
            const int row = tid >> 1, half = tid & 1;
            const bf16_t* src = p.ckv + (long)(m0 + row) * 128 + half * 64;
            float ss = 0.f;
#pragma unroll
            for (int i = 0; i < 8; ++i) {
                u32x4 v = *(const u32x4*)(src + i * 8);
#pragma unroll
                for (int j = 0; j < 4; ++j) { float a = __uint_as_float(v[j] << 16), b2 = __uint_as_float(v[j] & 0xffff0000u); ss += a * a + b2 * b2; }
            }
            ss += __shfl_xor(ss, 1);
            if (half == 0) rsv[row] = rsqrtf(ss / 128.f + 1e-6f);
        }
        f32x16 acc[2][2];
#pragma unroll
        for (int a = 0; a < 2; ++a)
#pragma unroll
            for (int b2 = 0; b2 < 2; ++b2)
#pragma unroll
                for (int r = 0; r < 16; ++r) acc[a][b2][r] = 0.f;
        const bf16_t* A = p.ckv + (long)m0 * 128;
        const bf16_t* Bt = p.Wukv + ((long)l * 512 + tn * 128) * 128;
        gemm_core<128, 128, BMODE_BF16_NK>(acc, [&](int r) { return A + (long)r * 128; }, [&](int r) { return Bt + (long)r * 128; }, 128, lds);
#pragma unroll
        for (int mi = 0; mi < 2; ++mi) {
            const float rs = rsv[wm * 64 + mi * 32 + r32];
#pragma unroll
            for (int ni = 0; ni < 2; ++ni)
#pragma unroll
                for (int r = 0; r < 16; ++r) acc[ni][mi][r] *= rs;
        }
        const int g = tn * 2 + wn;
        if (g < 4) epi_tok(acc, m0 + wm * 64, 1, 1.f, p.kcc, 256, g * 64, p.cs, p.sn);
        else epi_vt(acc, m0 + wm * 64, p.vcT, 4, g - 4);
    }
}

#define SC_PER_B 2162688
__device__ __forceinline__ long sc_row_off(int b, int t) { const int qt = t >> 6; return (long)b * SC_PER_B + 2048L * qt * (qt + 1) + (long)(t & 63) * (qt + 1) * 64; }
__device__ void phase_idx(const Params& p, int bid, int nblk, char* lds) {
    const int tid = threadIdx.x, lane = tid & 63, w = tid >> 6, r32 = lane & 31, hi = lane >> 5;
    const int qg = w & 1, ksub = w >> 1;
    const int lrow = tid >> 3, lch = tid & 7;
    for (int unit = bid; unit < B_ * 28; unit += nblk) {
        const int qt = 31 - (unit % 28), b = unit / 28;
        const int t = qt * 64 + 32 * qg + r32; const long row = (long)b * S_ + t;
        bf16x8 qf[4][4];
#pragma unroll
        for (int h = 0; h < 4; ++h)
#pragma unroll
            for (int ds = 0; ds < 4; ++ds) qf[h][ds] = *(const bf16x8*)(p.qi + row * 256 + h * 64 + ds * 16 + hi * 8);
        const f32x4 wv = *(const f32x4*)(p.wi + row * 4);
        float* dst = p.sc + sc_row_off(b, t) + 32 * ksub + 4 * hi;
        const bf16_t* kbase = p.ki + (long)b * S_ * 64;
        u32x4 rk[2];
#pragma unroll
        for (int i = 0; i < 2; ++i) rk[i] = *(const u32x4*)(kbase + (long)(lrow + 32 * i) * 64 + lch * 8);
        for (int kt = 0; kt <= qt; ++kt) {
            __syncthreads();
#pragma unroll
            for (int i = 0; i < 2; ++i) *(u32x4*)(lds + (lrow + 32 * i) * TSTR + lch * 16) = rk[i];
            __syncthreads();
            if (kt < qt) {
#pragma unroll
                for (int i = 0; i < 2; ++i) rk[i] = *(const u32x4*)(kbase + (long)((kt + 1) * 64 + lrow + 32 * i) * 64 + lch * 8);
            }
            bf16x8 kf[4];
#pragma unroll
            for (int ds = 0; ds < 4; ++ds) kf[ds] = *(const bf16x8*)(lds + (32 * ksub + r32) * TSTR + ds * 32 + hi * 16);
            f32x16 score;
#pragma unroll
            for (int r = 0; r < 16; ++r) score[r] = 0.f;
#pragma unroll
            for (int h = 0; h < 4; ++h) {
                f32x16 sacc;
#pragma unroll
                for (int r = 0; r < 16; ++r) sacc[r] = 0.f;
#pragma unroll
                for (int ds = 0; ds < 4; ++ds) sacc = MFMA32(kf[ds], qf[h][ds], sacc);
#pragma unroll
                for (int r = 0; r < 16; ++r) score[r] += wv[h] * fmaxf(sacc[r], 0.f);
            }
#pragma unroll
            for (int rg = 0; rg < 4; ++rg) {
                f32x4 v = {score[rg * 4 + 0], score[rg * 4 + 1], score[rg * 4 + 2], score[rg * 4 + 3]};
                *(f32x4*)(dst + kt * 64 + 8 * rg) = v;
            }
        }
    }
}
__device__ void phase_dsel(const Params& p, int bid, int nblk) {
    const int tid = threadIdx.x, lane = tid & 63, w = tid >> 6;
    for (int rowid = bid * 4 + w; rowid < T_; rowid += nblk * 4) {
        const int b = rowid / S_, t = rowid % S_;
        unsigned word;
        if (t < 256) {
            const int lo = 32 * lane;
            word = (lo + 31 <= t) ? 0xffffffffu : (lo <= t ? ((1u << (t - lo + 1)) - 1u) : 0u);
        } else {
            const float* base = p.sc + sc_row_off(b, t) + 32 * lane;
            unsigned u[32];
            if (32 * lane <= t) {
#pragma unroll
                for (int i = 0; i < 8; ++i) {
                    f32x4 v = *(const f32x4*)(base + 4 * i);
#pragma unroll
                    for (int j = 0; j < 4; ++j) {
                        unsigned bits = __float_as_uint(v[j]);
                        unsigned x = bits ^ ((bits >> 31) ? 0xffffffffu : 0x80000000u);
                        u[4 * i + j] = (32 * lane + 4 * i + j <= t) ? x : 0u;
                    }
                }
            } else {
#pragma unroll
                for (int i = 0; i < 32; ++i) u[i] = 0u;
            }
            unsigned thr = 0u;
            for (int bit = 31; bit >= 0; --bit) {
                const unsigned cand = thr | (1u << bit);
                int cnt = 0;
#pragma unroll
                for (int i = 0; i < 32; ++i) cnt += __builtin_popcountll(__ballot(u[i] >= cand));
                if (cnt >= 256) thr = cand;
            }
            unsigned gt = 0u, eq = 0u;
#pragma unroll
            for (int i = 0; i < 32; ++i) { gt |= (u[i] > thr ? 1u : 0u) << i; eq |= (u[i] == thr ? 1u : 0u) << i; }
            int cg = __builtin_popcount(gt);
#pragma unroll
            for (int o_ = 32; o_ > 0; o_ >>= 1) cg += __shfl_xor(cg, o_);
            const int need = 256 - cg;
            const int e = __builtin_popcount(eq);
            int inc = e;
#pragma unroll
            for (int o_ = 1; o_ < 64; o_ <<= 1) { int tt = __shfl_up(inc, o_); if (lane >= o_) inc += tt; }
            int k = need - (inc - e); if (k > e) k = e;
            unsigned take = 0u, x = eq;
            while (k > 0) { unsigned low = x & (0u - x); take |= low; x ^= low; --k; }
            word = gt | take;
        }
        p.dmask[(long)rowid * 64 + lane] = word;
    }
}
#define HSTR 528
__device__ __forceinline__ float gelu_tanh_f(float x) {
    const float u = 0.7978845608028654f * (x + 0.044715f * x * x * x);
    const float e = __expf(2.f * u);
    const float th = 1.f - 2.f / (e + 1.f);
    return 0.5f * x * (1.f + th);
}
__device__ void phase_compress(const Params& p, int l, int bid, int nblk, char* lds) {
    const int tid = threadIdx.x, lane = tid & 63, w = tid >> 6, r32 = lane & 31, hi = lane >> 5;
    for (int unit = bid; unit < 32; unit += nblk) {
        const int kv = unit & 1, rt = unit >> 1;
        const bf16_t* src = kv ? p.vcmp : p.kcmp;
        const bf16_t* Bt = p.W1t + (long)(l * 2 + kv) * 256 * 2048;
        f32x16 acc[2][2];
#pragma unroll
        for (int a = 0; a < 2; ++a)
#pragma unroll
            for (int b2 = 0; b2 < 2; ++b2)
#pragma unroll
                for (int r = 0; r < 16; ++r) acc[a][b2][r] = 0.f;
        gemm_core<64, 256, BMODE_BF16_NK>(acc, [&](int r) { int R = rt * 64 + r; if (R > 1015) R = 1015; const int b = R / NCMP, c = R % NCMP; return src + ((long)b * S_ + 16 * c) * 64; },
                                          [&](int r) { return Bt + (long)r * 2048; }, 2048, lds);
        __syncthreads();
        const float* peb = p.peb + (l * 2 + kv) * 256;
#pragma unroll
        for (int ni = 0; ni < 2; ++ni)
#pragma unroll
            for (int rg = 0; rg < 4; ++rg) {
                const int n = w * 64 + ni * 32 + 8 * rg + 4 * hi;
                const f32x4 bv = *(const f32x4*)(peb + n);
#pragma unroll
                for (int mi = 0; mi < 2; ++mi) {
                    u32x2 v;
                    v.x = cvtpk(gelu_tanh_f(acc[ni][mi][rg * 4 + 0] + bv[0]), gelu_tanh_f(acc[ni][mi][rg * 4 + 1] + bv[1]));
                    v.y = cvtpk(gelu_tanh_f(acc[ni][mi][rg * 4 + 2] + bv[2]), gelu_tanh_f(acc[ni][mi][rg * 4 + 3] + bv[3]));
                    *(u32x2*)(lds + (mi * 32 + r32) * HSTR + n * 2) = v;
                }
            }
        __syncthreads();
        const int ni2 = w & 1, mi2 = w >> 1;
        const bf16_t* W2 = p.W2t + (long)(l * 2 + kv) * 64 * 256 + (long)(ni2 * 32 + r32) * 256 + hi * 8;
        f32x16 a2;
#pragma unroll
        for (int r = 0; r < 16; ++r) a2[r] = 0.f;
#pragma unroll
        for (int ks = 0; ks < 16; ++ks) {
            const bf16x8 bf = *(const bf16x8*)(W2 + ks * 16);
            const bf16x8 af = *(const bf16x8*)(lds + (mi2 * 32 + r32) * HSTR + ks * 32 + hi * 16);
            a2 = MFMA32(bf, af, a2);
        }
        const int R = rt * 64 + mi2 * 32 + r32;
        if (R < 1016) {
            const int b = R / NCMP, c = R % NCMP;
            if (kv == 0) {
#pragma unroll
                for (int rg = 0; rg < 4; ++rg) st4(p.kcb + ((long)b * 128 + c) * 64 + ni2 * 32 + 8 * rg + 4 * hi, a2[rg * 4 + 0], a2[rg * 4 + 1], a2[rg * 4 + 2], a2[rg * 4 + 3]);
            } else {
#pragma unroll
                for (int r = 0; r < 16; ++r) p.vcbT[((long)b * 64 + ni2 * 32 + crow(r, hi)) * 128 + vtpos(c)] = f2bf(a2[r]);
            }
        }
        __syncthreads();
    }
}
__device__ void phase_cmp(const Params& p, int bid, int nblk, char* lds) {
    const int tid = threadIdx.x, lane = tid & 63, w = tid >> 6, r32 = lane & 31, hi = lane >> 5;
    float* slab = (float*)(lds + 20480);
    for (int unit = bid; unit < B_ * 64; unit += nblk) {
        const int qb = unit & 63, b = unit >> 6;
        const int h = w, q0 = qb * 32;
        AttnDesc u{};
        const int t = q0 + r32; const long row = (long)b * S_ + t;
        u.q = p.qa + row * 256 + h * 64;
        u.k = p.kcb + (long)b * 128 * 64; u.ldk = 64;
        u.vt = p.vcbT + (long)b * 64 * 128; u.ldvt = 128;
        int lim = (t - 31) >> 4; if (lim > 126) lim = 126;
        int maxlim = (q0 + 31 - 31) >> 4; if (maxlim > 126) maxlim = 126;
        u.kt_lo = 0; u.kt_hi = (maxlim >= 64) ? 1 : 0; u.wkt_lo = 0; u.wkt_hi = u.kt_hi;
        u.tq = lim;
        f32x16 o[2]; float m, lsum;
        attn_core<A_CMP>(u, o, m, lsum, lds);
        const float inv = (lsum > 0.f) ? 1.f / lsum : 0.f;
        {
            const float sc = p.ga[row * 12 + h * 3 + 0] * inv;
            float* dst = p.ocmp + row * 256 + h * 64;
#pragma unroll
            for (int dh = 0; dh < 2; ++dh)
#pragma unroll
                for (int rg = 0; rg < 4; ++rg) {
                    f32x4 v = {o[dh][rg * 4 + 0] * sc, o[dh][rg * 4 + 1] * sc, o[dh][rg * 4 + 2] * sc, o[dh][rg * 4 + 3] * sc};
                    *(f32x4*)(dst + dh * 32 + 8 * rg + 4 * hi) = v;
                }
        }
        {
            const int lrow = tid >> 3, lch = tid & 7;
#pragma unroll
            for (int i = 0; i < 4; ++i) *(u32x4*)(lds + (lrow + 32 * i) * TSTR + lch * 16) = *(const u32x4*)(u.k + (long)(lrow + 32 * i) * 64 + lch * 8);
        }
        __syncthreads();
        bf16x8 qf[4];
#pragma unroll
        for (int ds = 0; ds < 4; ++ds) qf[ds] = *(const bf16x8*)(u.q + ds * 16 + hi * 8);
        float G[16], Lst[16];
#pragma unroll
        for (int s4 = 0; s4 < 4; ++s4) {
            f32x16 sa;
#pragma unroll
            for (int r = 0; r < 16; ++r) sa[r] = 0.f;
#pragma unroll
            for (int ds = 0; ds < 4; ++ds) sa = MFMA32(*(const bf16x8*)(lds + (32 * s4 + r32) * TSTR + ds * 32 + hi * 16), qf[ds], sa);
#pragma unroll
            for (int rg = 0; rg < 4; ++rg) {
                float g = 0.f, last = 0.f;
#pragma unroll
                for (int j = 0; j < 4; ++j) {
                    const int c = 32 * s4 + 8 * rg + 4 * hi + j;
                    const float pn = (c <= lim) ? exp2f(sa[rg * 4 + j] - m) * inv : 0.f;
                    g += pn; last = pn;
                }
                G[s4 * 4 + rg] = g; Lst[s4 * 4 + rg] = last;
            }
        }
        float* myslab = slab + (h * 32 + r32) * 33;
#pragma unroll
        for (int i = 0; i < 16; ++i) { const int jj = 8 * (i >> 2) + 2 * (i & 3) + hi; myslab[jj] = G[i]; }
        __builtin_amdgcn_s_waitcnt(0xc07f);
#pragma unroll
        for (int i = 0; i < 16; ++i) { const int jj = 8 * (i >> 2) + 2 * (i & 3) + hi; if (jj + 1 < 32) atomicAdd(&myslab[jj + 1], Lst[i]); }
        __syncthreads();
        if (tid < 32) {
            const int q = tid; const int tt = q0 + q; const int cur = tt >> 6;
            float* rowp = slab + q * 33;
            for (int j = 0; j < 32; ++j) {
                float a = slab[(0 * 32 + q) * 33 + j] + slab[(1 * 32 + q) * 33 + j] + slab[(2 * 32 + q) * 33 + j] + slab[(3 * 32 + q) * 33 + j];
                if (j == 0 || j == cur || j == cur - 1) a = 1e4f;
                if (j > cur) a = -1e4f;
                rowp[j] = a;
            }
            unsigned msk = 0u;
            for (int j = 0; j < 32; ++j) {
                const float v = rowp[j]; int rank = 0;
                for (int j2 = 0; j2 < 32; ++j2) { const float uu = rowp[j2]; rank += (uu > v) || (uu == v && j2 < j); }
                if (rank < 16) msk |= 1u << j;
            }
            p.selmask[(long)b * S_ + tt] = msk;
        }
        __syncthreads();
    }
}

__device__ void phase_merge(const Params& p, int l, int bid, int nblk, char* lds) {
    const int tid = threadIdx.x, lane = tid & 63, w = tid >> 6, r32 = lane & 31, hi = lane >> 5;
    const int wm = w & 1, wn = w >> 1;
    for (int tile = bid; tile < 8 * (T_ / 128); tile += nblk) {
        const int tn = tile / (T_ / 128), tm = tile % (T_ / 128);
        const int m0 = tm * 128, n0 = tn * 128;
        f32x16 acc[2][2], tot[2][2];
#pragma unroll
        for (int a = 0; a < 2; ++a)
#pragma unroll
            for (int b2 = 0; b2 < 2; ++b2)
#pragma unroll
                for (int r = 0; r < 16; ++r) { acc[a][b2][r] = 0.f; tot[a][b2][r] = 0.f; }
        const bf16_t* A = p.o + (long)m0 * D_;
        const bf16_t* Bt = p.Wbt + ((long)l * 1024 + n0) * 1024;
        auto hook = [&](int kt) {
            if ((kt & 3) == 3) {
                const int i = kt >> 2;
#pragma unroll
                for (int mi = 0; mi < 2; ++mi) {
                    const bf16_t* gp = p.gates + (long)(m0 + wm * 64 + mi * 32 + r32) * 4096 + i * 1024 + n0 + wn * 64 + 4 * hi;
#pragma unroll
                    for (int ni = 0; ni < 2; ++ni)
#pragma unroll
                        for (int rg = 0; rg < 4; ++rg) {
                            const u32x2 gv = *(const u32x2*)(gp + ni * 32 + 8 * rg);
                            tot[ni][mi][rg * 4 + 0] += acc[ni][mi][rg * 4 + 0] * __uint_as_float(gv.x << 16);
                            tot[ni][mi][rg * 4 + 1] += acc[ni][mi][rg * 4 + 1] * __uint_as_float(gv.x & 0xffff0000u);
                            tot[ni][mi][rg * 4 + 2] += acc[ni][mi][rg * 4 + 2] * __uint_as_float(gv.y << 16);
                            tot[ni][mi][rg * 4 + 3] += acc[ni][mi][rg * 4 + 3] * __uint_as_float(gv.y & 0xffff0000u);
                            acc[ni][mi][rg * 4 + 0] = 0.f; acc[ni][mi][rg * 4 + 1] = 0.f; acc[ni][mi][rg * 4 + 2] = 0.f; acc[ni][mi][rg * 4 + 3] = 0.f;
                        }
                }
            }
        };
        gemm_core<128, 128, BMODE_BF16_NK>(acc, [&](int r) { return A + (long)r * D_; }, [&](int r) { return Bt + (long)r * 1024; }, 1024, lds, hook);
#pragma unroll
        for (int mi = 0; mi < 2; ++mi) {
            bf16_t* dst = p.merged + (long)(m0 + wm * 64 + mi * 32 + r32) * D_ + n0 + wn * 64 + 4 * hi;
#pragma unroll
            for (int ni = 0; ni < 2; ++ni)
#pragma unroll
                for (int rg = 0; rg < 4; ++rg) st4(dst + ni * 32 + 8 * rg, tot[ni][mi][rg * 4 + 0], tot[ni][mi][rg * 4 + 1], tot[ni][mi][rg * 4 + 2], tot[ni][mi][rg * 4 + 3]);
        }
    }
}
__device__ void phase_outproj(const Params& p, int l, int bid, int nblk, char* lds) {
    const int tid = threadIdx.x, lane = tid & 63, w = tid >> 6, r32 = lane & 31, hi = lane >> 5;
    const int wm = w & 1, wn = w >> 1;
    for (int tile = bid; tile < 8 * (T_ / 128); tile += nblk) {
        const int tn = tile / (T_ / 128), tm = tile % (T_ / 128);
        const int m0 = tm * 128, n0 = tn * 128;
        f32x16 acc[2][2];
#pragma unroll
        for (int a = 0; a < 2; ++a)
#pragma unroll
            for (int b2 = 0; b2 < 2; ++b2)
#pragma unroll
                for (int r = 0; r < 16; ++r) acc[a][b2][r] = 0.f;
        const bf16_t* A = p.merged + (long)m0 * D_;
        const bf16_t* Bt = p.Wot + ((long)l * 1024 + n0) * 1024;
        gemm_core<128, 128, BMODE_BF16_NK>(acc, [&](int r) { return A + (long)r * D_; }, [&](int r) { return Bt + (long)r * 1024; }, 1024, lds);
#pragma unroll
        for (int mi = 0; mi < 2; ++mi) {
            float* dst = p.h + (long)(m0 + wm * 64 + mi * 32 + r32) * D_ + n0 + wn * 64 + 4 * hi;
#pragma unroll
            for (int ni = 0; ni < 2; ++ni)
#pragma unroll
                for (int rg = 0; rg < 4; ++rg) {
                    f32x4 v = *(f32x4*)(dst + ni * 32 + 8 * rg);
                    v[0] += acc[ni][mi][rg * 4 + 0]; v[1] += acc[ni][mi][rg * 4 + 1]; v[2] += acc[ni][mi][rg * 4 + 2]; v[3] += acc[ni][mi][rg * 4 + 3];
                    *(f32x4*)(dst + ni * 32 + 8 * rg) = v;
                }
        }
    }
}
__device__ void phase_router(const Params& p, int l, int bid, int nblk, char* lds) {
    const int tid = threadIdx.x, lane = tid & 63, w = tid >> 6;
    const int ti = lane & 15, kq = lane >> 4;
    float* lgw = (float*)lds + w * (16 * 81);
    const float* Wr = p.Wrt + (long)l * 80 * 1024;
    for (int task = bid * 4 + w; task < T_ / 16; task += nblk * 4) {
        const int t0 = task * 16;
        const float* xr = p.h + (long)(t0 + ti) * D_ + 4 * kq;
        f32x4 acc[5];
#pragma unroll
        for (int nt = 0; nt < 5; ++nt) acc[nt] = (f32x4){0.f, 0.f, 0.f, 0.f};
        float ss = 0.f;
        for (int k0 = 0; k0 < D_; k0 += 16) {
            const f32x4 xa = *(const f32x4*)(xr + k0);
            ss += xa[0] * xa[0] + xa[1] * xa[1] + xa[2] * xa[2] + xa[3] * xa[3];
#pragma unroll
            for (int nt = 0; nt < 5; ++nt) {
                const f32x4 wb = *(const f32x4*)(Wr + (long)(nt * 16 + ti) * 1024 + k0 + 4 * kq);
#pragma unroll
                for (int s_ = 0; s_ < 4; ++s_) acc[nt] = __builtin_amdgcn_mfma_f32_16x16x4f32(xa[s_], wb[s_], acc[nt], 0, 0, 0);
            }
        }
        ss += __shfl_xor(ss, 16); ss += __shfl_xor(ss, 32);
        const float rs = rsqrtf(ss / (float)D_ + 1e-6f);
        for (int k0 = 0; k0 < D_; k0 += 16) {
            const f32x4 xa = *(const f32x4*)(xr + k0);
            const f32x4 g = *(const f32x4*)(p.ffn_norm + l * D_ + k0 + 4 * kq);
            st4(p.hn + (long)(t0 + ti) * D_ + k0 + 4 * kq, xa[0] * rs * g[0], xa[1] * rs * g[1], xa[2] * rs * g[2], xa[3] * rs * g[3]);
        }
#pragma unroll
        for (int reg = 0; reg < 4; ++reg) {
            const int tok = 4 * kq + reg;
            const float rst = __shfl(rs, tok);
#pragma unroll
            for (int nt = 0; nt < 5; ++nt) lgw[tok * 81 + nt * 16 + ti] = acc[nt][reg] * rst;
        }
        __builtin_amdgcn_s_waitcnt(0xc07f);
        if (lane < 16) {
            const float* lg = lgw + lane * 81;
            float g[8]; float mx = -1e30f; int gi = 0;
#pragma unroll
            for (int i = 0; i < 8; ++i) { g[i] = lg[i] + p.moe_b_group[l * 8 + i]; if (g[i] > mx) { mx = g[i]; gi = i; } }
            float den = 0.f;
#pragma unroll
            for (int i = 0; i < 8; ++i) den += expf(g[i] - mx);
            const float pg = 1.f / den;
            float v0 = -1e30f, v1 = -1e30f; int i0 = 0, i1 = 0;
            for (int i = 0; i < 8; ++i) { const float e = lg[8 + gi * 8 + i] + p.moe_b_expert[l * 64 + gi * 8 + i]; if (e > v0) { v1 = v0; i1 = i0; v0 = e; i0 = i; } else if (e > v1) { v1 = e; i1 = i; } }
            const float x = expf(v1 - v0);
            const float w0 = pg / (1.f + x), w1 = pg * x / (1.f + x);
            const int t = t0 + lane;
            const int e0 = gi * 8 + i0, e1 = gi * 8 + i1;
            unsigned* cnt = p.ecnt + l * 64;
            const unsigned p0 = atomicAdd(&cnt[e0], 1u);
            p.elist[(long)e0 * T_ + p0] = t * 2;
            const unsigned p1 = atomicAdd(&cnt[e1], 1u);
            p.elist[(long)e1 * T_ + p1] = t * 2 + 1;
            p.slotw[t * 2] = w0; p.slotw[t * 2 + 1] = w1;
        }
        __builtin_amdgcn_s_waitcnt(0xc07f);
    }
}
__device__ __forceinline__ int moe_tiles(const Params& p, int l, int* tstart  ) {
    __syncthreads();
    if (threadIdx.x == 0) {
        int acc = 0;
        for (int e = 0; e < 64; ++e) { tstart[e] = acc; acc += (int)((p.ecnt[l * 64 + e] + 127u) >> 7); }
        tstart[64] = acc;
    }
    __syncthreads();
    return tstart[64];
}
__device__ __forceinline__ int moe_find(const int* tstart, int ti) { int e = 0; for (int i = 0; i < 64; ++i) if (tstart[i + 1] <= ti) e = i + 1; return e; }
__device__ void phase_moe_up(const Params& p, int l, int bid, int nblk, char* lds) {
    const int tid = threadIdx.x, lane = tid & 63, w = tid >> 6, r32 = lane & 31, hi = lane >> 5;
    const int wm = w & 1, wn = w >> 1;
    int* tstart = (int*)(lds + 2 * 128 * TSTR);
    const int ntl = moe_tiles(p, l, tstart);
    for (int unit = bid; unit < ntl * 4; unit += nblk) {
        const int nt = unit & 3, ti = unit >> 2;
        const int e = moe_find(tstart, ti); const int rt = ti - tstart[e];
        const int cnt = (int)p.ecnt[l * 64 + e];
        const int* lst = p.elist + (long)e * T_;
        f32x16 acc[2][2];
#pragma unroll
        for (int a = 0; a < 2; ++a)
#pragma unroll
            for (int b2 = 0; b2 < 2; ++b2)
#pragma unroll
                for (int r = 0; r < 16; ++r) acc[a][b2][r] = 0.f;
        const float* wgate = p.moe_w_gate + ((long)l * 64 + e) * 1024 * 256;
        const float* wup = p.moe_w_up + ((long)l * 64 + e) * 1024 * 256;
        gemm_core<128, 128, BMODE_F32_KN>(acc,
            [&](int r) { int rr = rt * 128 + r; if (rr >= cnt) rr = 0; const int slot = lst[rr]; return p.hn + (long)(slot >> 1) * D_; },
            [&](int nb, int& ld) { ld = 256; const int col = nt * 64 + (nb >> 6) * 32 + (nb & 31); return ((nb & 32) ? wup : wgate) + col; },
            1024, lds);
#pragma unroll
        for (int mi = 0; mi < 2; ++mi) {
            bf16_t* dst = p.hid + ((long)ti * 128 + wm * 64 + mi * 32 + r32) * 256 + nt * 64 + wn * 32 + 4 * hi;
#pragma unroll
            for (int rg = 0; rg < 4; ++rg) {
                float v[4];
#pragma unroll
                for (int j = 0; j < 4; ++j) { const float g = acc[0][mi][rg * 4 + j], uu = acc[1][mi][rg * 4 + j]; v[j] = g / (1.f + __expf(-g)) * uu; }
                st4(dst + 8 * rg, v[0], v[1], v[2], v[3]);
            }
        }
    }
}
__device__ void phase_moe_down(const Params& p, int l, int bid, int nblk, char* lds) {
    const int tid = threadIdx.x, lane = tid & 63, w = tid >> 6, r32 = lane & 31, hi = lane >> 5;
    const int wm = w & 1, wn = w >> 1;
    int* tstart = (int*)(lds + 2 * 128 * TSTR);
    const int ntl = moe_tiles(p, l, tstart);
    for (int unit = bid; unit < ntl * 8; unit += nblk) {
        const int nt = unit & 7, ti = unit >> 3;
        const int e = moe_find(tstart, ti); const int rt = ti - tstart[e];
        const int cnt = (int)p.ecnt[l * 64 + e];
        const int* lst = p.elist + (long)e * T_;
        f32x16 acc[2][2];
#pragma unroll
        for (int a = 0; a < 2; ++a)
#pragma unroll
            for (int b2 = 0; b2 < 2; ++b2)
#pragma unroll
                for (int r = 0; r < 16; ++r) acc[a][b2][r] = 0.f;
        const bf16_t* A = p.hid + (long)ti * 128 * 256;
        const float* wd = p.moe_w_down + ((long)l * 64 + e) * 256 * 1024 + nt * 128;
        gemm_core<128, 128, BMODE_F32_KN>(acc, [&](int r) { return A + (long)r * 256; }, [&](int nb, int& ld) { ld = 1024; return wd + nb; }, 256, lds);
#pragma unroll
        for (int mi = 0; mi < 2; ++mi) {
            const int rr = rt * 128 + wm * 64 + mi * 32 + r32;
            if (rr < cnt) {
                const int slot = lst[rr]; const float wgt = p.slotw[slot];
                bf16_t* dst = p.y + (long)slot * D_ + nt * 128 + wn * 64 + 4 * hi;
#pragma unroll
                for (int ni = 0; ni < 2; ++ni)
#pragma unroll
                    for (int rg = 0; rg < 4; ++rg)
                        st4(dst + ni * 32 + 8 * rg, acc[ni][mi][rg * 4 + 0] * wgt, acc[ni][mi][rg * 4 + 1] * wgt, acc[ni][mi][rg * 4 + 2] * wgt, acc[ni][mi][rg * 4 + 3] * wgt);
            }
        }
    }
}
__device__ void phase_combine(const Params& p, int lnext, int bid, int nblk) {
    const int tid = threadIdx.x, lane = tid & 63, w = tid >> 6;
    for (int row = bid * 4 + w; row < T_; row += nblk * 4) {
        f32x4 v[4]; float ss = 0.f;
#pragma unroll
        for (int i = 0; i < 4; ++i) {
            const int c = i * 256 + lane * 4;
            v[i] = *(const f32x4*)(p.h + (long)row * D_ + c);
            const u32x2 a = *(const u32x2*)(p.y + (long)(row * 2) * D_ + c), b2 = *(const u32x2*)(p.y + (long)(row * 2 + 1) * D_ + c);
            v[i][0] += __uint_as_float(a.x << 16) + __uint_as_float(b2.x << 16);
            v[i][1] += __uint_as_float(a.x & 0xffff0000u) + __uint_as_float(b2.x & 0xffff0000u);
            v[i][2] += __uint_as_float(a.y << 16) + __uint_as_float(b2.y << 16);
            v[i][3] += __uint_as_float(a.y & 0xffff0000u) + __uint_as_float(b2.y & 0xffff0000u);
            ss += v[i][0] * v[i][0] + v[i][1] * v[i][1] + v[i][2] * v[i][2] + v[i][3] * v[i][3];
        }
        for (int o_ = 32; o_ > 0; o_ >>= 1) ss += __shfl_xor(ss, o_);
        const float rs = rsqrtf(ss / (float)D_ + 1e-6f);
#pragma unroll
        for (int i = 0; i < 4; ++i) {
            const int c = i * 256 + lane * 4;
            if (lnext < 2) {
                const f32x4 g = *(const f32x4*)(p.attn_norm + lnext * D_ + c);
                *(f32x4*)(p.h + (long)row * D_ + c) = v[i];
                st4(p.hn + (long)row * D_ + c, v[i][0] * rs * g[0], v[i][1] * rs * g[1], v[i][2] * rs * g[2], v[i][3] * rs * g[3]);
            } else {
                const f32x4 g = *(const f32x4*)(p.final_norm + c);
                f32x4 ov = {v[i][0] * rs * g[0], v[i][1] * rs * g[1], v[i][2] * rs * g[2], v[i][3] * rs * g[3]};
                *(f32x4*)(p.out + (long)row * D_ + c) = ov;
            }
        }
    }
}

__global__ __launch_bounds__(256, 2) void k_phase_prep(Params p) { __shared__ __attribute__((aligned(16))) char lds[49152]; phase_prep(p, blockIdx.x, gridDim.x, lds); }
__global__ __launch_bounds__(256, 2) void k_phase_norm(Params p, int l) { phase_norm(p, l, blockIdx.x, gridDim.x); }
__global__ __launch_bounds__(256, 2) void k_phase_inproj(Params p, int l) { __shared__ __attribute__((aligned(16))) char lds[49152]; phase_inproj(p, l, blockIdx.x, gridDim.x, lds); }

__global__ __launch_bounds__(256, 2) void k_phase_fox(Params p) { __shared__ __attribute__((aligned(16))) char lds[49152]; phase_cumsum(p, blockIdx.x, gridDim.x); }
__global__ __launch_bounds__(256, 2) void k_phase_fox2(Params p) { __shared__ __attribute__((aligned(16))) char lds[49152]; phase_fox(p, blockIdx.x, gridDim.x, lds); }
__global__ __launch_bounds__(256, 2) void k_phase_swa(Params p, int l) { __shared__ __attribute__((aligned(16))) char lds[49152]; phase_swa(p, l, blockIdx.x, gridDim.x, lds); }
__global__ __launch_bounds__(256, 2) void k_phase_win(Params p) { __shared__ __attribute__((aligned(16))) char lds[49152]; phase_win(p, blockIdx.x, gridDim.x, lds); }
__global__ __launch_bounds__(256, 2) void k_phase_sel(Params p) { __shared__ __attribute__((aligned(16))) char lds[49152]; phase_sel(p, blockIdx.x, gridDim.x, lds); }
__global__ __launch_bounds__(256, 2) void k_phase_dsa(Params p) { __shared__ __attribute__((aligned(16))) char lds[49152]; phase_dsa(p, blockIdx.x, gridDim.x, lds); }
__global__ __launch_bounds__(256, 2) void k_phase_kvc(Params p, int l) { __shared__ __attribute__((aligned(16))) char lds[49152]; phase_kvc(p, l, blockIdx.x, gridDim.x, lds); }
__global__ __launch_bounds__(256, 2) void k_phase_idx(Params p) { __shared__ __attribute__((aligned(16))) char lds[49152]; phase_idx(p, blockIdx.x, gridDim.x, lds); }
__global__ __launch_bounds__(256, 2) void k_phase_dsel(Params p) { phase_dsel(p, blockIdx.x, gridDim.x); }
__global__ __launch_bounds__(256, 2) void k_phase_compress(Params p, int l) { __shared__ __attribute__((aligned(16))) char lds[49152]; phase_compress(p, l, blockIdx.x, gridDim.x, lds); }
__global__ __launch_bounds__(256, 2) void k_phase_cmp(Params p) { __shared__ __attribute__((aligned(16))) char lds[49152]; phase_cmp(p, blockIdx.x, gridDim.x, lds); }
__global__ __launch_bounds__(256, 2) void k_phase_merge(Params p, int l) { __shared__ __attribute__((aligned(16))) char lds[49152]; phase_merge(p, l, blockIdx.x, gridDim.x, lds); }
__global__ __launch_bounds__(256, 2) void k_phase_outproj(Params p, int l) { __shared__ __attribute__((aligned(16))) char lds[49152]; phase_outproj(p, l, blockIdx.x, gridDim.x, lds); }
__global__ __launch_bounds__(256, 2) void k_phase_router(Params p, int l) { __shared__ __attribute__((aligned(16))) char lds[49152]; phase_router(p, l, blockIdx.x, gridDim.x, lds); }
__global__ __launch_bounds__(256, 2) void k_phase_moe_up(Params p, int l) { __shared__ __attribute__((aligned(16))) char lds[49152]; phase_moe_up(p, l, blockIdx.x, gridDim.x, lds); }
__global__ __launch_bounds__(256, 2) void k_phase_moe_down(Params p, int l) { __shared__ __attribute__((aligned(16))) char lds[49152]; phase_moe_down(p, l, blockIdx.x, gridDim.x, lds); }
__global__ __launch_bounds__(256, 2) void k_phase_combine(Params p, int lnext) { phase_combine(p, lnext, blockIdx.x, gridDim.x); }
__global__ void k_dbg_cvt(const bf16_t* src, int lds_, float* dst, int ldd, int dcol, int ncols, float scale) {
    long idx = (long)blockIdx.x * blockDim.x + threadIdx.x; long tot = (long)T_ * ncols; if (idx >= tot) return;
    long t = idx / ncols; int c = idx % ncols;
    dst[t * ldd + dcol + c] = scale * bf2f(src[t * lds_ + c]);
}
__global__ void k_dbg_f2b(const float* src, int lds_, bf16_t* dst, int ldd, int dcol, int ncols) {
    long idx = (long)blockIdx.x * blockDim.x + threadIdx.x; long tot = (long)T_ * ncols; if (idx >= tot) return;
    long t = idx / ncols; int c = idx % ncols;
    dst[t * ldd + dcol + c] = f2bf_host_dev(src[t * lds_ + c]);
}
__global__ void k_dbg_cvt_vt(const bf16_t* src, int nh, float* dst, int ldd, int dcol) {
    long idx = (long)blockIdx.x * blockDim.x + threadIdx.x; long tot = (long)T_ * nh * 64; if (idx >= tot) return;
    int d = idx % 64; int hh = (idx / 64) % nh; long m = idx / (64 * nh); int b = m / S_, t = m % S_;
    dst[m * ldd + dcol + hh * 64 + d] = bf2f(src[((long)(b * nh + hh) * 64 + d) * S_ + vtpos(t)]);
}
__global__ void k_dbg_cvt_f32(const float* src, int lds_, float* dst, int ldd, int dcol, int ncols, int mode) {
    long idx = (long)blockIdx.x * blockDim.x + threadIdx.x; long tot = (long)T_ * ncols; if (idx >= tot) return;
    long t = idx / ncols; int c = idx % ncols;
    float v = src[t * lds_ + c];
    if (mode == 1) v = logf(v / (1.f - v));
    if (mode == 2) v = v * 16.f;
    dst[t * ldd + dcol + c] = v;
}

extern "C" void kernel_launch(void* const* d_in, const int* in_sizes, int n_in, void* d_out, int out_size, void* d_ws, size_t ws_size,
                              hipStream_t stream) {
    Params p{};
    p.x = (const float*)d_in[0]; p.positions = (const int*)d_in[1]; p.attn_norm = (const float*)d_in[2]; p.w_in = (const float*)d_in[3];
    p.nsa_pe_k = (const float*)d_in[4]; p.nsa_w1_k = (const float*)d_in[5]; p.nsa_w2_k = (const float*)d_in[6];
    p.nsa_pe_v = (const float*)d_in[7]; p.nsa_w1_v = (const float*)d_in[8]; p.nsa_w2_v = (const float*)d_in[9];
    p.fox_bias = (const float*)d_in[10]; p.dsa_kv_norm = (const float*)d_in[11]; p.dsa_w_ukv = (const float*)d_in[12]; p.swa_sinks = (const float*)d_in[13];
    p.w_branch = (const float*)d_in[14]; p.w_gate = (const float*)d_in[15]; p.w_out = (const float*)d_in[16]; p.ffn_norm = (const float*)d_in[17];
    p.moe_w_group = (const float*)d_in[18]; p.moe_b_group = (const float*)d_in[19]; p.moe_w_expert = (const float*)d_in[20]; p.moe_b_expert = (const float*)d_in[21];
    p.moe_w_gate = (const float*)d_in[22]; p.moe_w_up = (const float*)d_in[23]; p.moe_w_down = (const float*)d_in[24]; p.final_norm = (const float*)d_in[25];
    p.out = (float*)d_out;

    char* ws = (char*)d_ws;
    size_t off = 0;
    auto alloc = [&](size_t bytes) { char* q = ws + off; off += (bytes + 255) & ~(size_t)255; return (void*)q; };
    p.bar = (unsigned*)alloc(XCD_BAR_WORDS * 4);
    p.cs = (float*)alloc((size_t)T_ * 32 * 4); p.sn = (float*)alloc((size_t)T_ * 32 * 4);
    p.Wcat = (bf16_t*)alloc((size_t)2 * NCAT * 1024 * 2);
    p.Wukv = (bf16_t*)alloc((size_t)2 * 512 * 128 * 2);
    p.W1t = (bf16_t*)alloc((size_t)2 * 2 * 256 * 2048 * 2);
    p.W2t = (bf16_t*)alloc((size_t)2 * 2 * 64 * 256 * 2);
    p.peb = (float*)alloc((size_t)2 * 2 * 256 * 4);
    p.Wbt = (bf16_t*)alloc((size_t)2 * 1024 * 1024 * 2);
    p.Wot = (bf16_t*)alloc((size_t)2 * 1024 * 1024 * 2);
    p.Wrt = (float*)alloc((size_t)2 * 80 * 1024 * 4);
    p.h = (float*)alloc((size_t)T_ * D_ * 4);
    p.hn = (bf16_t*)alloc((size_t)T_ * D_ * 2);
    char* zreg = ws + off;
    p.qa = (bf16_t*)alloc((size_t)T_ * 256 * 2); p.kcmp = (bf16_t*)alloc((size_t)T_ * 64 * 2); p.vcmp = (bf16_t*)alloc((size_t)T_ * 64 * 2);
    p.ksel = (bf16_t*)alloc((size_t)T_ * 64 * 2); p.vselT = (bf16_t*)alloc((size_t)T_ * 64 * 2); p.kwin = (bf16_t*)alloc((size_t)T_ * 64 * 2);
    p.vwinT = (bf16_t*)alloc((size_t)T_ * 64 * 2);
    p.qb = (bf16_t*)alloc((size_t)T_ * 256 * 2); p.kb = (bf16_t*)alloc((size_t)T_ * 256 * 2); p.vbT = (bf16_t*)alloc((size_t)T_ * 256 * 2);
    p.qc = (bf16_t*)alloc((size_t)T_ * 256 * 2); p.ckv = (bf16_t*)alloc((size_t)T_ * 128 * 2); p.qi = (bf16_t*)alloc((size_t)T_ * 256 * 2);
    p.ki = (bf16_t*)alloc((size_t)T_ * 64 * 2); p.qd = (bf16_t*)alloc((size_t)T_ * 256 * 2); p.kd = (bf16_t*)alloc((size_t)T_ * 128 * 2);
    p.vdT = (bf16_t*)alloc((size_t)T_ * 128 * 2);
    p.ga = (float*)alloc((size_t)T_ * 12 * 4); p.logf = (float*)alloc((size_t)T_ * 4 * 4); p.wi = (float*)alloc((size_t)T_ * 4 * 4);
    p.kcc = (bf16_t*)alloc((size_t)T_ * 256 * 2); p.vcT = (bf16_t*)alloc((size_t)T_ * 256 * 2);
    char* greg = ws + off;
    p.gates = (bf16_t*)alloc((size_t)T_ * 4096 * 2);
    p.o = (bf16_t*)alloc((size_t)T_ * D_ * 2);
    p.kbias = (float*)alloc((size_t)B_ * 4 * S_ * 4);
    p.ocmp = (float*)alloc((size_t)T_ * 256 * 4);
    p.owin = (float*)alloc((size_t)T_ * 256 * 4);
    p.sc = (float*)alloc((size_t)B_ * 2162688 * 4);
    p.kcb = (bf16_t*)alloc((size_t)B_ * 128 * 64 * 2); p.vcbT = (bf16_t*)alloc((size_t)B_ * 64 * 128 * 2);
    p.dmask = (unsigned*)alloc((size_t)T_ * 64 * 4);
    p.selmask = (unsigned*)alloc((size_t)T_ * 4);
    p.ecnt = (unsigned*)alloc(128 * 4);
    p.elist = (int*)alloc((size_t)64 * T_ * 4);
    p.slotw = (float*)alloc((size_t)2 * T_ * 4);
    p.merged = (bf16_t*)zreg;
    p.hid = (bf16_t*)(zreg + (size_t)T_ * D_ * 2);
    p.y = (bf16_t*)greg;

    hipMemsetAsync(p.bar, 0, XCD_BAR_WORDS * 4, stream);
    const int NB = 512;
    k_phase_prep<<<NB, 256, 0, stream>>>(p);
    RopeP rk{}; { for (int i = 0; i < 4; ++i) rk.off[i] = 64 * i; rk.nh = 4; }
    auto cvt = [&](const bf16_t* src, int lds_, float* dst, int ldd, int dcol, int ncols, float scale) {
        long tot = (long)T_ * ncols; k_dbg_cvt<<<(unsigned)((tot + 255) / 256), 256, 0, stream>>>(src, lds_, dst, ldd, dcol, ncols, scale);
    };

    for (int l = 0; l < 2; ++l) {
        if (l == 0) k_phase_norm<<<NB, 256, 0, stream>>>(p, 0);
        k_phase_inproj<<<NB, 256, 0, stream>>>(p, l);
        k_phase_kvc<<<NB, 256, 0, stream>>>(p, l);
        k_phase_compress<<<NB, 256, 0, stream>>>(p, l);
        k_phase_cmp<<<NB, 256, 0, stream>>>(p);
        k_phase_win<<<NB, 256, 0, stream>>>(p);
        k_phase_sel<<<NB, 256, 0, stream>>>(p);
        k_phase_fox<<<NB, 256, 0, stream>>>(p);
        k_phase_fox2<<<NB, 256, 0, stream>>>(p);
        k_phase_idx<<<NB, 256, 0, stream>>>(p);
        k_phase_dsel<<<NB, 256, 0, stream>>>(p);
        k_phase_dsa<<<NB, 256, 0, stream>>>(p);
        k_phase_swa<<<NB, 256, 0, stream>>>(p, l);
        k_phase_merge<<<NB, 256, 0, stream>>>(p, l);
        k_phase_outproj<<<NB, 256, 0, stream>>>(p, l);
        k_phase_router<<<NB, 256, 0, stream>>>(p, l);
        k_phase_moe_up<<<NB, 256, 0, stream>>>(p, l);
        k_phase_moe_down<<<NB, 256, 0, stream>>>(p, l);
        if (l == 0) k_phase_combine<<<NB, 256, 0, stream>>>(p, 1);
    }
    k_phase_combine<<<NB, 256, 0, stream>>>(p, 2);
}
```

```cpp
#include <hip/hip_runtime.h>
#include <hip/hip_cooperative_groups.h>
#include <stdint.h>
namespace cg = cooperative_groups;

typedef unsigned short bf16_t;
__device__ __forceinline__ float bf2f(bf16_t b) { return __uint_as_float((unsigned)b << 16); }
__device__ __forceinline__ float ldf(const float* p, long i) { return p[i]; }
__device__ __forceinline__ float ldf(const bf16_t* p, long i) { return bf2f(p[i]); }
__device__ __forceinline__ int vtpos(int t) { int x = t & 15; int sub = x >> 2; int ns = ((sub & 1) << 1) | (sub >> 1); return (t & ~15) | (ns << 2) | (x & 3); }
#define LOG2E 1.4426950408889634f
__device__ __forceinline__ bf16_t f2bf_host_dev(float x) { unsigned u = __float_as_uint(x); u += 0x7fffu + ((u >> 16) & 1u); return (bf16_t)(u >> 16); }

#define B_ 8
#define S_ 2048
#define D_ 1024
#define T_ (B_ * S_)
#define DIN 2644
#define O_QA 0
#define O_KCMP 256
#define O_VCMP 320
#define O_KSEL 384
#define O_VSEL 448
#define O_KWIN 512
#define O_VWIN 576
#define O_GA 640
#define O_QB 652
#define O_KB 908
#define O_VB 1164
#define O_FB 1420
#define O_QC 1424
#define O_CKV 1680
#define O_QI 1808
#define O_KI 2064
#define O_WI 2128
#define O_QD 2132
#define O_KD 2388
#define O_VD 2516
#define NCMP 127

#define XB_TMO 128
#define XB_XCNT(j) (256 + 64 * (j))
#define XB_XSUB(j) (1280 + 64 * (j))
#define XB_XGEN(j) (2304 + 64 * (j))
#define XB_TOP 3328
#define XB_TOPGEN 3392
#define XCD_BAR_WORDS 3456
#define XB_SPIN_CAP (1u << 18)
#define LAS __attribute__((address_space(3)))
__device__ __forceinline__ unsigned xb_ld(unsigned* p) { return __hip_atomic_load(p, __ATOMIC_RELAXED, __HIP_MEMORY_SCOPE_AGENT); }
__device__ __forceinline__ unsigned xb_add(unsigned* p, unsigned v) { return __hip_atomic_fetch_add(p, v, __ATOMIC_RELAXED, __HIP_MEMORY_SCOPE_AGENT); }
__device__ __forceinline__ unsigned xb_xcc_id() { return (unsigned)__builtin_amdgcn_s_getreg((3 << 11) | 20) & 0xFu; }
#define XB_SPIN(cond, bar) do { unsigned _sp = 0; while (cond) { __builtin_amdgcn_s_sleep(1); \
    if ((++_sp & 255u) == 0u) { if (xb_ld(&(bar)[XB_TMO])) break; if (_sp > XB_SPIN_CAP) { atomicAdd(&(bar)[XB_TMO], 1u); break; } } } } while (0)
struct XcdBarrier { unsigned* bar; unsigned x; volatile LAS unsigned* st; };
__device__ __forceinline__ XcdBarrier xcd_barrier_post(unsigned* bar, volatile LAS unsigned* st) {
    XcdBarrier b; b.bar = bar; b.x = xb_xcc_id(); b.st = st;
    if (threadIdx.x == 0) (void)xb_add(&bar[XB_XCNT(b.x)], 1u);
    return b;
}
__device__ __forceinline__ void xcd_barrier_complete(unsigned* bar, unsigned x, unsigned& nloc, unsigned& nx) {
    const unsigned G = gridDim.x * gridDim.y * gridDim.z;
    unsigned sum, cnt, mine, sp = 0u;
    for (;;) {
        sum = 0u; cnt = 0u; mine = 0u;
#pragma unroll
        for (unsigned j = 0; j < 16; ++j) { const unsigned c = xb_ld(&bar[XB_XCNT(j)]); sum += c; cnt += (c > 0u) ? 1u : 0u; mine = (j == x) ? c : mine; }
        if (sum == G) break;
        __builtin_amdgcn_s_sleep(1);
        if ((++sp & 255u) == 0u) { if (xb_ld(&bar[XB_TMO])) break; if (sp > XB_SPIN_CAP) { atomicAdd(&bar[XB_TMO], 1u); break; } }
    }
    nloc = mine > 0u ? mine : 1u; nx = cnt > 0u ? cnt : 1u;
}
__device__ __forceinline__ void xcd_barrier(const XcdBarrier& b) {
    asm volatile("s_waitcnt vmcnt(0)" ::: "memory");
    __syncthreads();
    if (threadIdx.x == 0) {
        unsigned* bar = b.bar;
        __builtin_amdgcn_s_waitcnt(0);
        unsigned nloc = b.st[0], nx = b.st[1];
        if (nloc == 0u) { xcd_barrier_complete(bar, b.x, nloc, nx); b.st[0] = nloc; b.st[1] = nx; }
        const unsigned old = xb_add(&bar[XB_XSUB(b.x)], 1u);
        const unsigned gen = old / nloc;
        if (old + 1u == (gen + 1u) * nloc) {
            __builtin_amdgcn_fence(__ATOMIC_RELEASE, "agent");
            asm volatile("s_waitcnt vmcnt(0)" ::: "memory");
            const unsigned og = xb_add(&bar[XB_TOP], 1u);
            const unsigned tg = og / nx;
            if (og + 1u == (tg + 1u) * nx) xb_add(&bar[XB_TOPGEN], 1u);
            else XB_SPIN(xb_ld(&bar[XB_TOPGEN]) == tg, bar);
            __builtin_amdgcn_fence(__ATOMIC_ACQUIRE, "agent");
            xb_add(&bar[XB_XGEN(b.x)], 1u);
            asm volatile("s_waitcnt vmcnt(0)" ::: "memory");
        } else {
            XB_SPIN(xb_ld(&bar[XB_XGEN(b.x)]) == gen, bar);
            __builtin_amdgcn_fence(__ATOMIC_ACQUIRE, "agent");
            asm volatile("s_waitcnt vmcnt(0)" ::: "memory");
        }
    }
    __syncthreads();
}

__device__ __forceinline__ int otid() { int t = threadIdx.x; asm volatile("" : "+v"(t)); return t; }
__device__ __forceinline__ int osgpr(int v) { asm volatile("" : "+s"(v)); return v; }
typedef short bf16x8 __attribute__((ext_vector_type(8)));
typedef float f32x16 __attribute__((ext_vector_type(16)));
typedef float f32x4 __attribute__((ext_vector_type(4)));
typedef unsigned u32x4 __attribute__((ext_vector_type(4)));
typedef unsigned u32x2 __attribute__((ext_vector_type(2)));
#define MFMA32(a, b, c) __builtin_amdgcn_mfma_f32_32x32x16_bf16(a, b, c, 0, 0, 0)
__device__ __forceinline__ unsigned cvtpk(float lo, float hi) { unsigned r; asm("v_cvt_pk_bf16_f32 %0, %1, %2" : "=v"(r) : "v"(lo), "v"(hi)); return r; }
__device__ __forceinline__ bf16_t f2bf(float x) { return (bf16_t)(cvtpk(x, x) & 0xffffu); }
__device__ __forceinline__ int crow(int r, int hi) { return (r & 3) + 8 * (r >> 2) + 4 * hi; }
__device__ __forceinline__ float sigmoidf_(float x) { return 1.f / (1.f + __expf(-x)); }

#define NG_IN 106
#define NCAT (NG_IN * 64)
#define QSCALE 0.18033688011112042f

constexpr size_t wsal(size_t x) { return (x + 255) & ~(size_t)255; }
constexpr size_t OFF_bar = 0;
constexpr size_t OFF_cs = OFF_bar + wsal(XCD_BAR_WORDS * 4);
constexpr size_t OFF_sn = OFF_cs + wsal((size_t)T_ * 32 * 4);
constexpr size_t OFF_Wcat = OFF_sn + wsal((size_t)T_ * 32 * 4);
constexpr size_t OFF_Wukv = OFF_Wcat + wsal((size_t)2 * NCAT * 1024 * 2);
constexpr size_t OFF_W1t = OFF_Wukv + wsal((size_t)2 * 512 * 128 * 2);
constexpr size_t OFF_W2t = OFF_W1t + wsal((size_t)2 * 2 * 256 * 2048 * 2);
constexpr size_t OFF_peb = OFF_W2t + wsal((size_t)2 * 2 * 64 * 256 * 2);
constexpr size_t OFF_Wbt = OFF_peb + wsal((size_t)2 * 2 * 256 * 4);
constexpr size_t OFF_Wot = OFF_Wbt + wsal((size_t)2 * 1024 * 1024 * 2);
constexpr size_t OFF_Wrt = OFF_Wot + wsal((size_t)2 * 1024 * 1024 * 2);
constexpr size_t OFF_h = OFF_Wrt + wsal((size_t)2 * 80 * 1024 * 4);
constexpr size_t OFF_hn = OFF_h + wsal((size_t)T_ * D_ * 4);
constexpr size_t OFF_qa = OFF_hn + wsal((size_t)T_ * D_ * 2);
constexpr size_t OFF_kcmp = OFF_qa + wsal((size_t)T_ * 256 * 2);
constexpr size_t OFF_vcmp = OFF_kcmp + wsal((size_t)T_ * 64 * 2);
constexpr size_t OFF_ksel = OFF_vcmp + wsal((size_t)T_ * 64 * 2);
constexpr size_t OFF_vselT = OFF_ksel + wsal((size_t)T_ * 64 * 2);
constexpr size_t OFF_kwin = OFF_vselT + wsal((size_t)T_ * 64 * 2);
constexpr size_t OFF_vwinT = OFF_kwin + wsal((size_t)T_ * 64 * 2);
constexpr size_t OFF_qb = OFF_vwinT + wsal((size_t)T_ * 64 * 2);
constexpr size_t OFF_kb = OFF_qb + wsal((size_t)T_ * 256 * 2);
constexpr size_t OFF_vbT = OFF_kb + wsal((size_t)T_ * 256 * 2);
constexpr size_t OFF_qc = OFF_vbT + wsal((size_t)T_ * 256 * 2);
constexpr size_t OFF_ckv = OFF_qc + wsal((size_t)T_ * 256 * 2);
constexpr size_t OFF_qi = OFF_ckv + wsal((size_t)T_ * 128 * 2);
constexpr size_t OFF_ki = OFF_qi + wsal((size_t)T_ * 256 * 2);
constexpr size_t OFF_qd = OFF_ki + wsal((size_t)T_ * 64 * 2);
constexpr size_t OFF_kd = OFF_qd + wsal((size_t)T_ * 256 * 2);
constexpr size_t OFF_vdT = OFF_kd + wsal((size_t)T_ * 128 * 2);
constexpr size_t OFF_ga = OFF_vdT + wsal((size_t)T_ * 128 * 2);
constexpr size_t OFF_logf = OFF_ga + wsal((size_t)T_ * 12 * 4);
constexpr size_t OFF_wi = OFF_logf + wsal((size_t)T_ * 4 * 4);
constexpr size_t OFF_kcc = OFF_wi + wsal((size_t)T_ * 4 * 4);
constexpr size_t OFF_vcT = OFF_kcc + wsal((size_t)T_ * 256 * 2);
constexpr size_t OFF_gates = OFF_vcT + wsal((size_t)T_ * 256 * 2);
constexpr size_t OFF_o = OFF_gates + wsal((size_t)T_ * 4096 * 2);
constexpr size_t OFF_kbias = OFF_o + wsal((size_t)T_ * D_ * 2);
constexpr size_t OFF_ocmp = OFF_kbias + wsal((size_t)B_ * 4 * S_ * 4);
constexpr size_t OFF_owin = OFF_ocmp + wsal((size_t)T_ * 256 * 4);
constexpr size_t OFF_sc = OFF_owin + wsal((size_t)T_ * 256 * 4);
constexpr size_t OFF_kcb = OFF_sc + wsal((size_t)B_ * 2162688 * 4);
constexpr size_t OFF_vcbT = OFF_kcb + wsal((size_t)B_ * 128 * 64 * 2);
constexpr size_t OFF_dmask = OFF_vcbT + wsal((size_t)B_ * 64 * 128 * 2);
constexpr size_t OFF_selmask = OFF_dmask + wsal((size_t)T_ * 64 * 4);
constexpr size_t OFF_ecnt = OFF_selmask + wsal((size_t)T_ * 4);
constexpr size_t OFF_elist = OFF_ecnt + wsal(128 * 4);
constexpr size_t OFF_slotw = OFF_elist + wsal((size_t)64 * T_ * 4);
constexpr size_t WS_TOTAL = OFF_slotw + wsal((size_t)2 * T_ * 4);
constexpr size_t OFF_merged = OFF_qa;
constexpr size_t OFF_hid = OFF_qa + (size_t)T_ * D_ * 2;
constexpr size_t OFF_y = OFF_gates;
static_assert(OFF_hid + (size_t)328 * 128 * 256 * 2 <= OFF_ga, "hid must fit inside the dead z region");
static_assert(WS_TOTAL < (size_t)548 * 1000 * 1000, "workspace must stay below the guaranteed ws_size");
struct Params {
    const float* x; const int* positions; const float* attn_norm; const float* w_in;
    const float* nsa_pe_k; const float* nsa_w1_k; const float* nsa_w2_k; const float* nsa_pe_v; const float* nsa_w1_v; const float* nsa_w2_v;
    const float* fox_bias; const float* dsa_kv_norm; const float* dsa_w_ukv; const float* swa_sinks; const float* w_branch; const float* w_gate;
    const float* w_out; const float* ffn_norm; const float* moe_w_group; const float* moe_b_group; const float* moe_w_expert; const float* moe_b_expert;
    const float* moe_w_gate; const float* moe_w_up; const float* moe_w_down; const float* final_norm;
    float* out;
    char* ws;
    __device__ __forceinline__ unsigned* bar() const { return (unsigned*)(ws + OFF_bar); }
    __device__ __forceinline__ float* cs() const { return (float*)(ws + OFF_cs); }
    __device__ __forceinline__ float* sn() const { return (float*)(ws + OFF_sn); }
    __device__ __forceinline__ bf16_t* Wcat() const { return (bf16_t*)(ws + OFF_Wcat); }
    __device__ __forceinline__ bf16_t* Wukv() const { return (bf16_t*)(ws + OFF_Wukv); }
    __device__ __forceinline__ bf16_t* W1t() const { return (bf16_t*)(ws + OFF_W1t); }
    __device__ __forceinline__ bf16_t* W2t() const { return (bf16_t*)(ws + OFF_W2t); }
    __device__ __forceinline__ float* peb() const { return (float*)(ws + OFF_peb); }
    __device__ __forceinline__ bf16_t* Wbt() const { return (bf16_t*)(ws + OFF_Wbt); }
    __device__ __forceinline__ bf16_t* Wot() const { return (bf16_t*)(ws + OFF_Wot); }
    __device__ __forceinline__ float* Wrt() const { return (float*)(ws + OFF_Wrt); }
    __device__ __forceinline__ float* h() const { return (float*)(ws + OFF_h); }
    __device__ __forceinline__ bf16_t* hn() const { return (bf16_t*)(ws + OFF_hn); }
    __device__ __forceinline__ bf16_t* qa() const { return (bf16_t*)(ws + OFF_qa); }
    __device__ __forceinline__ bf16_t* kcmp() const { return (bf16_t*)(ws + OFF_kcmp); }
    __device__ __forceinline__ bf16_t* vcmp() const { return (bf16_t*)(ws + OFF_vcmp); }
    __device__ __forceinline__ bf16_t* ksel() const { return (bf16_t*)(ws + OFF_ksel); }
    __device__ __forceinline__ bf16_t* vselT() const { return (bf16_t*)(ws + OFF_vselT); }
    __device__ __forceinline__ bf16_t* kwin() const { return (bf16_t*)(ws + OFF_kwin); }
    __device__ __forceinline__ bf16_t* vwinT() const { return (bf16_t*)(ws + OFF_vwinT); }
    __device__ __forceinline__ bf16_t* qb() const { return (bf16_t*)(ws + OFF_qb); }
    __device__ __forceinline__ bf16_t* kb() const { return (bf16_t*)(ws + OFF_kb); }
    __device__ __forceinline__ bf16_t* vbT() const { return (bf16_t*)(ws + OFF_vbT); }
    __device__ __forceinline__ bf16_t* qc() const { return (bf16_t*)(ws + OFF_qc); }
    __device__ __forceinline__ bf16_t* ckv() const { return (bf16_t*)(ws + OFF_ckv); }
    __device__ __forceinline__ bf16_t* qi() const { return (bf16_t*)(ws + OFF_qi); }
    __device__ __forceinline__ bf16_t* ki() const { return (bf16_t*)(ws + OFF_ki); }
    __device__ __forceinline__ bf16_t* qd() const { return (bf16_t*)(ws + OFF_qd); }
    __device__ __forceinline__ bf16_t* kd() const { return (bf16_t*)(ws + OFF_kd); }
    __device__ __forceinline__ bf16_t* vdT() const { return (bf16_t*)(ws + OFF_vdT); }
    __device__ __forceinline__ float* ga() const { return (float*)(ws + OFF_ga); }
    __device__ __forceinline__ float* logf() const { return (float*)(ws + OFF_logf); }
    __device__ __forceinline__ float* wi() const { return (float*)(ws + OFF_wi); }
    __device__ __forceinline__ bf16_t* kcc() const { return (bf16_t*)(ws + OFF_kcc); }
    __device__ __forceinline__ bf16_t* vcT() const { return (bf16_t*)(ws + OFF_vcT); }
    __device__ __forceinline__ bf16_t* gates() const { return (bf16_t*)(ws + OFF_gates); }
    __device__ __forceinline__ bf16_t* o() const { return (bf16_t*)(ws + OFF_o); }
    __device__ __forceinline__ float* kbias() const { return (float*)(ws + OFF_kbias); }
    __device__ __forceinline__ float* ocmp() const { return (float*)(ws + OFF_ocmp); }
    __device__ __forceinline__ float* owin() const { return (float*)(ws + OFF_owin); }
    __device__ __forceinline__ float* sc() const { return (float*)(ws + OFF_sc); }
    __device__ __forceinline__ bf16_t* kcb() const { return (bf16_t*)(ws + OFF_kcb); }
    __device__ __forceinline__ bf16_t* vcbT() const { return (bf16_t*)(ws + OFF_vcbT); }
    __device__ __forceinline__ unsigned* dmask() const { return (unsigned*)(ws + OFF_dmask); }
    __device__ __forceinline__ unsigned* selmask() const { return (unsigned*)(ws + OFF_selmask); }
    __device__ __forceinline__ unsigned* ecnt() const { return (unsigned*)(ws + OFF_ecnt); }
    __device__ __forceinline__ int* elist() const { return (int*)(ws + OFF_elist); }
    __device__ __forceinline__ float* slotw() const { return (float*)(ws + OFF_slotw); }
    __device__ __forceinline__ bf16_t* merged() const { return (bf16_t*)(ws + OFF_merged); }
    __device__ __forceinline__ bf16_t* hid() const { return (bf16_t*)(ws + OFF_hid); }
    __device__ __forceinline__ bf16_t* y() const { return (bf16_t*)(ws + OFF_y); }
};

#define TSTR 144
enum { BMODE_BF16_NK = 0, BMODE_F32_KN = 1 };

struct NoHook { __device__ __forceinline__ void operator()(int) const {} };
template <int BM, int BN, int BMODE, class AROW, class BSRC, class HOOK = NoHook>
__device__ __forceinline__ void gemm_core(f32x16 (&acc)[2][2], AROW arow, BSRC bsrc, int K, char* lds, HOOK hook = HOOK()) {
    constexpr int WM = BM / 64;
    constexpr int NA = BM / 32, NB = BN / 32;
    const int tid = otid(), lane = tid & 63, w = tid >> 6, r32 = lane & 31, hi = lane >> 5;
    const int wm = w % WM, wn = w / WM;
    char* ldsA = lds; char* ldsB = lds + BM * TSTR;
    const bf16_t* ap[NA];
#pragma unroll
    for (int i = 0; i < NA; ++i) ap[i] = arow((tid >> 3) + 32 * i) + (tid & 7) * 8;
    const bf16_t* bp[NB];
    if constexpr (BMODE == BMODE_BF16_NK) {
#pragma unroll
        for (int i = 0; i < NB; ++i) bp[i] = (const bf16_t*)bsrc((tid >> 3) + 32 * i) + (tid & 7) * 8;
    }
    u32x4 ra[NA]; u32x4 rb[NB]; f32x4 rf[8];
    const int kg = tid >> 5, ng = tid & 31;
    const float* bfp = nullptr; int bld = 0;
    if constexpr (BMODE == BMODE_F32_KN) { bfp = (const float*)bsrc(ng * 4, bld); }
    auto load_regs = [&](int k0) {
#pragma unroll
        for (int i = 0; i < NA; ++i) ra[i] = *(const u32x4*)(ap[i] + k0);
        if (BMODE == BMODE_BF16_NK) {
#pragma unroll
            for (int i = 0; i < NB; ++i) rb[i] = *(const u32x4*)(bp[i] + k0);
        } else {
#pragma unroll
            for (int j = 0; j < 8; ++j) rf[j] = *(const f32x4*)(bfp + (long)(k0 + kg * 8 + j) * bld);
        }
    };
    auto store_lds = [&]() {
#pragma unroll
        for (int i = 0; i < NA; ++i) *(u32x4*)(ldsA + ((tid >> 3) + 32 * i) * TSTR + (tid & 7) * 16) = ra[i];
        if (BMODE == BMODE_BF16_NK) {
#pragma unroll
            for (int i = 0; i < NB; ++i) *(u32x4*)(ldsB + ((tid >> 3) + 32 * i) * TSTR + (tid & 7) * 16) = rb[i];
        } else {
#pragma unroll
            for (int i = 0; i < 4; ++i) {
                u32x4 v;
                v.x = cvtpk(rf[0][i], rf[1][i]); v.y = cvtpk(rf[2][i], rf[3][i]); v.z = cvtpk(rf[4][i], rf[5][i]); v.w = cvtpk(rf[6][i], rf[7][i]);
                *(u32x4*)(ldsB + (ng * 4 + i) * TSTR + kg * 16) = v;
            }
        }
    };
    const int nk = K / 64;
    load_regs(0);
    for (int kt = 0; kt < nk; ++kt) {
        __syncthreads();
        store_lds();
        __syncthreads();
        if (kt + 1 < nk) load_regs((kt + 1) * 64);
#pragma unroll
        for (int ks = 0; ks < 4; ++ks) {
            bf16x8 bf[2], af[2];
#pragma unroll
            for (int ni = 0; ni < 2; ++ni) bf[ni] = *(const bf16x8*)(ldsB + (wn * 64 + ni * 32 + r32) * TSTR + ks * 32 + hi * 16);
#pragma unroll
            for (int mi = 0; mi < 2; ++mi) af[mi] = *(const bf16x8*)(ldsA + (wm * 64 + mi * 32 + r32) * TSTR + ks * 32 + hi * 16);
#pragma unroll
            for (int ni = 0; ni < 2; ++ni)
#pragma unroll
                for (int mi = 0; mi < 2; ++mi) acc[ni][mi] = MFMA32(bf[ni], af[mi], acc[ni][mi]);
        }
        hook(kt);
    }
}

__device__ __forceinline__ void tconv_tile(const float* __restrict__ src, int lds_, bf16_t* __restrict__ dst, int ldd, const float* kscale, bool zero, char* lds) {
    float (*tile)[65] = (float (*)[65])lds;
    const int tid = otid();
    __syncthreads();
#pragma unroll
    for (int i = 0; i < 16; ++i) {
        int kk = i * 4 + (tid >> 6), nn = tid & 63;
        float v = zero ? 0.f : src[(long)kk * lds_ + nn];
        if (kscale) v *= kscale[kk];
        tile[kk][nn] = v;
    }
    __syncthreads();
#pragma unroll
    for (int i = 0; i < 2; ++i) {
        int c = tid + 256 * i; int nn = c >> 3, kc = (c & 7) * 8;
        u32x4 v;
        v.x = cvtpk(tile[kc + 0][nn], tile[kc + 1][nn]); v.y = cvtpk(tile[kc + 2][nn], tile[kc + 3][nn]);
        v.z = cvtpk(tile[kc + 4][nn], tile[kc + 5][nn]); v.w = cvtpk(tile[kc + 6][nn], tile[kc + 7][nn]);
        *(u32x4*)(dst + (long)nn * ldd + kc) = v;
    }
}
__device__ __forceinline__ int in_group_src(int g) {
    if (g < 10) return g * 64;
    if (g < 22) return O_QB + (g - 10) * 64;
    if (g < 33) return O_QC + (g - 22) * 64;
    return O_QD + (g - 33) * 64;
}
__device__ void phase_prep(const Params& p, int bid, int nblk, char* lds) {
    const int tid = otid();
    if (bid == 0 && tid < 128) p.ecnt()[tid] = 0u;
    for (int idx = bid * 256 + tid; idx < T_ * 32; idx += nblk * 256) {
        int i = idx & 31, t = idx >> 5;
        float inv = powf(10000.f, -(float)i / 32.f);
        float ang = (float)p.positions[t] * inv;
        double a = (double)ang; double n = rint(a * 0.15915494309189535); float rf = (float)(a - n * 6.283185307179586);
        p.cs()[idx] = cosf(rf); p.sn()[idx] = sinf(rf);
    }
    const int J_CAT = 2 * NG_IN * 16;
    const int J_UKV = 2 * 8 * 2;
    const int J_W1 = 2 * 2 * 4 * 32;
    const int J_W2 = 2 * 2 * 1 * 4;
    const int J_WB = 2 * 4 * 16 * 4;
    const int J_WO = 2 * 16 * 16;
    const int total = J_CAT + J_UKV + J_W1 + J_W2 + J_WB + J_WO;
    for (int j = bid; j < total; j += nblk) {
        int q = j;
        if (q < J_CAT) {
            int kt = q & 15; int g = (q >> 4) % NG_IN; int l = (q >> 4) / NG_IN;
            bf16_t* dst = p.Wcat() + ((long)l * NCAT + g * 64) * 1024 + kt * 64;
            if (g < 41) tconv_tile(p.w_in + (long)l * D_ * DIN + (long)kt * 64 * DIN + in_group_src(g), DIN, dst, 1024, nullptr, false, lds);
            else if (g == 41) {
                __syncthreads();
                float (*tile)[65] = (float (*)[65])lds;
                const float* src = p.w_in + (long)l * D_ * DIN + (long)kt * 64 * DIN;
#pragma unroll
                for (int i = 0; i < 16; ++i) {
                    int kk = i * 4 + (tid >> 6), nn = tid & 63;
                    float v = 0.f;
                    if (nn < 12) v = src[(long)kk * DIN + O_GA + nn];
                    else if (nn < 16) v = src[(long)kk * DIN + O_FB + nn - 12];
                    else if (nn < 20) v = src[(long)kk * DIN + O_WI + nn - 16];
                    tile[kk][nn] = v;
                }
                __syncthreads();
#pragma unroll
                for (int i = 0; i < 2; ++i) {
                    int c = tid + 256 * i; int nn = c >> 3, kc = (c & 7) * 8;
                    u32x4 v;
                    v.x = cvtpk(tile[kc + 0][nn], tile[kc + 1][nn]); v.y = cvtpk(tile[kc + 2][nn], tile[kc + 3][nn]);
                    v.z = cvtpk(tile[kc + 4][nn], tile[kc + 5][nn]); v.w = cvtpk(tile[kc + 6][nn], tile[kc + 7][nn]);
                    *(u32x4*)(dst + (long)nn * 1024 + kc) = v;
                }
            } else {
                int gg = g - 42; int i = gg >> 4, nt = gg & 15;
                tconv_tile(p.w_gate + ((long)(l * 4 + i) * D_ + kt * 64) * D_ + nt * 64, D_, dst, 1024, nullptr, false, lds);
            }
            continue;
        }
        q -= J_CAT;
        if (q < J_UKV) {
            int kt = q & 1, nt = (q >> 1) & 7, l = q >> 4;
            tconv_tile(p.dsa_w_ukv + (long)l * 128 * 512 + (long)kt * 64 * 512 + nt * 64, 512, p.Wukv() + ((long)l * 512 + nt * 64) * 128 + kt * 64, 128,
                       p.dsa_kv_norm + l * 128 + kt * 64, false, lds);
            continue;
        }
        q -= J_UKV;
        if (q < J_W1) {
            int kt = q & 31, nt = (q >> 5) & 3, kv = (q >> 7) & 1, l = q >> 8;
            const float* src = (kv ? p.nsa_w1_v : p.nsa_w1_k) + (long)l * 2048 * 256 + (long)kt * 64 * 256 + nt * 64;
            tconv_tile(src, 256, p.W1t() + ((long)(l * 2 + kv) * 256 + nt * 64) * 2048 + kt * 64, 2048, nullptr, false, lds);
            continue;
        }
        q -= J_W1;
        if (q < J_W2) {
            int kt = q & 3, kv = (q >> 2) & 1, l = q >> 3;
            const float* src = (kv ? p.nsa_w2_v : p.nsa_w2_k) + (long)l * 256 * 64 + (long)kt * 64 * 64;
            tconv_tile(src, 64, p.W2t() + ((long)(l * 2 + kv) * 64) * 256 + kt * 64, 256, nullptr, false, lds);
            continue;
        }
        q -= J_W2;
        if (q < J_WB) {
            int kt = q & 3, nt = (q >> 2) & 15, i = (q >> 6) & 3, l = q >> 8;
            tconv_tile(p.w_branch + ((long)(l * 4 + i) * 256 + kt * 64) * D_ + nt * 64, D_, p.Wbt() + ((long)l * 1024 + nt * 64) * 1024 + i * 256 + kt * 64, 1024,
                       nullptr, false, lds);
            continue;
        }
        q -= J_WB;
        {
            int kt = q & 15, nt = (q >> 4) & 15, l = q >> 8;
            tconv_tile(p.w_out + ((long)l * D_ + kt * 64) * D_ + nt * 64, D_, p.Wot() + ((long)l * 1024 + nt * 64) * 1024 + kt * 64, 1024, nullptr, false, lds);
        }
    }
    for (int idx = bid * 256 + tid; idx < 2 * 2 * 256; idx += nblk * 256) {
        int jn = idx & 255, kv = (idx >> 8) & 1, l = idx >> 9;
        const float* pe = (kv ? p.nsa_pe_v : p.nsa_pe_k) + l * 2048;
        const float* w1 = (kv ? p.nsa_w1_v : p.nsa_w1_k) + (long)l * 2048 * 256 + jn;
        float a = 0.f;
        for (int i = 0; i < 2048; ++i) a += pe[i] * w1[(long)i * 256];
        p.peb()[idx] = a;
    }
    for (int idx = bid * 256 + tid; idx < 2 * 80 * 1024; idx += nblk * 256) {
        int k = idx & 1023, jn = (idx >> 10) % 80, l = idx / (80 * 1024);
        float v = 0.f;
        if (jn < 8) v = p.moe_w_group[((long)l * D_ + k) * 8 + jn];
        else if (jn < 72) v = p.moe_w_expert[((long)l * D_ + k) * 64 + jn - 8];
        p.Wrt()[idx] = v * p.ffn_norm[l * D_ + k];
    }
}

__device__ void phase_norm(const Params& p, int l, int bid, int nblk) {
    const int tid = otid(), lane = tid & 63, w = tid >> 6;
    for (int row = bid * 4 + w; row < T_; row += nblk * 4) {
        const float* x = (l == 0 ? p.x : (const float*)p.h()) + (long)row * D_;
        f32x4 v[4]; float ss = 0.f;
#pragma unroll
        for (int i = 0; i < 4; ++i) { v[i] = *(const f32x4*)(x + i * 256 + lane * 4); ss += v[i][0] * v[i][0] + v[i][1] * v[i][1] + v[i][2] * v[i][2] + v[i][3] * v[i][3]; }
        for (int o = 32; o > 0; o >>= 1) ss += __shfl_xor(ss, o);
        float rs = rsqrtf(ss / (float)D_ + 1e-6f);
#pragma unroll
        for (int i = 0; i < 4; ++i) {
            f32x4 g = *(const f32x4*)(p.attn_norm + l * D_ + i * 256 + lane * 4);
            if (l == 0) *(f32x4*)(p.h() + (long)row * D_ + i * 256 + lane * 4) = v[i];
            u32x2 o2; o2.x = cvtpk(v[i][0] * rs * g[0], v[i][1] * rs * g[1]); o2.y = cvtpk(v[i][2] * rs * g[2], v[i][3] * rs * g[3]);
            *(u32x2*)(p.hn() + (long)row * D_ + i * 256 + lane * 4) = o2;
        }
    }
}

__device__ __forceinline__ void st4(bf16_t* dst, float a, float b, float c, float d) { u32x2 v; v.x = cvtpk(a, b); v.y = cvtpk(c, d); *(u32x2*)dst = v; }

__device__ __forceinline__ void epi_tok(const f32x16 (&acc)[2][2], int m_base, int kind, float scale, bf16_t* dst, int ld, int col0, const float* cs, const float* sn) {
    const int lane = otid() & 63, r32 = lane & 31, hi = lane >> 5;
#pragma unroll
    for (int mi = 0; mi < 2; ++mi) {
        const long m = m_base + mi * 32 + r32;
#pragma unroll
        for (int rg = 0; rg < 4; ++rg) {
            float x1[4], x2[4];
#pragma unroll
            for (int j = 0; j < 4; ++j) { x1[j] = acc[0][mi][rg * 4 + j]; x2[j] = acc[1][mi][rg * 4 + j]; }
            const int i0 = 8 * rg + 4 * hi;
            if (kind == 1) {
                f32x4 c = *(const f32x4*)(cs + m * 32 + i0), s = *(const f32x4*)(sn + m * 32 + i0);
#pragma unroll
                for (int j = 0; j < 4; ++j) { float a = x1[j] * c[j] - x2[j] * s[j]; float b = x2[j] * c[j] + x1[j] * s[j]; x1[j] = a; x2[j] = b; }
            }
            st4(dst + m * ld + col0 + i0, x1[0] * scale, x1[1] * scale, x1[2] * scale, x1[3] * scale);
            st4(dst + m * ld + col0 + 32 + i0, x2[0] * scale, x2[1] * scale, x2[2] * scale, x2[3] * scale);
        }
    }
}
__device__ __forceinline__ void epi_vt(const f32x16 (&acc)[2][2], int m_base, bf16_t* dst, int nh, int hh) {
    const int lane = otid() & 63, r32 = lane & 31, hi = lane >> 5;
#pragma unroll
    for (int mi = 0; mi < 2; ++mi) {
        const int m = m_base + mi * 32 + r32; const int b = m / S_, t = m % S_;
        bf16_t* base = dst + ((long)(b * nh + hh) * 64) * S_ + vtpos(t);
#pragma unroll
        for (int ni = 0; ni < 2; ++ni)
#pragma unroll
            for (int r = 0; r < 16; ++r) base[(long)(ni * 32 + crow(r, hi)) * S_] = f2bf(acc[ni][mi][r]);
    }
}

__device__ void phase_inproj(const Params& p, int l, int bid, int nblk, char* lds) {
    const int tid = otid(), lane = tid & 63, w = tid >> 6, r32 = lane & 31, hi = lane >> 5;
    const int wm = w & 1, wn = w >> 1;
    const bf16_t* Wc = p.Wcat() + (long)l * NCAT * 1024;
    const int NT_N = NCAT / 128, NT_M = T_ / 128;
    for (int tile = bid; tile < NT_N * NT_M; tile += nblk) {
        const int tn = tile / NT_M, tm = tile % NT_M;
        const int m0 = tm * 128, n0 = tn * 128;
        f32x16 acc[2][2];
#pragma unroll
        for (int a = 0; a < 2; ++a)
#pragma unroll
            for (int b = 0; b < 2; ++b)
#pragma unroll
                for (int r = 0; r < 16; ++r) acc[a][b][r] = 0.f;
        const bf16_t* A = p.hn() + (long)m0 * D_;
        const bf16_t* Bt = Wc + (long)n0 * 1024;
        gemm_core<128, 128, BMODE_BF16_NK>(acc, [&](int r) { return A + (long)r * D_; }, [&](int r) { return Bt + (long)r * 1024; }, D_, lds);
        const int g = tn * 2 + wn;
        const int mb = m0 + wm * 64;
        if (g < 4) epi_tok(acc, mb, 1, QSCALE, p.qa(), 256, g * 64, p.cs(), p.sn());
        else if (g == 4) epi_tok(acc, mb, 1, 1.f, p.kcmp(), 64, 0, p.cs(), p.sn());
        else if (g == 5) epi_tok(acc, mb, 0, 1.f, p.vcmp(), 64, 0, p.cs(), p.sn());
        else if (g == 6) epi_tok(acc, mb, 1, 1.f, p.ksel(), 64, 0, p.cs(), p.sn());
        else if (g == 7) epi_vt(acc, mb, p.vselT(), 1, 0);
        else if (g == 8) epi_tok(acc, mb, 1, 1.f, p.kwin(), 64, 0, p.cs(), p.sn());
        else if (g == 9) epi_vt(acc, mb, p.vwinT(), 1, 0);
        else if (g < 14) epi_tok(acc, mb, 0, QSCALE, p.qb(), 256, (g - 10) * 64, p.cs(), p.sn());
        else if (g < 18) epi_tok(acc, mb, 0, 1.f, p.kb(), 256, (g - 14) * 64, p.cs(), p.sn());
        else if (g < 22) epi_vt(acc, mb, p.vbT(), 4, g - 18);
        else if (g < 26) epi_tok(acc, mb, 1, QSCALE, p.qc(), 256, (g - 22) * 64, p.cs(), p.sn());
        else if (g < 28) epi_tok(acc, mb, 0, 1.f, p.ckv(), 128, (g - 26) * 64, p.cs(), p.sn());
        else if (g < 32) epi_tok(acc, mb, 1, 1.f, p.qi(), 256, (g - 28) * 64, p.cs(), p.sn());
        else if (g == 32) epi_tok(acc, mb, 1, 1.f, p.ki(), 64, 0, p.cs(), p.sn());
        else if (g < 37) epi_tok(acc, mb, 1, QSCALE, p.qd(), 256, (g - 33) * 64, p.cs(), p.sn());
        else if (g < 39) epi_tok(acc, mb, 1, 1.f, p.kd(), 128, (g - 37) * 64, p.cs(), p.sn());
        else if (g < 41) epi_vt(acc, mb, p.vdT(), 2, g - 39);
        else if (g == 41) {
#pragma unroll
            for (int mi = 0; mi < 2; ++mi) {
                const long m = mb + mi * 32 + r32;
#pragma unroll
                for (int r = 0; r < 16; ++r) {
                    const int c = crow(r, hi); const float v = acc[0][mi][r];
                    if (c < 12) p.ga()[m * 12 + c] = sigmoidf_(v);
                    else if (c < 16) { float xx = v + p.fox_bias[l * 4 + c - 12]; p.logf()[m * 4 + c - 12] = fminf(xx, 0.f) - __logf(1.f + __expf(-fabsf(xx))); }
                    else if (c < 20) p.wi()[m * 4 + c - 16] = v * 0.0625f;
                }
            }
        } else {
            const int col0 = (g - 42) * 64;
#pragma unroll
            for (int mi = 0; mi < 2; ++mi) {
                const long m = mb + mi * 32 + r32;
#pragma unroll
                for (int ni = 0; ni < 2; ++ni)
#pragma unroll
                    for (int rg = 0; rg < 4; ++rg)
                        st4(p.gates() + m * 4096 + col0 + ni * 32 + 8 * rg + 4 * hi, sigmoidf_(acc[ni][mi][rg * 4 + 0]), sigmoidf_(acc[ni][mi][rg * 4 + 1]),
                            sigmoidf_(acc[ni][mi][rg * 4 + 2]), sigmoidf_(acc[ni][mi][rg * 4 + 3]));
            }
        }
    }
}

enum { A_FOX = 0, A_DSA = 1, A_SEL = 2, A_WIN = 3, A_SWA = 4, A_CMP = 5 };
struct AttnDesc {
    const bf16_t* q;
    const bf16_t* k; int ldk;
    const bf16_t* vt; int ldvt;
    int kt_lo, kt_hi;
    int wkt_lo, wkt_hi;
    int tq;
    unsigned tilemask;
    unsigned selm;
    const unsigned* dmask;
    const float* kbias;
    int window;
};
__device__ __forceinline__ float hswap_max(float v) { auto rr = __builtin_amdgcn_permlane32_swap(__float_as_uint(v), __float_as_uint(v), false, false); return fmaxf(__uint_as_float(rr[0]), __uint_as_float(rr[1])); }
__device__ __forceinline__ float hswap_sum(float v) { auto rr = __builtin_amdgcn_permlane32_swap(__float_as_uint(v), __float_as_uint(v), false, false); return __uint_as_float(rr[0]) + __uint_as_float(rr[1]); }

template <int MODE>
__device__ __forceinline__ void attn_core(const AttnDesc& u, f32x16 (&o)[2], float& m_out, float& l_out, char* lds) {
    const int tid = otid(), lane = tid & 63, r32 = lane & 31, hi = lane >> 5;
    char* ldsK = lds; char* ldsV = lds + 64 * TSTR; float* ldsB = (float*)(lds + 2 * 64 * TSTR);
    bf16x8 qf[4];
#pragma unroll
    for (int ds = 0; ds < 4; ++ds) qf[ds] = *(const bf16x8*)(u.q + ds * 16 + hi * 8);
#pragma unroll
    for (int r = 0; r < 16; ++r) { o[0][r] = 0.f; o[1][r] = 0.f; }
    float m = -1e30f, l = 0.f;
    const int lrow = tid >> 3, lch = tid & 7;
    u32x4 rk[2], rv[2]; float rbias = 0.f; u32x2 dm_next = {0u, 0u};
    auto skip_tile = [&](int kt) -> bool { return (MODE == A_SEL) && !((u.tilemask >> kt) & 1u); };
    auto load_regs = [&](int kt) {
#pragma unroll
        for (int i = 0; i < 2; ++i) {
            rk[i] = *(const u32x4*)(u.k + (long)(kt * 64 + lrow + 32 * i) * u.ldk + lch * 8);
            rv[i] = *(const u32x4*)(u.vt + (long)(lrow + 32 * i) * u.ldvt + kt * 64 + lch * 8);
        }
        if (MODE == A_FOX) { if (tid < 64) rbias = u.kbias[kt * 64 + tid]; }
        if (MODE == A_DSA) dm_next = *(const u32x2*)(u.dmask + kt * 2);
    };
    int kt = u.kt_lo;
    while (kt <= u.kt_hi && skip_tile(kt)) ++kt;
    if (kt <= u.kt_hi) load_regs(kt);
    while (kt <= u.kt_hi) {
        __syncthreads();
#pragma unroll
        for (int i = 0; i < 2; ++i) {
            *(u32x4*)(ldsK + (lrow + 32 * i) * TSTR + lch * 16) = rk[i];
            *(u32x4*)(ldsV + (lrow + 32 * i) * TSTR + lch * 16) = rv[i];
        }
        if (MODE == A_FOX) { if (tid < 64) ldsB[tid] = rbias; }
        u32x2 dm = dm_next;
        __syncthreads();
        int ktn = kt + 1;
        while (ktn <= u.kt_hi && skip_tile(ktn)) ++ktn;
        if (ktn <= u.kt_hi) load_regs(ktn);
        if (kt >= u.wkt_lo && kt <= u.wkt_hi) {
            f32x16 p[2];
            if (MODE == A_FOX) {
#pragma unroll
                for (int sub = 0; sub < 2; ++sub)
#pragma unroll
                    for (int rg = 0; rg < 4; ++rg) {
                        f32x4 bv = *(const f32x4*)(ldsB + 32 * sub + 8 * rg + 4 * hi);
                        p[sub][rg * 4 + 0] = bv[0]; p[sub][rg * 4 + 1] = bv[1]; p[sub][rg * 4 + 2] = bv[2]; p[sub][rg * 4 + 3] = bv[3];
                    }
            } else {
#pragma unroll
                for (int r = 0; r < 16; ++r) { p[0][r] = 0.f; p[1][r] = 0.f; }
            }
#pragma unroll
            for (int ds = 0; ds < 4; ++ds) {
                bf16x8 k0 = *(const bf16x8*)(ldsK + r32 * TSTR + ds * 32 + hi * 16);
                bf16x8 k1 = *(const bf16x8*)(ldsK + (32 + r32) * TSTR + ds * 32 + hi * 16);
                p[0] = MFMA32(k0, qf[ds], p[0]);
                p[1] = MFMA32(k1, qf[ds], p[1]);
            }
            const int key0 = kt * 64 + 4 * hi;
            if (MODE == A_FOX || MODE == A_SEL || MODE == A_WIN || MODE == A_SWA || MODE == A_CMP) {
                if (MODE == A_CMP || kt * 64 + 63 > u.tq - r32) {
#pragma unroll
                    for (int sub = 0; sub < 2; ++sub)
#pragma unroll
                        for (int r = 0; r < 16; ++r) { int key = key0 + 32 * sub + (r & 3) + 8 * (r >> 2); if (key > u.tq) p[sub][r] = -INFINITY; }
                }
            }
            if (MODE == A_WIN || MODE == A_SWA) {
                if (kt * 64 <= u.tq - r32 + 31 - u.window) {
#pragma unroll
                    for (int sub = 0; sub < 2; ++sub)
#pragma unroll
                        for (int r = 0; r < 16; ++r) { int key = key0 + 32 * sub + (r & 3) + 8 * (r >> 2); if (key <= u.tq - u.window) p[sub][r] = -INFINITY; }
                }
            }
            if (MODE == A_SEL) {
                if (!((u.selm >> kt) & 1u)) {
#pragma unroll
                    for (int r = 0; r < 16; ++r) { p[0][r] = -INFINITY; p[1][r] = -INFINITY; }
                }
            }
            if (MODE == A_DSA) {
                const unsigned w0 = dm.x >> (4 * hi), w1 = dm.y >> (4 * hi);
#pragma unroll
                for (int r = 0; r < 16; ++r) {
                    const unsigned bit = 1u << ((r & 3) + 8 * (r >> 2));
                    if (!(w0 & bit)) p[0][r] = -INFINITY;
                    if (!(w1 & bit)) p[1][r] = -INFINITY;
                }
            }
            float mloc = p[0][0];
#pragma unroll
            for (int r = 1; r < 16; ++r) mloc = fmaxf(mloc, p[0][r]);
#pragma unroll
            for (int r = 0; r < 16; ++r) mloc = fmaxf(mloc, p[1][r]);
            mloc = hswap_max(mloc);
            const float mn = fmaxf(m, mloc);
            const float alpha = exp2f(m - mn);
            m = mn;
            float ls = 0.f;
#pragma unroll
            for (int sub = 0; sub < 2; ++sub)
#pragma unroll
                for (int r = 0; r < 16; ++r) { float e = exp2f(p[sub][r] - mn); p[sub][r] = e; ls += e; }
            l = l * alpha + ls;
#pragma unroll
            for (int r = 0; r < 16; ++r) { o[0][r] *= alpha; o[1][r] *= alpha; }
#pragma unroll
            for (int ks = 0; ks < 4; ++ks) {
                const int sub = ks >> 1, rb = 8 * (ks & 1);
                u32x4 pw;
                pw.x = cvtpk(p[sub][rb + 0], p[sub][rb + 1]); pw.y = cvtpk(p[sub][rb + 2], p[sub][rb + 3]);
                pw.z = cvtpk(p[sub][rb + 4], p[sub][rb + 5]); pw.w = cvtpk(p[sub][rb + 6], p[sub][rb + 7]);
                const bf16x8 pf = __builtin_bit_cast(bf16x8, pw);
                bf16x8 v0 = *(const bf16x8*)(ldsV + r32 * TSTR + ks * 32 + hi * 16);
                bf16x8 v1 = *(const bf16x8*)(ldsV + (32 + r32) * TSTR + ks * 32 + hi * 16);
                o[0] = MFMA32(v0, pf, o[0]);
                o[1] = MFMA32(v1, pf, o[1]);
            }
        }
        kt = ktn;
    }
    m_out = m; l_out = hswap_sum(l);
    __syncthreads();
}

__device__ void phase_fox(const Params& p, int bid, int nblk, char* lds) {
    const int tid = otid(), lane = tid & 63, w = tid >> 6, r32 = lane & 31, hi = lane >> 5;
    for (int unit = bid; unit < B_ * 4 * 16; unit += nblk) {
        const int qb = 15 - (unit & 15), h = (unit >> 4) & 3, b = unit >> 6;
        const int q0 = qb * 128 + w * 32;
        AttnDesc u{};
        const long row = (long)b * S_ + q0 + r32;
        u.q = p.qb() + row * 256 + h * 64;
        u.k = p.kb() + (long)b * S_ * 256 + h * 64; u.ldk = 256;
        u.vt = p.vbT() + ((long)(b * 4 + h) * 64) * S_; u.ldvt = S_;
        u.kt_lo = 0; u.kt_hi = (qb * 128 + 127) >> 6; u.wkt_lo = 0; u.wkt_hi = (q0 + 31) >> 6;
        u.tq = q0 + r32;
        u.kbias = p.kbias() + (long)(b * 4 + h) * S_;
        f32x16 o[2]; float m, l;
        attn_core<A_FOX>(u, o, m, l, lds);
        const float inv = 1.f / l;
        bf16_t* dst = p.o() + row * D_ + 256 + h * 64;
#pragma unroll
        for (int dh = 0; dh < 2; ++dh)
#pragma unroll
            for (int rg = 0; rg < 4; ++rg)
                st4(dst + dh * 32 + 8 * rg + 4 * hi, o[dh][rg * 4 + 0] * inv, o[dh][rg * 4 + 1] * inv, o[dh][rg * 4 + 2] * inv, o[dh][rg * 4 + 3] * inv);
    }
}
__device__ void phase_cumsum(const Params& p, int bid, int nblk) {
    const int tid = otid(), lane = tid & 63, w = tid >> 6;
    for (int seq = bid * 4 + w; seq < B_ * 4; seq += nblk * 4) {
        const int b = seq >> 2, h = seq & 3;
        float v[32]; float tot = 0.f;
#pragma unroll
        for (int i = 0; i < 32; ++i) { v[i] = p.logf()[((long)b * S_ + lane * 32 + i) * 4 + h]; tot += v[i]; }
        float inc = tot;
#pragma unroll
        for (int o = 1; o < 64; o <<= 1) { float t = __shfl_up(inc, o); if (lane >= o) inc += t; }
        float run = inc - tot;
#pragma unroll
        for (int i = 0; i < 32; ++i) { run += v[i]; p.kbias()[(long)(b * 4 + h) * S_ + lane * 32 + i] = -run * LOG2E; }
    }
}

__device__ void phase_swa(const Params& p, int l, int bid, int nblk, char* lds) {
    const int tid = otid(), lane = tid & 63, w = tid >> 6, r32 = lane & 31, hi = lane >> 5;
    for (int unit = bid; unit < B_ * 2 * 32; unit += nblk) {
        const int qb = unit & 31, kvh = (unit >> 5) & 1, b = unit >> 6;
        const int h = kvh * 2 + (w & 1);
        const int q0 = qb * 64 + 32 * (w >> 1);
        AttnDesc u{};
        const long row = (long)b * S_ + q0 + r32;
        u.q = p.qd() + row * 256 + h * 64;
        u.k = p.kd() + (long)b * S_ * 128 + kvh * 64; u.ldk = 128;
        u.vt = p.vdT() + ((long)(b * 2 + kvh) * 64) * S_; u.ldvt = S_;
        int lo = qb * 64 - 127; if (lo < 0) lo = 0;
        u.kt_lo = lo >> 6; u.kt_hi = qb;
        int wlo = q0 - 127; if (wlo < 0) wlo = 0;
        u.wkt_lo = wlo >> 6; u.wkt_hi = (q0 + 31) >> 6;
        u.tq = q0 + r32; u.window = 128;
        f32x16 o[2]; float m, lsum;
        attn_core<A_SWA>(u, o, m, lsum, lds);
        const float sk = p.swa_sinks[l * 4 + h] * LOG2E;
        const float mn = fmaxf(m, sk); const float a = exp2f(m - mn);
        const float sc = a / (lsum * a + exp2f(sk - mn));
        bf16_t* dst = p.o() + row * D_ + 768 + h * 64;
#pragma unroll
        for (int dh = 0; dh < 2; ++dh)
#pragma unroll
            for (int rg = 0; rg < 4; ++rg)
                st4(dst + dh * 32 + 8 * rg + 4 * hi, o[dh][rg * 4 + 0] * sc, o[dh][rg * 4 + 1] * sc, o[dh][rg * 4 + 2] * sc, o[dh][rg * 4 + 3] * sc);
    }
}
__device__ void phase_win(const Params& p, int bid, int nblk, char* lds) {
    const int tid = otid(), lane = tid & 63, w = tid >> 6, r32 = lane & 31, hi = lane >> 5;
    for (int unit = bid; unit < B_ * 64; unit += nblk) {
        const int qb = unit & 63, b = unit >> 6;
        const int h = w, q0 = qb * 32;
        AttnDesc u{};
        const long row = (long)b * S_ + q0 + r32;
        u.q = p.qa() + row * 256 + h * 64;
        u.k = p.kwin() + (long)b * S_ * 64; u.ldk = 64;
        u.vt = p.vwinT() + ((long)b * 64) * S_; u.ldvt = S_;
        int lo = q0 - 511; if (lo < 0) lo = 0;
        u.kt_lo = lo >> 6; u.kt_hi = (q0 + 31) >> 6; u.wkt_lo = u.kt_lo; u.wkt_hi = u.kt_hi;
        u.tq = q0 + r32; u.window = 512;
        f32x16 o[2]; float m, lsum;
        attn_core<A_WIN>(u, o, m, lsum, lds);
        const float sc = p.ga()[row * 12 + h * 3 + 2] / lsum;
        float* dst = p.owin() + row * 256 + h * 64;
#pragma unroll
        for (int dh = 0; dh < 2; ++dh)
#pragma unroll
            for (int rg = 0; rg < 4; ++rg) {
                f32x4 v = {o[dh][rg * 4 + 0] * sc, o[dh][rg * 4 + 1] * sc, o[dh][rg * 4 + 2] * sc, o[dh][rg * 4 + 3] * sc};
                *(f32x4*)(dst + dh * 32 + 8 * rg + 4 * hi) = v;
            }
    }
}
__device__ void phase_sel(const Params& p, int bid, int nblk, char* lds) {
    const int tid = otid(), lane = tid & 63, w = tid >> 6, r32 = lane & 31, hi = lane >> 5;
    unsigned* lds_or = (unsigned*)(lds + 2 * 64 * TSTR + 512);
    for (int unit = bid; unit < B_ * 32 * 2; unit += nblk) {
        const int hp = unit & 1, qb = 31 - ((unit >> 1) & 31), b = unit >> 6;
        const int h = hp * 2 + (w & 1);
        const int q0 = qb * 64 + 32 * (w >> 1);
        AttnDesc u{};
        const long row = (long)b * S_ + q0 + r32;
        u.q = p.qa() + row * 256 + h * 64;
        u.k = p.ksel() + (long)b * S_ * 64; u.ldk = 64;
        u.vt = p.vselT() + ((long)b * 64) * S_; u.ldvt = S_;
        u.kt_lo = 0; u.kt_hi = qb; u.wkt_lo = 0; u.wkt_hi = qb;
        u.tq = q0 + r32;
        u.selm = p.selmask()[row];
        unsigned orv = u.selm;
#pragma unroll
        for (int o_ = 32; o_ > 0; o_ >>= 1) orv |= (unsigned)__shfl_xor((int)orv, o_);
        __syncthreads();
        if (tid == 0) *lds_or = 0u;
        __syncthreads();
        if (lane == 0) atomicOr(lds_or, orv);
        __syncthreads();
        u.tilemask = *lds_or;
        f32x16 o[2]; float m, lsum;
        attn_core<A_SEL>(u, o, m, lsum, lds);
        const float sc = p.ga()[row * 12 + h * 3 + 1] / lsum;
        const float* oc = p.ocmp() + row * 256 + h * 64; const float* ow = p.owin() + row * 256 + h * 64;
        bf16_t* dst = p.o() + row * D_ + h * 64;
#pragma unroll
        for (int dh = 0; dh < 2; ++dh)
#pragma unroll
            for (int rg = 0; rg < 4; ++rg) {
                const int c = dh * 32 + 8 * rg + 4 * hi;
                f32x4 a = *(const f32x4*)(oc + c), bb = *(const f32x4*)(ow + c);
                st4(dst + c, o[dh][rg * 4 + 0] * sc + a[0] + bb[0], o[dh][rg * 4 + 1] * sc + a[1] + bb[1], o[dh][rg * 4 + 2] * sc + a[2] + bb[2],
                    o[dh][rg * 4 + 3] * sc + a[3] + bb[3]);
            }
    }
}
__device__ void phase_dsa(const Params& p, int bid, int nblk, char* lds) {
    const int tid = otid(), lane = tid & 63, w = tid >> 6, r32 = lane & 31, hi = lane >> 5;
    for (int unit = bid; unit < B_ * 4 * 16; unit += nblk) {
        const int qb = 15 - (unit & 15), h = (unit >> 4) & 3, b = unit >> 6;
        const int q0 = qb * 128 + w * 32;
        AttnDesc u{};
        const long row = (long)b * S_ + q0 + r32;
        u.q = p.qc() + row * 256 + h * 64;
        u.k = p.kcc() + (long)b * S_ * 256 + h * 64; u.ldk = 256;
        u.vt = p.vcT() + ((long)(b * 4 + h) * 64) * S_; u.ldvt = S_;
        u.kt_lo = 0; u.kt_hi = (qb * 128 + 127) >> 6; u.wkt_lo = 0; u.wkt_hi = (q0 + 31) >> 6;
        u.tq = q0 + r32;
        u.dmask = p.dmask() + row * 64;
        f32x16 o[2]; float m, lsum;
        attn_core<A_DSA>(u, o, m, lsum, lds);
        const float inv = 1.f / lsum;
        bf16_t* dst = p.o() + row * D_ + 512 + h * 64;
#pragma unroll
        for (int dh = 0; dh < 2; ++dh)
#pragma unroll
            for (int rg = 0; rg < 4; ++rg)
                st4(dst + dh * 32 + 8 * rg + 4 * hi, o[dh][rg * 4 + 0] * inv, o[dh][rg * 4 + 1] * inv, o[dh][rg * 4 + 2] * inv, o[dh][rg * 4 + 3] * inv);
    }
}
__device__ void phase_kvc(const Params& p, int l, int bid, int nblk, char* lds) {
    const int tid = otid(), lane = tid & 63, w = tid >> 6, r32 = lane & 31;
    const int wm = w & 1, wn = w >> 1;
    float* rsv = (float*)(lds + 2 * 128 * TSTR);
    for (int unit = bid; unit < (T_ / 128) * 4; unit += nblk) {
        const int tn = unit & 3, tm = unit >> 2;
        const int m0 = tm * 128;
        __syncthreads();
        {
            const int row = tid >> 1, half = tid & 1;
            const bf16_t* src = p.ckv() + (long)(m0 + row) * 128 + half * 64;
            float ss = 0.f;
#pragma unroll
            for (int i = 0; i < 8; ++i) {
                u32x4 v = *(const u32x4*)(src + i * 8);
#pragma unroll
                for (int j = 0; j < 4; ++j) { float a = __uint_as_float(v[j] << 16), b2 = __uint_as_float(v[j] & 0xffff0000u); ss += a * a + b2 * b2; }
            }
            ss += __shfl_xor(ss, 1);
            if (half == 0) rsv[row] = rsqrtf(ss / 128.f + 1e-6f);
        }
        f32x16 acc[2][2];
#pragma unroll
        for (int a = 0; a < 2; ++a)
#pragma unroll
            for (int b2 = 0; b2 < 2; ++b2)
#pragma unroll
                for (int r = 0; r < 16; ++r) acc[a][b2][r] = 0.f;
        const bf16_t* A = p.ckv() + (long)m0 * 128;
        const bf16_t* Bt = p.Wukv() + ((long)l * 512 + tn * 128) * 128;
        gemm_core<128, 128, BMODE_BF16_NK>(acc, [&](int r) { return A + (long)r * 128; }, [&](int r) { return Bt + (long)r * 128; }, 128, lds);
#pragma unroll
        for (int mi = 0; mi < 2; ++mi) {
            const float rs = rsv[wm * 64 + mi * 32 + r32];
#pragma unroll
            for (int ni = 0; ni < 2; ++ni)
#pragma unroll
                for (int r = 0; r < 16; ++r) acc[ni][mi][r] *= rs;
        }
        const int g = tn * 2 + wn;
        if (g < 4) epi_tok(acc, m0 + wm * 64, 1, 1.f, p.kcc(), 256, g * 64, p.cs(), p.sn());
        else epi_vt(acc, m0 + wm * 64, p.vcT(), 4, g - 4);
    }
}

#define SC_PER_B 2162688
__device__ __forceinline__ long sc_row_off(int b, int t) { const int qt = t >> 6; return (long)b * SC_PER_B + 2048L * qt * (qt + 1) + (long)(t & 63) * (qt + 1) * 64; }
__device__ void phase_idx(const Params& p, int bid, int nblk, char* lds) {
    const int tid = otid(), lane = tid & 63, w = tid >> 6, r32 = lane & 31, hi = lane >> 5;
    const int qg = w & 1, ksub = w >> 1;
    const int lrow = tid >> 3, lch = tid & 7;
    for (int unit = bid; unit < B_ * 28; unit += nblk) {
        const int qt = 31 - (unit % 28), b = unit / 28;
        const int t = qt * 64 + 32 * qg + r32; const long row = (long)b * S_ + t;
        bf16x8 qf[4][4];
#pragma unroll
        for (int h = 0; h < 4; ++h)
#pragma unroll
            for (int ds = 0; ds < 4; ++ds) qf[h][ds] = *(const bf16x8*)(p.qi() + row * 256 + h * 64 + ds * 16 + hi * 8);
        const f32x4 wv = *(const f32x4*)(p.wi() + row * 4);
        float* dst = p.sc() + sc_row_off(b, t) + 32 * ksub + 4 * hi;
        const bf16_t* kbase = p.ki() + (long)b * S_ * 64;
        u32x4 rk[2];
#pragma unroll
        for (int i = 0; i < 2; ++i) rk[i] = *(const u32x4*)(kbase + (long)(lrow + 32 * i) * 64 + lch * 8);
        for (int kt = 0; kt <= qt; ++kt) {
            __syncthreads();
#pragma unroll
            for (int i = 0; i < 2; ++i) *(u32x4*)(lds + (lrow + 32 * i) * TSTR + lch * 16) = rk[i];
            __syncthreads();
            if (kt < qt) {
#pragma unroll
                for (int i = 0; i < 2; ++i) rk[i] = *(const u32x4*)(kbase + (long)((kt + 1) * 64 + lrow + 32 * i) * 64 + lch * 8);
            }
            bf16x8 kf[4];
#pragma unroll
            for (int ds = 0; ds < 4; ++ds) kf[ds] = *(const bf16x8*)(lds + (32 * ksub + r32) * TSTR + ds * 32 + hi * 16);
            f32x16 score;
#pragma unroll
            for (int r = 0; r < 16; ++r) score[r] = 0.f;
#pragma unroll
            for (int h = 0; h < 4; ++h) {
                f32x16 sacc;
#pragma unroll
                for (int r = 0; r < 16; ++r) sacc[r] = 0.f;
#pragma unroll
                for (int ds = 0; ds < 4; ++ds) sacc = MFMA32(kf[ds], qf[h][ds], sacc);
#pragma unroll
                for (int r = 0; r < 16; ++r) score[r] += wv[h] * fmaxf(sacc[r], 0.f);
            }
#pragma unroll
            for (int rg = 0; rg < 4; ++rg) {
                f32x4 v = {score[rg * 4 + 0], score[rg * 4 + 1], score[rg * 4 + 2], score[rg * 4 + 3]};
                *(f32x4*)(dst + kt * 64 + 8 * rg) = v;
            }
        }
    }
}
__device__ void phase_dsel(const Params& p, int bid, int nblk) {
    const int tid = otid(), lane = tid & 63, w = tid >> 6;
    for (int rowid = bid * 4 + w; rowid < T_; rowid += nblk * 4) {
        const int b = rowid / S_, t = rowid % S_;
        unsigned word;
        if (t < 256) {
            const int lo = 32 * lane;
            word = (lo + 31 <= t) ? 0xffffffffu : (lo <= t ? ((1u << (t - lo + 1)) - 1u) : 0u);
        } else {
            const float* base = p.sc() + sc_row_off(b, t) + 32 * lane;
            unsigned u[32];
            if (32 * lane <= t) {
#pragma unroll
                for (int i = 0; i < 8; ++i) {
                    f32x4 v = *(const f32x4*)(base + 4 * i);
#pragma unroll
                    for (int j = 0; j < 4; ++j) {
                        unsigned bits = __float_as_uint(v[j]);
                        unsigned x = bits ^ ((bits >> 31) ? 0xffffffffu : 0x80000000u);
                        u[4 * i + j] = (32 * lane + 4 * i + j <= t) ? x : 0u;
                    }
                }
            } else {
#pragma unroll
                for (int i = 0; i < 32; ++i) u[i] = 0u;
            }
            unsigned thr = 0u;
            for (int bit = 31; bit >= 0; --bit) {
                const unsigned cand = thr | (1u << bit);
                int cnt = 0;
#pragma unroll
                for (int i = 0; i < 32; ++i) cnt += __builtin_popcountll(__ballot(u[i] >= cand));
                if (cnt >= 256) thr = cand;
            }
            unsigned gt = 0u, eq = 0u;
#pragma unroll
            for (int i = 0; i < 32; ++i) { gt |= (u[i] > thr ? 1u : 0u) << i; eq |= (u[i] == thr ? 1u : 0u) << i; }
            int cg = __builtin_popcount(gt);
#pragma unroll
            for (int o_ = 32; o_ > 0; o_ >>= 1) cg += __shfl_xor(cg, o_);
            const int need = 256 - cg;
            const int e = __builtin_popcount(eq);
            int inc = e;
#pragma unroll
            for (int o_ = 1; o_ < 64; o_ <<= 1) { int tt = __shfl_up(inc, o_); if (lane >= o_) inc += tt; }
            int k = need - (inc - e); if (k > e) k = e;
            unsigned take = 0u, x = eq;
            while (k > 0) { unsigned low = x & (0u - x); take |= low; x ^= low; --k; }
            word = gt | take;
        }
        p.dmask()[(long)rowid * 64 + lane] = word;
    }
}
#define HSTR 528
__device__ __forceinline__ float gelu_tanh_f(float x) {
    const float u = 0.7978845608028654f * (x + 0.044715f * x * x * x);
    const float e = __expf(2.f * u);
    const float th = 1.f - 2.f / (e + 1.f);
    return 0.5f * x * (1.f + th);
}
__device__ void phase_compress(const Params& p, int l, int bid, int nblk, char* lds) {
    const int tid = otid(), lane = tid & 63, w = tid >> 6, r32 = lane & 31, hi = lane >> 5;
    for (int unit = bid; unit < 32; unit += nblk) {
        const int kv = unit & 1, rt = unit >> 1;
        const bf16_t* src = kv ? p.vcmp() : p.kcmp();
        const bf16_t* Bt = p.W1t() + (long)(l * 2 + kv) * 256 * 2048;
        f32x16 acc[2][2];
#pragma unroll
        for (int a = 0; a < 2; ++a)
#pragma unroll
            for (int b2 = 0; b2 < 2; ++b2)
#pragma unroll
                for (int r = 0; r < 16; ++r) acc[a][b2][r] = 0.f;
        gemm_core<64, 256, BMODE_BF16_NK>(acc, [&](int r) { int R = rt * 64 + r; if (R > 1015) R = 1015; const int b = R / NCMP, c = R % NCMP; return src + ((long)b * S_ + 16 * c) * 64; },
                                          [&](int r) { return Bt + (long)r * 2048; }, 2048, lds);
        __syncthreads();
        const float* peb = p.peb() + (l * 2 + kv) * 256;
#pragma unroll
        for (int ni = 0; ni < 2; ++ni)
#pragma unroll
            for (int rg = 0; rg < 4; ++rg) {
                const int n = w * 64 + ni * 32 + 8 * rg + 4 * hi;
                const f32x4 bv = *(const f32x4*)(peb + n);
#pragma unroll
                for (int mi = 0; mi < 2; ++mi) {
                    u32x2 v;
                    v.x = cvtpk(gelu_tanh_f(acc[ni][mi][rg * 4 + 0] + bv[0]), gelu_tanh_f(acc[ni][mi][rg * 4 + 1] + bv[1]));
                    v.y = cvtpk(gelu_tanh_f(acc[ni][mi][rg * 4 + 2] + bv[2]), gelu_tanh_f(acc[ni][mi][rg * 4 + 3] + bv[3]));
                    *(u32x2*)(lds + (mi * 32 + r32) * HSTR + n * 2) = v;
                }
            }
        __syncthreads();
        const int ni2 = w & 1, mi2 = w >> 1;
        const bf16_t* W2 = p.W2t() + (long)(l * 2 + kv) * 64 * 256 + (long)(ni2 * 32 + r32) * 256 + hi * 8;
        f32x16 a2;
#pragma unroll
        for (int r = 0; r < 16; ++r) a2[r] = 0.f;
#pragma unroll
        for (int ks = 0; ks < 16; ++ks) {
            const bf16x8 bf = *(const bf16x8*)(W2 + ks * 16);
            const bf16x8 af = *(const bf16x8*)(lds + (mi2 * 32 + r32) * HSTR + ks * 32 + hi * 16);
            a2 = MFMA32(bf, af, a2);
        }
        const int R = rt * 64 + mi2 * 32 + r32;
        if (R < 1016) {
            const int b = R / NCMP, c = R % NCMP;
            if (kv == 0) {
#pragma unroll
                for (int rg = 0; rg < 4; ++rg) st4(p.kcb() + ((long)b * 128 + c) * 64 + ni2 * 32 + 8 * rg + 4 * hi, a2[rg * 4 + 0], a2[rg * 4 + 1], a2[rg * 4 + 2], a2[rg * 4 + 3]);
            } else {
#pragma unroll
                for (int r = 0; r < 16; ++r) p.vcbT()[((long)b * 64 + ni2 * 32 + crow(r, hi)) * 128 + vtpos(c)] = f2bf(a2[r]);
            }
        }
        __syncthreads();
    }
}
__device__ void phase_cmp(const Params& p, int bid, int nblk, char* lds) {
    const int tid = otid(), lane = tid & 63, w = tid >> 6, r32 = lane & 31, hi = lane >> 5;
    float* slab = (float*)(lds + 20480);
    for (int unit = bid; unit < B_ * 64; unit += nblk) {
        const int qb = unit & 63, b = unit >> 6;
        const int h = w, q0 = qb * 32;
        AttnDesc u{};
        const int t = q0 + r32; const long row = (long)b * S_ + t;
        u.q = p.qa() + row * 256 + h * 64;
        u.k = p.kcb() + (long)b * 128 * 64; u.ldk = 64;
        u.vt = p.vcbT() + (long)b * 64 * 128; u.ldvt = 128;
        int lim = (t - 31) >> 4; if (lim > 126) lim = 126;
        int maxlim = (q0 + 31 - 31) >> 4; if (maxlim > 126) maxlim = 126;
        u.kt_lo = 0; u.kt_hi = (maxlim >= 64) ? 1 : 0; u.wkt_lo = 0; u.wkt_hi = u.kt_hi;
        u.tq = lim;
        f32x16 o[2]; float m, lsum;
        attn_core<A_CMP>(u, o, m, lsum, lds);
        const float inv = (lsum > 0.f) ? 1.f / lsum : 0.f;
        {
            const float sc = p.ga()[row * 12 + h * 3 + 0] * inv;
            float* dst = p.ocmp() + row * 256 + h * 64;
#pragma unroll
            for (int dh = 0; dh < 2; ++dh)
#pragma unroll
                for (int rg = 0; rg < 4; ++rg) {
                    f32x4 v = {o[dh][rg * 4 + 0] * sc, o[dh][rg * 4 + 1] * sc, o[dh][rg * 4 + 2] * sc, o[dh][rg * 4 + 3] * sc};
                    *(f32x4*)(dst + dh * 32 + 8 * rg + 4 * hi) = v;
                }
        }
        {
            const int lrow = tid >> 3, lch = tid & 7;
#pragma unroll
            for (int i = 0; i < 4; ++i) *(u32x4*)(lds + (lrow + 32 * i) * TSTR + lch * 16) = *(const u32x4*)(u.k + (long)(lrow + 32 * i) * 64 + lch * 8);
        }
        __syncthreads();
        bf16x8 qf[4];
#pragma unroll
        for (int ds = 0; ds < 4; ++ds) qf[ds] = *(const bf16x8*)(u.q + ds * 16 + hi * 8);
        float G[16], Lst[16];
#pragma unroll
        for (int s4 = 0; s4 < 4; ++s4) {
            f32x16 sa;
#pragma unroll
            for (int r = 0; r < 16; ++r) sa[r] = 0.f;
#pragma unroll
            for (int ds = 0; ds < 4; ++ds) sa = MFMA32(*(const bf16x8*)(lds + (32 * s4 + r32) * TSTR + ds * 32 + hi * 16), qf[ds], sa);
#pragma unroll
            for (int rg = 0; rg < 4; ++rg) {
                float g = 0.f, last = 0.f;
#pragma unroll
                for (int j = 0; j < 4; ++j) {
                    const int c = 32 * s4 + 8 * rg + 4 * hi + j;
                    const float pn = (c <= lim) ? exp2f(sa[rg * 4 + j] - m) * inv : 0.f;
                    g += pn; last = pn;
                }
                G[s4 * 4 + rg] = g; Lst[s4 * 4 + rg] = last;
            }
        }
        float* myslab = slab + (h * 32 + r32) * 33;
#pragma unroll
        for (int i = 0; i < 16; ++i) { const int jj = 8 * (i >> 2) + 2 * (i & 3) + hi; myslab[jj] = G[i]; }
        __builtin_amdgcn_s_waitcnt(0xc07f);
#pragma unroll
        for (int i = 0; i < 16; ++i) { const int jj = 8 * (i >> 2) + 2 * (i & 3) + hi; if (jj + 1 < 32) atomicAdd(&myslab[jj + 1], Lst[i]); }
        __syncthreads();
        if (tid < 32) {
            const int q = tid; const int tt = q0 + q; const int cur = tt >> 6;
            float* rowp = slab + q * 33;
            for (int j = 0; j < 32; ++j) {
                float a = slab[(0 * 32 + q) * 33 + j] + slab[(1 * 32 + q) * 33 + j] + slab[(2 * 32 + q) * 33 + j] + slab[(3 * 32 + q) * 33 + j];
                if (j == 0 || j == cur || j == cur - 1) a = 1e4f;
                if (j > cur) a = -1e4f;
                rowp[j] = a;
            }
            unsigned msk = 0u;
            for (int j = 0; j < 32; ++j) {
                const float v = rowp[j]; int rank = 0;
                for (int j2 = 0; j2 < 32; ++j2) { const float uu = rowp[j2]; rank += (uu > v) || (uu == v && j2 < j); }
                if (rank < 16) msk |= 1u << j;
            }
            p.selmask()[(long)b * S_ + tt] = msk;
        }
        __syncthreads();
    }
}

__device__ void phase_merge(const Params& p, int l, int bid, int nblk, char* lds) {
    const int tid = otid(), lane = tid & 63, w = tid >> 6, r32 = lane & 31, hi = lane >> 5;
    const int wm = w & 1, wn = w >> 1;
    for (int tile = bid; tile < 8 * (T_ / 128); tile += nblk) {
        const int tn = tile / (T_ / 128), tm = tile % (T_ / 128);
        const int m0 = tm * 128, n0 = tn * 128;
        f32x16 acc[2][2], tot[2][2];
#pragma unroll
        for (int a = 0; a < 2; ++a)
#pragma unroll
            for (int b2 = 0; b2 < 2; ++b2)
#pragma unroll
                for (int r = 0; r < 16; ++r) { acc[a][b2][r] = 0.f; tot[a][b2][r] = 0.f; }
        const bf16_t* A = p.o() + (long)m0 * D_;
        const bf16_t* Bt = p.Wbt() + ((long)l * 1024 + n0) * 1024;
        auto hook = [&](int kt) {
            if ((kt & 3) == 3) {
                const int i = kt >> 2;
#pragma unroll
                for (int mi = 0; mi < 2; ++mi) {
                    const bf16_t* gp = p.gates() + (long)(m0 + wm * 64 + mi * 32 + r32) * 4096 + i * 1024 + n0 + wn * 64 + 4 * hi;
#pragma unroll
                    for (int ni = 0; ni < 2; ++ni)
#pragma unroll
                        for (int rg = 0; rg < 4; ++rg) {
                            const u32x2 gv = *(const u32x2*)(gp + ni * 32 + 8 * rg);
                            tot[ni][mi][rg * 4 + 0] += acc[ni][mi][rg * 4 + 0] * __uint_as_float(gv.x << 16);
                            tot[ni][mi][rg * 4 + 1] += acc[ni][mi][rg * 4 + 1] * __uint_as_float(gv.x & 0xffff0000u);
                            tot[ni][mi][rg * 4 + 2] += acc[ni][mi][rg * 4 + 2] * __uint_as_float(gv.y << 16);
                            tot[ni][mi][rg * 4 + 3] += acc[ni][mi][rg * 4 + 3] * __uint_as_float(gv.y & 0xffff0000u);
                            acc[ni][mi][rg * 4 + 0] = 0.f; acc[ni][mi][rg * 4 + 1] = 0.f; acc[ni][mi][rg * 4 + 2] = 0.f; acc[ni][mi][rg * 4 + 3] = 0.f;
                        }
                }
            }
        };
        gemm_core<128, 128, BMODE_BF16_NK>(acc, [&](int r) { return A + (long)r * D_; }, [&](int r) { return Bt + (long)r * 1024; }, 1024, lds, hook);
#pragma unroll
        for (int mi = 0; mi < 2; ++mi) {
            bf16_t* dst = p.merged() + (long)(m0 + wm * 64 + mi * 32 + r32) * D_ + n0 + wn * 64 + 4 * hi;
#pragma unroll
            for (int ni = 0; ni < 2; ++ni)
#pragma unroll
                for (int rg = 0; rg < 4; ++rg) st4(dst + ni * 32 + 8 * rg, tot[ni][mi][rg * 4 + 0], tot[ni][mi][rg * 4 + 1], tot[ni][mi][rg * 4 + 2], tot[ni][mi][rg * 4 + 3]);
        }
    }
}
__device__ void phase_outproj(const Params& p, int l, int bid, int nblk, char* lds) {
    const int tid = otid(), lane = tid & 63, w = tid >> 6, r32 = lane & 31, hi = lane >> 5;
    const int wm = w & 1, wn = w >> 1;
    for (int tile = bid; tile < 8 * (T_ / 128); tile += nblk) {
        const int tn = tile / (T_ / 128), tm = tile % (T_ / 128);
        const int m0 = tm * 128, n0 = tn * 128;
        f32x16 acc[2][2];
#pragma unroll
        for (int a = 0; a < 2; ++a)
#pragma unroll
            for (int b2 = 0; b2 < 2; ++b2)
#pragma unroll
                for (int r = 0; r < 16; ++r) acc[a][b2][r] = 0.f;
        const bf16_t* A = p.merged() + (long)m0 * D_;
        const bf16_t* Bt = p.Wot() + ((long)l * 1024 + n0) * 1024;
        gemm_core<128, 128, BMODE_BF16_NK>(acc, [&](int r) { return A + (long)r * D_; }, [&](int r) { return Bt + (long)r * 1024; }, 1024, lds);
#pragma unroll
        for (int mi = 0; mi < 2; ++mi) {
            float* dst = p.h() + (long)(m0 + wm * 64 + mi * 32 + r32) * D_ + n0 + wn * 64 + 4 * hi;
#pragma unroll
            for (int ni = 0; ni < 2; ++ni)
#pragma unroll
                for (int rg = 0; rg < 4; ++rg) {
                    f32x4 v = *(f32x4*)(dst + ni * 32 + 8 * rg);
                    v[0] += acc[ni][mi][rg * 4 + 0]; v[1] += acc[ni][mi][rg * 4 + 1]; v[2] += acc[ni][mi][rg * 4 + 2]; v[3] += acc[ni][mi][rg * 4 + 3];
                    *(f32x4*)(dst + ni * 32 + 8 * rg) = v;
                }
        }
    }
}
__device__ void phase_router(const Params& p, int l, int bid, int nblk, char* lds) {
    const int tid = otid(), lane = tid & 63, w = tid >> 6;
    const int ti = lane & 15, kq = lane >> 4;
    float* lgw = (float*)lds + w * (16 * 81);
    const float* Wr = p.Wrt() + (long)l * 80 * 1024;
    for (int task = bid * 4 + w; task < T_ / 16; task += nblk * 4) {
        const int t0 = task * 16;
        const float* xr = p.h() + (long)(t0 + ti) * D_ + 4 * kq;
        f32x4 acc[5];
#pragma unroll
        for (int nt = 0; nt < 5; ++nt) acc[nt] = (f32x4){0.f, 0.f, 0.f, 0.f};
        float ss = 0.f;
        for (int k0 = 0; k0 < D_; k0 += 16) {
            const f32x4 xa = *(const f32x4*)(xr + k0);
            ss += xa[0] * xa[0] + xa[1] * xa[1] + xa[2] * xa[2] + xa[3] * xa[3];
#pragma unroll
            for (int nt = 0; nt < 5; ++nt) {
                const f32x4 wb = *(const f32x4*)(Wr + (long)(nt * 16 + ti) * 1024 + k0 + 4 * kq);
#pragma unroll
                for (int s_ = 0; s_ < 4; ++s_) acc[nt] = __builtin_amdgcn_mfma_f32_16x16x4f32(xa[s_], wb[s_], acc[nt], 0, 0, 0);
            }
        }
        ss += __shfl_xor(ss, 16); ss += __shfl_xor(ss, 32);
        const float rs = rsqrtf(ss / (float)D_ + 1e-6f);
        for (int k0 = 0; k0 < D_; k0 += 16) {
            const f32x4 xa = *(const f32x4*)(xr + k0);
            const f32x4 g = *(const f32x4*)(p.ffn_norm + l * D_ + k0 + 4 * kq);
            st4(p.hn() + (long)(t0 + ti) * D_ + k0 + 4 * kq, xa[0] * rs * g[0], xa[1] * rs * g[1], xa[2] * rs * g[2], xa[3] * rs * g[3]);
        }
#pragma unroll
        for (int reg = 0; reg < 4; ++reg) {
            const int tok = 4 * kq + reg;
            const float rst = __shfl(rs, tok);
#pragma unroll
            for (int nt = 0; nt < 5; ++nt) lgw[tok * 81 + nt * 16 + ti] = acc[nt][reg] * rst;
        }
        __builtin_amdgcn_s_waitcnt(0xc07f);
        if (lane < 16) {
            const float* lg = lgw + lane * 81;
            float g[8]; float mx = -1e30f; int gi = 0;
#pragma unroll
            for (int i = 0; i < 8; ++i) { g[i] = lg[i] + p.moe_b_group[l * 8 + i]; if (g[i] > mx) { mx = g[i]; gi = i; } }
            float den = 0.f;
#pragma unroll
            for (int i = 0; i < 8; ++i) den += expf(g[i] - mx);
            const float pg = 1.f / den;
            float v0 = -1e30f, v1 = -1e30f; int i0 = 0, i1 = 0;
            for (int i = 0; i < 8; ++i) { const float e = lg[8 + gi * 8 + i] + p.moe_b_expert[l * 64 + gi * 8 + i]; if (e > v0) { v1 = v0; i1 = i0; v0 = e; i0 = i; } else if (e > v1) { v1 = e; i1 = i; } }
            const float x = expf(v1 - v0);
            const float w0 = pg / (1.f + x), w1 = pg * x / (1.f + x);
            const int t = t0 + lane;
            const int e0 = gi * 8 + i0, e1 = gi * 8 + i1;
            unsigned* cnt = p.ecnt() + l * 64;
            const unsigned p0 = atomicAdd(&cnt[e0], 1u);
            p.elist()[(long)e0 * T_ + p0] = t * 2;
            const unsigned p1 = atomicAdd(&cnt[e1], 1u);
            p.elist()[(long)e1 * T_ + p1] = t * 2 + 1;
            p.slotw()[t * 2] = w0; p.slotw()[t * 2 + 1] = w1;
        }
        __builtin_amdgcn_s_waitcnt(0xc07f);
    }
}
__device__ __forceinline__ int moe_tiles(const Params& p, int l, int* tstart  ) {
    __syncthreads();
    if (otid() == 0) {
        int acc = 0;
        for (int e = 0; e < 64; ++e) { tstart[e] = acc; acc += (int)((p.ecnt()[l * 64 + e] + 127u) >> 7); }
        tstart[64] = acc;
    }
    __syncthreads();
    return tstart[64];
}
__device__ __forceinline__ int moe_find(const int* tstart, int ti) { int e = 0; for (int i = 0; i < 64; ++i) if (tstart[i + 1] <= ti) e = i + 1; return e; }
__device__ void phase_moe_up(const Params& p, int l, int bid, int nblk, char* lds) {
    const int tid = otid(), lane = tid & 63, w = tid >> 6, r32 = lane & 31, hi = lane >> 5;
    const int wm = w & 1, wn = w >> 1;
    int* tstart = (int*)(lds + 2 * 128 * TSTR);
    const int ntl = moe_tiles(p, l, tstart);
    for (int unit = bid; unit < ntl * 4; unit += nblk) {
        const int nt = unit & 3, ti = unit >> 2;
        const int e = moe_find(tstart, ti); const int rt = ti - tstart[e];
        const int cnt = (int)p.ecnt()[l * 64 + e];
        const int* lst = p.elist() + (long)e * T_;
        f32x16 acc[2][2];
#pragma unroll
        for (int a = 0; a < 2; ++a)
#pragma unroll
            for (int b2 = 0; b2 < 2; ++b2)
#pragma unroll
                for (int r = 0; r < 16; ++r) acc[a][b2][r] = 0.f;
        const float* wgate = p.moe_w_gate + ((long)l * 64 + e) * 1024 * 256;
        const float* wup = p.moe_w_up + ((long)l * 64 + e) * 1024 * 256;
        gemm_core<128, 128, BMODE_F32_KN>(acc,
            [&](int r) { int rr = rt * 128 + r; if (rr >= cnt) rr = 0; const int slot = lst[rr]; return p.hn() + (long)(slot >> 1) * D_; },
            [&](int nb, int& ld) { ld = 256; const int col = nt * 64 + (nb >> 6) * 32 + (nb & 31); return ((nb & 32) ? wup : wgate) + col; },
            1024, lds);
#pragma unroll
        for (int mi = 0; mi < 2; ++mi) {
            bf16_t* dst = p.hid() + ((long)ti * 128 + wm * 64 + mi * 32 + r32) * 256 + nt * 64 + wn * 32 + 4 * hi;
#pragma unroll
            for (int rg = 0; rg < 4; ++rg) {
                float v[4];
#pragma unroll
                for (int j = 0; j < 4; ++j) { const float g = acc[0][mi][rg * 4 + j], uu = acc[1][mi][rg * 4 + j]; v[j] = g / (1.f + __expf(-g)) * uu; }
                st4(dst + 8 * rg, v[0], v[1], v[2], v[3]);
            }
        }
    }
}
__device__ void phase_moe_down(const Params& p, int l, int bid, int nblk, char* lds) {
    const int tid = otid(), lane = tid & 63, w = tid >> 6, r32 = lane & 31, hi = lane >> 5;
    const int wm = w & 1, wn = w >> 1;
    int* tstart = (int*)(lds + 2 * 128 * TSTR);
    const int ntl = moe_tiles(p, l, tstart);
    for (int unit = bid; unit < ntl * 8; unit += nblk) {
        const int nt = unit & 7, ti = unit >> 3;
        const int e = moe_find(tstart, ti); const int rt = ti - tstart[e];
        const int cnt = (int)p.ecnt()[l * 64 + e];
        const int* lst = p.elist() + (long)e * T_;
        f32x16 acc[2][2];
#pragma unroll
        for (int a = 0; a < 2; ++a)
#pragma unroll
            for (int b2 = 0; b2 < 2; ++b2)
#pragma unroll
                for (int r = 0; r < 16; ++r) acc[a][b2][r] = 0.f;
        const bf16_t* A = p.hid() + (long)ti * 128 * 256;
        const float* wd = p.moe_w_down + ((long)l * 64 + e) * 256 * 1024 + nt * 128;
        gemm_core<128, 128, BMODE_F32_KN>(acc, [&](int r) { return A + (long)r * 256; }, [&](int nb, int& ld) { ld = 1024; return wd + nb; }, 256, lds);
#pragma unroll
        for (int mi = 0; mi < 2; ++mi) {
            const int rr = rt * 128 + wm * 64 + mi * 32 + r32;
            if (rr < cnt) {
                const int slot = lst[rr]; const float wgt = p.slotw()[slot];
                bf16_t* dst = p.y() + (long)slot * D_ + nt * 128 + wn * 64 + 4 * hi;
#pragma unroll
                for (int ni = 0; ni < 2; ++ni)
#pragma unroll
                    for (int rg = 0; rg < 4; ++rg)
                        st4(dst + ni * 32 + 8 * rg, acc[ni][mi][rg * 4 + 0] * wgt, acc[ni][mi][rg * 4 + 1] * wgt, acc[ni][mi][rg * 4 + 2] * wgt, acc[ni][mi][rg * 4 + 3] * wgt);
            }
        }
    }
}
__device__ void phase_combine(const Params& p, int lnext, int bid, int nblk) {
    const int tid = otid(), lane = tid & 63, w = tid >> 6;
    for (int row = bid * 4 + w; row < T_; row += nblk * 4) {
        f32x4 v[4]; float ss = 0.f;
#pragma unroll
        for (int i = 0; i < 4; ++i) {
            const int c = i * 256 + lane * 4;
            v[i] = *(const f32x4*)(p.h() + (long)row * D_ + c);
            const u32x2 a = *(const u32x2*)(p.y() + (long)(row * 2) * D_ + c), b2 = *(const u32x2*)(p.y() + (long)(row * 2 + 1) * D_ + c);
            v[i][0] += __uint_as_float(a.x << 16) + __uint_as_float(b2.x << 16);
            v[i][1] += __uint_as_float(a.x & 0xffff0000u) + __uint_as_float(b2.x & 0xffff0000u);
            v[i][2] += __uint_as_float(a.y << 16) + __uint_as_float(b2.y << 16);
            v[i][3] += __uint_as_float(a.y & 0xffff0000u) + __uint_as_float(b2.y & 0xffff0000u);
            ss += v[i][0] * v[i][0] + v[i][1] * v[i][1] + v[i][2] * v[i][2] + v[i][3] * v[i][3];
        }
        for (int o_ = 32; o_ > 0; o_ >>= 1) ss += __shfl_xor(ss, o_);
        const float rs = rsqrtf(ss / (float)D_ + 1e-6f);
#pragma unroll
        for (int i = 0; i < 4; ++i) {
            const int c = i * 256 + lane * 4;
            if (lnext < 2) {
                const f32x4 g = *(const f32x4*)(p.attn_norm + lnext * D_ + c);
                *(f32x4*)(p.h() + (long)row * D_ + c) = v[i];
                st4(p.hn() + (long)row * D_ + c, v[i][0] * rs * g[0], v[i][1] * rs * g[1], v[i][2] * rs * g[2], v[i][3] * rs * g[3]);
            } else {
                const f32x4 g = *(const f32x4*)(p.final_norm + c);
                f32x4 ov = {v[i][0] * rs * g[0], v[i][1] * rs * g[1], v[i][2] * rs * g[2], v[i][3] * rs * g[3]};
                *(f32x4*)(p.out + (long)row * D_ + c) = ov;
            }
        }
    }
}

__device__ __forceinline__ Params opq(Params p) { asm volatile("" : "+s"(p.ws)); return p; }
__global__ __launch_bounds__(256, 2) void k_mega(Params p) {
    __shared__ __attribute__((aligned(16))) char lds[49152];
    __shared__ uint4 xbw;
    cg::grid_group grid = cg::this_grid();
    const int bid = blockIdx.x, nblk = gridDim.x;
    if (threadIdx.x == 0) xbw = make_uint4(0u, 0u, 0u, 0u);
    __syncthreads();
    XcdBarrier xb = xcd_barrier_post(p.bar(), (volatile LAS unsigned*)&xbw);
    auto rot = [&](int off) { return osgpr((bid + off) % nblk); };
    phase_prep(opq(p), osgpr(bid), nblk, lds);
    phase_norm(opq(p), 0, osgpr(bid), nblk);
    grid.sync();
    for (int l = 0; l < 2; ++l) {
        phase_inproj(opq(p), l, osgpr(bid), nblk, lds);
        xcd_barrier(xb);
        phase_idx(opq(p), osgpr(bid), nblk, lds);
        phase_compress(opq(p), l, rot(32), nblk, lds);
        phase_kvc(opq(p), l, osgpr(bid), nblk, lds);
        phase_cumsum(opq(p), rot(64), nblk);
        phase_swa(opq(p), l, rot(256), nblk, lds);
        phase_win(opq(p), rot(256), nblk, lds);
        xcd_barrier(xb);
        phase_cmp(opq(p), osgpr(bid), nblk, lds);
        phase_fox(opq(p), osgpr(bid), nblk, lds);
        phase_dsel(opq(p), osgpr(bid), nblk);
        xcd_barrier(xb);
        phase_sel(opq(p), osgpr(bid), nblk, lds);
        phase_dsa(opq(p), rot(256), nblk, lds);
        xcd_barrier(xb);
        phase_merge(opq(p), l, osgpr(bid), nblk, lds);
        xcd_barrier(xb);
        phase_outproj(opq(p), l, osgpr(bid), nblk, lds);
        xcd_barrier(xb);
        phase_router(opq(p), l, osgpr(bid), nblk, lds);
        xcd_barrier(xb);
        phase_moe_up(opq(p), l, osgpr(bid), nblk, lds);
        xcd_barrier(xb);
        phase_moe_down(opq(p), l, osgpr(bid), nblk, lds);
        xcd_barrier(xb);
        phase_combine(opq(p), l + 1, osgpr(bid), nblk);
        if (l == 0) xcd_barrier(xb);
    }
}

extern "C" void kernel_launch(void* const* d_in, const int* in_sizes, int n_in, void* d_out, int out_size, void* d_ws, size_t ws_size,
                              hipStream_t stream) {
    Params p{};
    p.x = (const float*)d_in[0]; p.positions = (const int*)d_in[1]; p.attn_norm = (const float*)d_in[2]; p.w_in = (const float*)d_in[3];
    p.nsa_pe_k = (const float*)d_in[4]; p.nsa_w1_k = (const float*)d_in[5]; p.nsa_w2_k = (const float*)d_in[6];
    p.nsa_pe_v = (const float*)d_in[7]; p.nsa_w1_v = (const float*)d_in[8]; p.nsa_w2_v = (const float*)d_in[9];
    p.fox_bias = (const float*)d_in[10]; p.dsa_kv_norm = (const float*)d_in[11]; p.dsa_w_ukv = (const float*)d_in[12]; p.swa_sinks = (const float*)d_in[13];
    p.w_branch = (const float*)d_in[14]; p.w_gate = (const float*)d_in[15]; p.w_out = (const float*)d_in[16]; p.ffn_norm = (const float*)d_in[17];
    p.moe_w_group = (const float*)d_in[18]; p.moe_b_group = (const float*)d_in[19]; p.moe_w_expert = (const float*)d_in[20]; p.moe_b_expert = (const float*)d_in[21];
    p.moe_w_gate = (const float*)d_in[22]; p.moe_w_up = (const float*)d_in[23]; p.moe_w_down = (const float*)d_in[24]; p.final_norm = (const float*)d_in[25];
    p.out = (float*)d_out;

    p.ws = (char*)d_ws;

    hipMemsetAsync(p.ws + OFF_bar, 0, XCD_BAR_WORDS * 4, stream);
    static int grid_blocks = 0;
    if (!grid_blocks) {
        int dev = 0, cus = 0, per_cu = 0;
        hipGetDevice(&dev);
        hipDeviceGetAttribute(&cus, hipDeviceAttributeMultiprocessorCount, dev);
        hipOccupancyMaxActiveBlocksPerMultiprocessor(&per_cu, k_mega, 256, 0);
        if (per_cu > 2) per_cu = 2;
        if (per_cu < 1) per_cu = 1;
        grid_blocks = cus * per_cu;
    }
    void* args[] = {(void*)&p};
    hipLaunchCooperativeKernel((void*)k_mega, dim3(grid_blocks), dim3(256), args, 0, stream);
}
```

```cpp
#include <hip/hip_runtime.h>
#ifndef DIAG_K
#define DIAG_K -1
#endif
#ifndef DIAG_PH
#define DIAG_PH 0
#endif
#include <hip/hip_cooperative_groups.h>
#include <stdint.h>
namespace cg = cooperative_groups;

typedef unsigned short bf16_t;
__device__ __forceinline__ float bf2f(bf16_t b) { return __uint_as_float((unsigned)b << 16); }
__device__ __forceinline__ float ldf(const float* p, long i) { return p[i]; }
__device__ __forceinline__ float ldf(const bf16_t* p, long i) { return bf2f(p[i]); }
__device__ __forceinline__ int vtpos(int t) { int x = t & 15; int sub = x >> 2; int ns = ((sub & 1) << 1) | (sub >> 1); return (t & ~15) | (ns << 2) | (x & 3); }
#define LOG2E 1.4426950408889634f
__device__ __forceinline__ bf16_t f2bf_host_dev(float x) { unsigned u = __float_as_uint(x); u += 0x7fffu + ((u >> 16) & 1u); return (bf16_t)(u >> 16); }

#define B_ 8
#define S_ 2048
#define D_ 1024
#define T_ (B_ * S_)
#define DIN 2644
#define O_QA 0
#define O_KCMP 256
#define O_VCMP 320
#define O_KSEL 384
#define O_VSEL 448
#define O_KWIN 512
#define O_VWIN 576
#define O_GA 640
#define O_QB 652
#define O_KB 908
#define O_VB 1164
#define O_FB 1420
#define O_QC 1424
#define O_CKV 1680
#define O_QI 1808
#define O_KI 2064
#define O_WI 2128
#define O_QD 2132
#define O_KD 2388
#define O_VD 2516
#define NCMP 127

#define XB_TMO 128
#define XB_XCNT(j) (256 + 64 * (j))
#define XB_XSUB(j) (1280 + 64 * (j))
#define XB_XGEN(j) (2304 + 64 * (j))
#define XB_TOP 3328
#define XB_TOPGEN 3392
#define XCD_BAR_WORDS 3456
#define XB_SPIN_CAP (1u << 18)
#define LAS __attribute__((address_space(3)))
__device__ __forceinline__ unsigned xb_ld(unsigned* p) { return __hip_atomic_load(p, __ATOMIC_RELAXED, __HIP_MEMORY_SCOPE_AGENT); }
__device__ __forceinline__ unsigned xb_add(unsigned* p, unsigned v) { return __hip_atomic_fetch_add(p, v, __ATOMIC_RELAXED, __HIP_MEMORY_SCOPE_AGENT); }
__device__ __forceinline__ unsigned xb_xcc_id() { return (unsigned)__builtin_amdgcn_s_getreg((3 << 11) | 20) & 0xFu; }
#define XB_SPIN(cond, bar) do { unsigned _sp = 0; while (cond) { __builtin_amdgcn_s_sleep(1); \
    if ((++_sp & 255u) == 0u) { if (xb_ld(&(bar)[XB_TMO])) break; if (_sp > XB_SPIN_CAP) { atomicAdd(&(bar)[XB_TMO], 1u); break; } } } } while (0)
struct XcdBarrier { unsigned* bar; unsigned x; volatile LAS unsigned* st; };
__device__ __forceinline__ XcdBarrier xcd_barrier_post(unsigned* bar, volatile LAS unsigned* st) {
    XcdBarrier b; b.bar = bar; b.x = xb_xcc_id(); b.st = st;
    if (threadIdx.x == 0) (void)xb_add(&bar[XB_XCNT(b.x)], 1u);
    return b;
}
__device__ __forceinline__ void xb_st(unsigned* p, unsigned v) { __hip_atomic_store(p, v, __ATOMIC_RELAXED, __HIP_MEMORY_SCOPE_AGENT); }
__device__ __forceinline__ void xcd_barrier_complete(unsigned* bar, unsigned x, unsigned& nloc, unsigned& nx, unsigned& mask) {
    const unsigned G = gridDim.x * gridDim.y * gridDim.z;
    unsigned sum, cnt, mine, mk, sp = 0u;
    for (;;) {
        sum = 0u; cnt = 0u; mine = 0u; mk = 0u;
#pragma unroll
        for (unsigned j = 0; j < 16; ++j) { const unsigned c = xb_ld(&bar[XB_XCNT(j)]); sum += c; cnt += (c > 0u) ? 1u : 0u; mk |= (c > 0u) ? (1u << j) : 0u; mine = (j == x) ? c : mine; }
        if (sum == G) break;
        __builtin_amdgcn_s_sleep(1);
        if ((++sp & 255u) == 0u) { if (xb_ld(&bar[XB_TMO])) break; if (sp > XB_SPIN_CAP) { atomicAdd(&bar[XB_TMO], 1u); break; } }
    }
    nloc = mine > 0u ? mine : 1u; nx = cnt > 0u ? cnt : 1u; mask = mk;
}
__device__ __forceinline__ void xcd_barrier_impl(const XcdBarrier& b) {
    asm volatile("s_waitcnt vmcnt(0)" ::: "memory");
    __syncthreads();
    if (threadIdx.x == 0) {
        unsigned* bar = b.bar;
        __builtin_amdgcn_s_waitcnt(0);
        unsigned nloc = b.st[0], nx = b.st[1], mask = b.st[2];
        if (nloc == 0u) { xcd_barrier_complete(bar, b.x, nloc, nx, mask); b.st[0] = nloc; b.st[1] = nx; b.st[2] = mask; }
        const unsigned old = xb_add(&bar[XB_XSUB(b.x)], 1u);
        const unsigned gen = old / nloc;
        if (old + 1u == (gen + 1u) * nloc) {
            __builtin_amdgcn_fence(__ATOMIC_RELEASE, "agent");
            asm volatile("s_waitcnt vmcnt(0)" ::: "memory");
            xb_st(&bar[XB_TOP + b.x], gen + 1u);
        }
        unsigned sp = 0u;
        for (;;) {
            unsigned ok = 1u;
#pragma unroll
            for (unsigned j = 0; j < 16; ++j) { const unsigned v = xb_ld(&bar[XB_TOP + j]); ok &= (((mask >> j) & 1u) == 0u || (int)(v - (gen + 1u)) >= 0) ? 1u : 0u; }
            if (ok) break;
            __builtin_amdgcn_s_sleep(1);
            if ((++sp & 255u) == 0u) { if (xb_ld(&bar[XB_TMO])) break; if (sp > XB_SPIN_CAP) { atomicAdd(&bar[XB_TMO], 1u); break; } }
        }
        __builtin_amdgcn_fence(__ATOMIC_ACQUIRE, "agent");
        asm volatile("s_waitcnt vmcnt(0)" ::: "memory");
    }
    __syncthreads();
}

__device__ __forceinline__ void xcd_barrier2(char* ws, volatile LAS unsigned* st) {
    XcdBarrier b; b.bar = (unsigned*)ws; b.x = xb_xcc_id(); b.st = st;
    xcd_barrier_impl(b);
}
__device__ __forceinline__ int otid() { int t = threadIdx.x; asm volatile("" : "+v"(t)); return t; }
__device__ __forceinline__ int osgpr(int v) { asm volatile("" : "+s"(v)); return v; }
typedef short bf16x8 __attribute__((ext_vector_type(8)));
typedef float f32x16 __attribute__((ext_vector_type(16)));
typedef float f32x4 __attribute__((ext_vector_type(4)));
typedef unsigned u32x4 __attribute__((ext_vector_type(4)));
typedef unsigned u32x2 __attribute__((ext_vector_type(2)));
#define MFMA32(a, b, c) __builtin_amdgcn_mfma_f32_32x32x16_bf16(a, b, c, 0, 0, 0)
__device__ __forceinline__ unsigned cvtpk(float lo, float hi) { unsigned r; asm("v_cvt_pk_bf16_f32 %0, %1, %2" : "=v"(r) : "v"(lo), "v"(hi)); return r; }
__device__ __forceinline__ unsigned cvtpk_t(float lo, float hi) { unsigned r; asm("s_nop 1\n\tv_cvt_pk_bf16_f32 %0, %1, %2" : "=v"(r) : "v"(lo), "v"(hi)); return r; }
__device__ __forceinline__ bf16_t f2bf(float x) { return (bf16_t)(cvtpk(x, x) & 0xffffu); }
__device__ __forceinline__ int crow(int r, int hi) { return (r & 3) + 8 * (r >> 2) + 4 * hi; }
__device__ __forceinline__ void st16_asm(void* ptr, u32x4 v) { asm volatile("global_store_dwordx4 %0, %1, off\n\ts_nop 1" :: "v"(ptr), "v"(v) : "memory"); }
__device__ __forceinline__ float sigmoidf_(float x) { return __builtin_amdgcn_rcpf(1.f + __expf(-x)); }

#define NG_IN 106
#define NCAT (NG_IN * 64)
#define QSCALE 0.18033688011112042f

constexpr size_t wsal(size_t x) { return (x + 255) & ~(size_t)255; }
constexpr size_t OFF_bar = 0;
constexpr size_t OFF_cs = OFF_bar + wsal(XCD_BAR_WORDS * 4 + 1024);
constexpr size_t OFF_sn = OFF_cs + wsal((size_t)T_ * 32 * 4);
constexpr size_t OFF_Wcat = OFF_sn + wsal((size_t)T_ * 32 * 4);
constexpr size_t OFF_Wukv = OFF_Wcat + wsal((size_t)2 * NCAT * 1024 * 2);
constexpr size_t OFF_W1t = OFF_Wukv + wsal((size_t)2 * 512 * 128 * 2);
constexpr size_t OFF_W2t = OFF_W1t + wsal((size_t)2 * 2 * 256 * 2048 * 2);
constexpr size_t OFF_peb = OFF_W2t + wsal((size_t)2 * 2 * 64 * 256 * 2);
constexpr size_t OFF_pebp = OFF_peb + wsal((size_t)2 * 2 * 256 * 4);
constexpr size_t OFF_Wbt = OFF_pebp + wsal((size_t)4 * 32 * 256 * 4);
constexpr size_t OFF_Wot = OFF_Wbt + wsal((size_t)2 * 1024 * 1024 * 2);
constexpr size_t OFF_Wrt = OFF_Wot + wsal((size_t)2 * 1024 * 1024 * 2);
constexpr size_t OFF_h = OFF_Wrt + wsal((size_t)2 * 80 * 1024 * 4);
constexpr size_t OFF_hn = OFF_h + wsal((size_t)T_ * D_ * 4);
constexpr size_t OFF_qa = OFF_hn + wsal((size_t)T_ * D_ * 2);
constexpr size_t OFF_kcmp = OFF_qa + wsal((size_t)T_ * 256 * 2);
constexpr size_t OFF_vcmp = OFF_kcmp + wsal((size_t)T_ * 64 * 2);
constexpr size_t OFF_ksel = OFF_vcmp + wsal((size_t)T_ * 64 * 2);
constexpr size_t OFF_vselT = OFF_ksel + wsal((size_t)T_ * 64 * 2);
constexpr size_t OFF_kwin = OFF_vselT + wsal((size_t)T_ * 64 * 2);
constexpr size_t OFF_vwinT = OFF_kwin + wsal((size_t)T_ * 64 * 2);
constexpr size_t OFF_qb = OFF_vwinT + wsal((size_t)T_ * 64 * 2);
constexpr size_t OFF_kb = OFF_qb + wsal((size_t)T_ * 256 * 2);
constexpr size_t OFF_vbT = OFF_kb + wsal((size_t)T_ * 256 * 2);
constexpr size_t OFF_qc = OFF_vbT + wsal((size_t)T_ * 256 * 2);
constexpr size_t OFF_ckv = OFF_qc + wsal((size_t)T_ * 256 * 2);
constexpr size_t OFF_qi = OFF_ckv + wsal((size_t)T_ * 128 * 2);
constexpr size_t OFF_ki = OFF_qi + wsal((size_t)T_ * 256 * 2);
constexpr size_t OFF_qd = OFF_ki + wsal((size_t)T_ * 64 * 2);
constexpr size_t OFF_kd = OFF_qd + wsal((size_t)T_ * 256 * 2);
constexpr size_t OFF_vdT = OFF_kd + wsal((size_t)T_ * 128 * 2);
constexpr size_t OFF_ga = OFF_vdT + wsal((size_t)T_ * 128 * 2);
constexpr size_t OFF_logf = OFF_ga + wsal((size_t)T_ * 12 * 4);
constexpr size_t OFF_wi = OFF_logf + wsal((size_t)T_ * 4 * 4);
constexpr size_t OFF_kcc = OFF_wi + wsal((size_t)T_ * 4 * 4);
constexpr size_t OFF_vcT = OFF_kcc + wsal((size_t)T_ * 256 * 2);
constexpr size_t OFF_gates = OFF_vcT + wsal((size_t)T_ * 256 * 2);
constexpr size_t OFF_o = OFF_gates + wsal((size_t)T_ * 4096 * 2);
constexpr size_t OFF_kbias = OFF_o + wsal((size_t)T_ * D_ * 2);
constexpr size_t OFF_ocmp = OFF_kbias + wsal((size_t)B_ * 4 * S_ * 4);
constexpr size_t OFF_owin = OFF_ocmp + wsal((size_t)T_ * 256 * 4);
constexpr size_t OFF_sc = OFF_owin + wsal((size_t)T_ * 256 * 4);
constexpr size_t OFF_kcb = OFF_sc + wsal((size_t)B_ * 2162688 * 4);
constexpr size_t OFF_vcbT = OFF_kcb + wsal((size_t)B_ * 128 * 64 * 2);
constexpr size_t OFF_dmask = OFF_vcbT + wsal((size_t)B_ * 64 * 128 * 2);
constexpr size_t OFF_selmask = OFF_dmask + wsal((size_t)T_ * 64 * 4);
constexpr size_t OFF_ecnt = OFF_selmask + wsal((size_t)T_ * 4);
constexpr size_t OFF_elist = OFF_ecnt + wsal(128 * 4);
constexpr size_t OFF_slotw = OFF_elist + wsal((size_t)64 * T_ * 4);
constexpr size_t WS_TOTAL = OFF_slotw + wsal((size_t)2 * T_ * 4);
constexpr size_t OFF_merged = OFF_qa;
constexpr size_t OFF_hid = OFF_qa + (size_t)T_ * D_ * 2;
constexpr size_t OFF_y = OFF_gates;
static_assert(OFF_hid + (size_t)328 * 128 * 256 * 2 <= OFF_ga, "hid must fit inside the dead z region");
static_assert(WS_TOTAL < (size_t)548 * 1000 * 1000, "workspace must stay below the guaranteed ws_size");
struct Params {
    const float* x; const int* positions; const float* attn_norm; const float* w_in;
    const float* nsa_pe_k; const float* nsa_w1_k; const float* nsa_w2_k; const float* nsa_pe_v; const float* nsa_w1_v; const float* nsa_w2_v;
    const float* fox_bias; const float* dsa_kv_norm; const float* dsa_w_ukv; const float* swa_sinks; const float* w_branch; const float* w_gate;
    const float* w_out; const float* ffn_norm; const float* moe_w_group; const float* moe_b_group; const float* moe_w_expert; const float* moe_b_expert;
    const float* moe_w_gate; const float* moe_w_up; const float* moe_w_down; const float* final_norm;
    float* out;
    char* ws;
    __device__ __forceinline__ unsigned* bar() const { return (unsigned*)(ws + OFF_bar); }
    __device__ __forceinline__ float* cs() const { return (float*)(ws + OFF_cs); }
    __device__ __forceinline__ float* sn() const { return (float*)(ws + OFF_sn); }
    __device__ __forceinline__ bf16_t* Wcat() const { return (bf16_t*)(ws + OFF_Wcat); }
    __device__ __forceinline__ bf16_t* Wukv() const { return (bf16_t*)(ws + OFF_Wukv); }
    __device__ __forceinline__ bf16_t* W1t() const { return (bf16_t*)(ws + OFF_W1t); }
    __device__ __forceinline__ bf16_t* W2t() const { return (bf16_t*)(ws + OFF_W2t); }
    __device__ __forceinline__ float* peb() const { return (float*)(ws + OFF_peb); }
    __device__ __forceinline__ float* pebp() const { return (float*)(ws + OFF_pebp); }
    __device__ __forceinline__ bf16_t* Wbt() const { return (bf16_t*)(ws + OFF_Wbt); }
    __device__ __forceinline__ bf16_t* Wot() const { return (bf16_t*)(ws + OFF_Wot); }
    __device__ __forceinline__ float* Wrt() const { return (float*)(ws + OFF_Wrt); }
    __device__ __forceinline__ float* h() const { return (float*)(ws + OFF_h); }
    __device__ __forceinline__ bf16_t* hn() const { return (bf16_t*)(ws + OFF_hn); }
    __device__ __forceinline__ bf16_t* qa() const { return (bf16_t*)(ws + OFF_qa); }
    __device__ __forceinline__ bf16_t* kcmp() const { return (bf16_t*)(ws + OFF_kcmp); }
    __device__ __forceinline__ bf16_t* vcmp() const { return (bf16_t*)(ws + OFF_vcmp); }
    __device__ __forceinline__ bf16_t* ksel() const { return (bf16_t*)(ws + OFF_ksel); }
    __device__ __forceinline__ bf16_t* vselT() const { return (bf16_t*)(ws + OFF_vselT); }
    __device__ __forceinline__ bf16_t* kwin() const { return (bf16_t*)(ws + OFF_kwin); }
    __device__ __forceinline__ bf16_t* vwinT() const { return (bf16_t*)(ws + OFF_vwinT); }
    __device__ __forceinline__ bf16_t* qb() const { return (bf16_t*)(ws + OFF_qb); }
    __device__ __forceinline__ bf16_t* kb() const { return (bf16_t*)(ws + OFF_kb); }
    __device__ __forceinline__ bf16_t* vbT() const { return (bf16_t*)(ws + OFF_vbT); }
    __device__ __forceinline__ bf16_t* qc() const { return (bf16_t*)(ws + OFF_qc); }
    __device__ __forceinline__ bf16_t* ckv() const { return (bf16_t*)(ws + OFF_ckv); }
    __device__ __forceinline__ bf16_t* qi() const { return (bf16_t*)(ws + OFF_qi); }
    __device__ __forceinline__ bf16_t* ki() const { return (bf16_t*)(ws + OFF_ki); }
    __device__ __forceinline__ bf16_t* qd() const { return (bf16_t*)(ws + OFF_qd); }
    __device__ __forceinline__ bf16_t* kd() const { return (bf16_t*)(ws + OFF_kd); }
    __device__ __forceinline__ bf16_t* vdT() const { return (bf16_t*)(ws + OFF_vdT); }
    __device__ __forceinline__ float* ga() const { return (float*)(ws + OFF_ga); }
    __device__ __forceinline__ float* logf() const { return (float*)(ws + OFF_logf); }
    __device__ __forceinline__ float* wi() const { return (float*)(ws + OFF_wi); }
    __device__ __forceinline__ bf16_t* kcc() const { return (bf16_t*)(ws + OFF_kcc); }
    __device__ __forceinline__ bf16_t* vcT() const { return (bf16_t*)(ws + OFF_vcT); }
    __device__ __forceinline__ bf16_t* gates() const { return (bf16_t*)(ws + OFF_gates); }
    __device__ __forceinline__ bf16_t* o() const { return (bf16_t*)(ws + OFF_o); }
    __device__ __forceinline__ float* kbias() const { return (float*)(ws + OFF_kbias); }
    __device__ __forceinline__ float* ocmp() const { return (float*)(ws + OFF_ocmp); }
    __device__ __forceinline__ float* owin() const { return (float*)(ws + OFF_owin); }
    __device__ __forceinline__ float* sc() const { return (float*)(ws + OFF_sc); }
    __device__ __forceinline__ bf16_t* kcb() const { return (bf16_t*)(ws + OFF_kcb); }
    __device__ __forceinline__ bf16_t* vcbT() const { return (bf16_t*)(ws + OFF_vcbT); }
    __device__ __forceinline__ unsigned* dmask() const { return (unsigned*)(ws + OFF_dmask); }
    __device__ __forceinline__ unsigned* selmask() const { return (unsigned*)(ws + OFF_selmask); }
    __device__ __forceinline__ unsigned* ecnt() const { return (unsigned*)(ws + OFF_ecnt); }
    __device__ __forceinline__ int* elist() const { return (int*)(ws + OFF_elist); }
    __device__ __forceinline__ float* slotw() const { return (float*)(ws + OFF_slotw); }
    __device__ __forceinline__ bf16_t* merged() const { return (bf16_t*)(ws + OFF_merged); }
    __device__ __forceinline__ bf16_t* hid() const { return (bf16_t*)(ws + OFF_hid); }
    __device__ __forceinline__ bf16_t* y() const { return (bf16_t*)(ws + OFF_y); }
};

#define TSTR 144
enum { BMODE_BF16_NK = 0, BMODE_F32_KN = 1 };

struct NoHook { __device__ __forceinline__ void operator()(int) const {} };
template <int BM, int BN, int BMODE, class AROW, class BSRC, class HOOK = NoHook>
__device__ __forceinline__ void gemm_core(f32x16 (&acc)[2][2], AROW arow, BSRC bsrc, int K, char* lds, HOOK hook = HOOK()) {
    constexpr int WM = BM / 64;
    constexpr int NA = BM / 32, NB = BN / 32;
    const int tid = otid(), lane = tid & 63, w = tid >> 6, r32 = lane & 31, hi = lane >> 5;
    const int wm = w % WM, wn = w / WM;
    char* ldsA = lds; char* ldsB = lds + BM * TSTR;
    const bf16_t* ap[NA];
#pragma unroll
    for (int i = 0; i < NA; ++i) ap[i] = arow((tid >> 3) + 32 * i) + (tid & 7) * 8;
    const bf16_t* bp[NB];
    if constexpr (BMODE == BMODE_BF16_NK) {
#pragma unroll
        for (int i = 0; i < NB; ++i) bp[i] = (const bf16_t*)bsrc((tid >> 3) + 32 * i) + (tid & 7) * 8;
    }
    u32x4 ra[NA]; u32x4 rb[NB]; f32x4 rf[8];
    const int kg = tid >> 5, ng = tid & 31;
    const float* bfp = nullptr; int bld = 0;
    if constexpr (BMODE == BMODE_F32_KN) { bfp = (const float*)bsrc(ng * 4, bld); }
    auto load_regs = [&](int k0) {
#pragma unroll
        for (int i = 0; i < NA; ++i) ra[i] = *(const u32x4*)(ap[i] + k0);
        if (BMODE == BMODE_BF16_NK) {
#pragma unroll
            for (int i = 0; i < NB; ++i) rb[i] = *(const u32x4*)(bp[i] + k0);
        } else {
#pragma unroll
            for (int j = 0; j < 8; ++j) rf[j] = *(const f32x4*)(bfp + (long)(k0 + kg * 8 + j) * bld);
        }
    };
    auto store_lds = [&]() {
#pragma unroll
        for (int i = 0; i < NA; ++i) *(u32x4*)(ldsA + ((tid >> 3) + 32 * i) * TSTR + (tid & 7) * 16) = ra[i];
        if (BMODE == BMODE_BF16_NK) {
#pragma unroll
            for (int i = 0; i < NB; ++i) *(u32x4*)(ldsB + ((tid >> 3) + 32 * i) * TSTR + (tid & 7) * 16) = rb[i];
        } else {
#pragma unroll
            for (int i = 0; i < 4; ++i) {
                u32x4 v;
                v.x = cvtpk(rf[0][i], rf[1][i]); v.y = cvtpk(rf[2][i], rf[3][i]); v.z = cvtpk(rf[4][i], rf[5][i]); v.w = cvtpk(rf[6][i], rf[7][i]);
                *(u32x4*)(ldsB + (ng * 4 + i) * TSTR + kg * 16) = v;
            }
        }
    };
    const int nk = K / 64;
    load_regs(0);
    for (int kt = 0; kt < nk; ++kt) {
        __syncthreads();
        store_lds();
        __syncthreads();
        if (kt + 1 < nk) load_regs((kt + 1) * 64);
#pragma unroll
        for (int ks = 0; ks < 4; ++ks) {
            bf16x8 bf[2], af[2];
#pragma unroll
            for (int ni = 0; ni < 2; ++ni) bf[ni] = *(const bf16x8*)(ldsB + (wn * 64 + ni * 32 + r32) * TSTR + ks * 32 + hi * 16);
#pragma unroll
            for (int mi = 0; mi < 2; ++mi) af[mi] = *(const bf16x8*)(ldsA + (wm * 64 + mi * 32 + r32) * TSTR + ks * 32 + hi * 16);
#pragma unroll
            for (int ni = 0; ni < 2; ++ni)
#pragma unroll
                for (int mi = 0; mi < 2; ++mi) acc[ni][mi] = MFMA32(bf[ni], af[mi], acc[ni][mi]);
        }
        hook(kt);
    }
}

__device__ __forceinline__ void glds16(const void* g, unsigned lds_addr) {
    unsigned sv;
    asm volatile("s_mov_b32 %0, m0\n\ts_mov_b32 m0, %2\n\ts_nop 0\n\tglobal_load_lds_dwordx4 %1, off\n\ts_mov_b32 m0, %0" : "=&s"(sv) : "v"(g), "s"(lds_addr) : "memory");
}
__device__ __forceinline__ void glds4(const void* g, unsigned lds_addr) {
    unsigned sv;
    asm volatile("s_mov_b32 %0, m0\n\ts_mov_b32 m0, %2\n\ts_nop 0\n\tglobal_load_lds_dword %1, off\n\ts_mov_b32 m0, %0" : "=&s"(sv) : "v"(g), "s"(lds_addr) : "memory");
}
template <typename T> __device__ __forceinline__ T* uni_ptr(T* q) {
    const unsigned long long v = (unsigned long long)q;
    const unsigned lo = (unsigned)__builtin_amdgcn_readfirstlane((int)(unsigned)v), hi_ = (unsigned)__builtin_amdgcn_readfirstlane((int)(unsigned)(v >> 32));
    return (T*)(((unsigned long long)hi_ << 32) | lo);
}
__device__ __forceinline__ void glds16_so(const void* sbase, unsigned voff, unsigned lds_addr) {
    unsigned sv;
    asm volatile("s_mov_b32 %0, m0\n\ts_mov_b32 m0, %3\n\ts_nop 0\n\tglobal_load_lds_dwordx4 %1, %2\n\ts_mov_b32 m0, %0" : "=&s"(sv) : "v"(voff), "s"(sbase), "s"(lds_addr) : "memory");
}
#define DMA_WAIT_BARRIER() asm volatile("s_waitcnt vmcnt(0) lgkmcnt(0)\n\ts_barrier" ::: "memory")
#define GBUF 32768
#define LDS_AUX 73728
template <int BMODE, int VAR = 0, class AROW, class BSRC, class HOOK = NoHook>
__device__ __forceinline__ void gemm_glds(f32x16 (&acc)[2][2], AROW arow, BSRC bsrc, int K, char* lds, HOOK hook = HOOK()) {
    const int tid = otid(), lane = tid & 63, w = tid >> 6, r32 = lane & 31, hi = lane >> 5;
    const int wm = w & 1, wn = w >> 1;
    const int srow = 8 * w + (lane >> 3), sslot = lane & 7;
    const bf16_t* ap[4];
#pragma unroll
    for (int i = 0; i < 4; ++i) { const int r = 32 * i + srow; ap[i] = arow(r) + ((sslot ^ ((r >> 1) & 7)) * 8); }
    const bf16_t* bp[4];
    if constexpr (BMODE == BMODE_BF16_NK) {
#pragma unroll
        for (int i = 0; i < 4; ++i) { const int r = 32 * i + srow; bp[i] = (const bf16_t*)bsrc(r) + ((sslot ^ ((r >> 1) & 7)) * 8); }
    }
    f32x4 rf[8];
    const int kg = tid >> 5, ng = tid & 31;
    const float* bfp = nullptr; int bld = 0;
    if constexpr (BMODE == BMODE_F32_KN) { bfp = (const float*)bsrc(ng * 4, bld); }
    const unsigned lds0 = (unsigned)(uintptr_t)lds;
    auto issue = [&](int kt) {
        if (VAR & 4) return;
        const unsigned buf = lds0 + (kt & 1) * GBUF + 8 * w * 128;
#pragma unroll
        for (int i = 0; i < 4; ++i)
            glds16(ap[i] + kt * 64, (unsigned)__builtin_amdgcn_readfirstlane(buf + 32 * i * 128));
        if constexpr (BMODE == BMODE_BF16_NK) {
#pragma unroll
            for (int i = 0; i < 4; ++i)
                glds16(bp[i] + kt * 64, (unsigned)__builtin_amdgcn_readfirstlane(buf + 16384 + 32 * i * 128));
        } else {
#pragma unroll
            for (int j = 0; j < 8; ++j) rf[j] = *(const f32x4*)(bfp + (long)(kt * 64 + kg * 8 + j) * bld);
        }
    };
    auto store_b = [&](int kt) {
        char* bufB = lds + (kt & 1) * GBUF + 16384;
#pragma unroll
        for (int i = 0; i < 4; ++i) {
            u32x4 v;
            v.x = cvtpk(rf[0][i], rf[1][i]); v.y = cvtpk(rf[2][i], rf[3][i]); v.z = cvtpk(rf[4][i], rf[5][i]); v.w = cvtpk(rf[6][i], rf[7][i]);
            const int r = ng * 4 + i;
            *(u32x4*)(bufB + r * 128 + ((kg ^ ((r >> 1) & 7)) * 16)) = v;
        }
    };
    const int nk = K / 64;
    issue(0);
    if constexpr (BMODE == BMODE_F32_KN) store_b(0);
    const int akey = ((r32 >> 1) & 7);
    for (int kt = 0; kt < nk; ++kt) {
        DMA_WAIT_BARRIER();
        if (kt + 1 < nk) issue(kt + 1);
        const char* bufA = lds + (kt & 1) * GBUF; const char* bufB = bufA + 16384;
        if (!(VAR & 2)) {
            bf16x8 bf[2][2], af[2][2];
            {
                const int coff = ((hi ^ akey) * 16);
#pragma unroll
                for (int ni = 0; ni < 2; ++ni) bf[0][ni] = *(const bf16x8*)(bufB + (wn * 64 + ni * 32 + r32) * 128 + coff);
#pragma unroll
                for (int mi = 0; mi < 2; ++mi) af[0][mi] = *(const bf16x8*)(bufA + (wm * 64 + mi * 32 + r32) * 128 + coff);
            }
#pragma unroll
            for (int ks = 0; ks < 4; ++ks) {
                const int cur = ks & 1, nxt = cur ^ 1;
                if (ks < 3) {
                    const int coff = ((((ks + 1) * 2 + hi) ^ akey) * 16);
#pragma unroll
                    for (int ni = 0; ni < 2; ++ni) bf[nxt][ni] = *(const bf16x8*)(bufB + (wn * 64 + ni * 32 + r32) * 128 + coff);
#pragma unroll
                    for (int mi = 0; mi < 2; ++mi) af[nxt][mi] = *(const bf16x8*)(bufA + (wm * 64 + mi * 32 + r32) * 128 + coff);
                }
#pragma unroll
                for (int ni = 0; ni < 2; ++ni)
#pragma unroll
                    for (int mi = 0; mi < 2; ++mi) acc[ni][mi] = MFMA32(bf[cur][ni], af[cur][mi], acc[ni][mi]);
            }
        }
        hook(kt);
        if constexpr (BMODE == BMODE_F32_KN) { if (kt + 1 < nk) store_b(kt + 1); }
    }
    __syncthreads();
}

#define BSTG 24576
__device__ __forceinline__ void gemm_big_issue01(const bf16_t* Abase, int lda, const bf16_t* Bbase, int ldb, char* lds, long ksa = 32, long ksb = 32) {
    const int tid = otid(), lane = tid & 63, w = tid >> 6;
    const int lrow = lane >> 2, lch = ((lane & 3) ^ ((lane >> 4) & 3)) * 8;
    const unsigned lds0 = (unsigned)(uintptr_t)lds;
#pragma unroll
    for (int s_ = 0; s_ < 2; ++s_) {
        const unsigned base = lds0 + s_ * BSTG;
        const bf16_t* ab = uni_ptr(Abase + s_ * ksa); const bf16_t* bb = uni_ptr(Bbase + s_ * ksb);
#pragma unroll
        for (int i = 0; i < 4; ++i) glds16_so(ab, (unsigned)(((64 * w + 16 * i + lrow) * lda + lch) * 2), (unsigned)__builtin_amdgcn_readfirstlane(base + (64 * w + 16 * i) * 64));
#pragma unroll
        for (int i = 0; i < 2; ++i) glds16_so(bb, (unsigned)(((32 * w + 16 * i + lrow) * ldb + lch) * 2), (unsigned)__builtin_amdgcn_readfirstlane(base + 16384 + (32 * w + 16 * i) * 64));
    }
}
__device__ __forceinline__ void gemm_big(f32x16 (&acc)[2][2][2], const bf16_t* Abase, int lda, const bf16_t* Bbase, int ldb, int K, char* lds, long ksa = 32, long ksb = 32) {
    const int tid = otid(), lane = tid & 63, w = tid >> 6, r32 = lane & 31, hi = lane >> 5;
    const int wm = w & 1, wn = w >> 1;
    const int lrow = lane >> 2, lch = ((lane & 3) ^ ((lane >> 4) & 3)) * 8;
    unsigned aoff[4], boff[2];
#pragma unroll
    for (int i = 0; i < 4; ++i) aoff[i] = (unsigned)(((64 * w + 16 * i + lrow) * lda + lch) * 2);
#pragma unroll
    for (int i = 0; i < 2; ++i) boff[i] = (unsigned)(((32 * w + 16 * i + lrow) * ldb + lch) * 2);
    const unsigned lds0 = (unsigned)(uintptr_t)lds;
    auto issue = [&](int s_, int stg) {
        const unsigned base = lds0 + stg * BSTG;
        const bf16_t* ab = uni_ptr(Abase + s_ * ksa); const bf16_t* bb = uni_ptr(Bbase + s_ * ksb);
#pragma unroll
        for (int i = 0; i < 4; ++i) glds16_so(ab, aoff[i], (unsigned)__builtin_amdgcn_readfirstlane(base + (64 * w + 16 * i) * 64));
#pragma unroll
        for (int i = 0; i < 2; ++i) glds16_so(bb, boff[i], (unsigned)__builtin_amdgcn_readfirstlane(base + 16384 + (32 * w + 16 * i) * 64));
    };
    const int n = K / 32;
    const int key = (r32 >> 2) & 3;
    int stg = 0;
    for (int s_ = 0; s_ < n; ++s_) {
        if (s_ > 0 && s_ + 1 < n) asm volatile("s_waitcnt vmcnt(6) lgkmcnt(0)\n\ts_barrier" ::: "memory");
        else asm volatile("s_waitcnt vmcnt(0) lgkmcnt(0)\n\ts_barrier" ::: "memory");
        if (s_ + 2 < n) { int st2 = stg + 2; if (st2 >= 3) st2 -= 3; issue(s_ + 2, st2); }
        const char* bufA = lds + stg * BSTG; const char* bufB = bufA + 16384;
#pragma unroll
        for (int ks = 0; ks < 2; ++ks) {
            const int coff = (((ks * 2 + hi) ^ key) * 16);
            bf16x8 bf[2], af[2][2];
#pragma unroll
            for (int ni = 0; ni < 2; ++ni) bf[ni] = *(const bf16x8*)(bufB + (wn * 64 + ni * 32 + r32) * 64 + coff);
#pragma unroll
            for (int mh = 0; mh < 2; ++mh)
#pragma unroll
                for (int mi = 0; mi < 2; ++mi) af[mh][mi] = *(const bf16x8*)(bufA + (wm * 128 + mh * 64 + mi * 32 + r32) * 64 + coff);
#pragma unroll
            for (int mh = 0; mh < 2; ++mh)
#pragma unroll
                for (int ni = 0; ni < 2; ++ni)
#pragma unroll
                    for (int mi = 0; mi < 2; ++mi) acc[mh][ni][mi] = MFMA32(bf[ni], af[mh][mi], acc[mh][ni][mi]);
        }
        if (++stg == 3) stg = 0;
    }
    __syncthreads();
}

#define MSTG 16384
template <class AROW, class BROW, class HOOK = NoHook>
__device__ __forceinline__ void gemm_mid(f32x16 (&acc)[2][2], const bf16_t* Abase, AROW arow, const bf16_t* Bbase, BROW brow, int K, char* lds, long ksa, long ksb, HOOK hook = HOOK()) {
    const int tid = otid(), lane = tid & 63, w = tid >> 6, r32 = lane & 31, hi = lane >> 5;
    const int wm = w & 1, wn = w >> 1;
    const int lrow = lane >> 2, lch = ((lane & 3) ^ ((lane >> 4) & 3)) * 8;
    unsigned aoff[2], boff[2];
#pragma unroll
    for (int i = 0; i < 2; ++i) { aoff[i] = (unsigned)((arow(32 * w + 16 * i + lrow) + lch) * 2); boff[i] = (unsigned)((brow(32 * w + 16 * i + lrow) + lch) * 2); }
    const unsigned lds0 = (unsigned)(uintptr_t)lds;
    auto issue = [&](int s_) {
        const unsigned base = lds0 + (s_ & 3) * MSTG + 32 * w * 64;
        const bf16_t* ab = uni_ptr(Abase + s_ * ksa); const bf16_t* bb = uni_ptr(Bbase + s_ * ksb);
#pragma unroll
        for (int i = 0; i < 2; ++i) glds16_so(ab, aoff[i], (unsigned)__builtin_amdgcn_readfirstlane(base + 16 * i * 64));
#pragma unroll
        for (int i = 0; i < 2; ++i) glds16_so(bb, boff[i], (unsigned)__builtin_amdgcn_readfirstlane(base + 8192 + 16 * i * 64));
    };
    const int n = K / 32;
    const int key = (r32 >> 2) & 3;
#pragma unroll
    for (int i = 0; i < 3; ++i) if (i < n) issue(i);
    for (int s_ = 0; s_ < n; ++s_) {
        const int ahead = n - 1 - s_;
        if (s_ > 0 && ahead >= 2) asm volatile("s_waitcnt vmcnt(8) lgkmcnt(0)\n\ts_barrier" ::: "memory");
        else if (s_ > 0 && ahead == 1) asm volatile("s_waitcnt vmcnt(4) lgkmcnt(0)\n\ts_barrier" ::: "memory");
        else asm volatile("s_waitcnt vmcnt(0) lgkmcnt(0)\n\ts_barrier" ::: "memory");
        if (s_ + 3 < n) issue(s_ + 3);
        const char* bufA = lds + (s_ & 3) * MSTG; const char* bufB = bufA + 8192;
#pragma unroll
        for (int ks = 0; ks < 2; ++ks) {
            const int coff = (((ks * 2 + hi) ^ key) * 16);
            bf16x8 bf[2], af[2];
#pragma unroll
            for (int ni = 0; ni < 2; ++ni) bf[ni] = *(const bf16x8*)(bufB + (wn * 64 + ni * 32 + r32) * 64 + coff);
#pragma unroll
            for (int mi = 0; mi < 2; ++mi) af[mi] = *(const bf16x8*)(bufA + (wm * 64 + mi * 32 + r32) * 64 + coff);
#pragma unroll
            for (int ni = 0; ni < 2; ++ni)
#pragma unroll
                for (int mi = 0; mi < 2; ++mi) acc[ni][mi] = MFMA32(bf[ni], af[mi], acc[ni][mi]);
        }
        hook(s_);
    }
    __syncthreads();
}

__device__ __forceinline__ void tconv_tile(const float* __restrict__ src, int lds_, bf16_t* __restrict__ dst, int ldd, const float* kscale, bool zero, char* lds) {
    float (*tile)[65] = (float (*)[65])lds;
    const int tid = otid();
    __syncthreads();
#pragma unroll
    for (int i = 0; i < 16; ++i) {
        int kk = i * 4 + (tid >> 6), nn = tid & 63;
        float v = zero ? 0.f : src[(long)kk * lds_ + nn];
        if (kscale) v *= kscale[kk];
        tile[kk][nn] = v;
    }
    __syncthreads();
#pragma unroll
    for (int i = 0; i < 2; ++i) {
        int c = tid + 256 * i; int nn = c >> 3, kc = (c & 7) * 8;
        u32x4 v;
        v.x = cvtpk(tile[kc + 0][nn], tile[kc + 1][nn]); v.y = cvtpk(tile[kc + 2][nn], tile[kc + 3][nn]);
        v.z = cvtpk(tile[kc + 4][nn], tile[kc + 5][nn]); v.w = cvtpk(tile[kc + 6][nn], tile[kc + 7][nn]);
        *(u32x4*)(dst + (long)nn * ldd + kc) = v;
    }
}
__device__ __forceinline__ int in_group_src(int g) {
    if (g < 10) return g * 64;
    if (g < 22) return O_QB + (g - 10) * 64;
    if (g < 33) return O_QC + (g - 22) * 64;
    return O_QD + (g - 33) * 64;
}
__device__ __forceinline__ void phase_prep(const Params& p, int bid, int nblk, char* lds, int part) {
    const int tid = otid();
    if (bid == 0 && tid < 128) p.ecnt()[tid] = 0u;
    if (bid == 0 && tid < 96) ((unsigned*)(p.ws + OFF_bar))[3600 + tid] = 0u;
    if (part & 1) for (int idx0 = bid * 256 + tid; idx0 < T_ * 32; idx0 += 4 * nblk * 256)
#pragma unroll
    for (int u_ = 0; u_ < 4; ++u_) {
        const int idx = idx0 + u_ * nblk * 256;
        if (idx >= T_ * 32) continue;
        int i = idx & 31, t = idx >> 5;
        float inv = powf(10000.f, -(float)i / 32.f);
        float ang = (float)p.positions[t] * inv;
        double a = (double)ang; double n = rint(a * 0.15915494309189535); float rf = (float)(a - n * 6.283185307179586);
        p.cs()[idx] = cosf(rf); p.sn()[idx] = sinf(rf);
    }
    const int J_CAT = 2 * NG_IN * 16;
    const int J_UKV = 2 * 8 * 2;
    const int J_W1 = 2 * 2 * 4 * 32;
    const int J_W2 = 2 * 2 * 1 * 4;
    const int J_WB = 2 * 4 * 16 * 4;
    const int J_WO = 2 * 16 * 16;
    const int total = J_CAT + J_UKV + J_W1 + J_W2 + J_WB + J_WO;
    auto desc = [&](int q, const float*& sp, int& ld, const float*& ks, bf16_t*& dst, int& ldd, const float*& pe, float*& pp) {
        const int nn = tid & 63;
        ks = nullptr; pe = nullptr; pp = nullptr;
        if (q < J_CAT) {
            const int kt = q & 15, g = (q >> 4) % NG_IN, l = (q >> 4) / NG_IN;
            dst = p.Wcat() + (long)l * NCAT * 1024 + ((long)(kt * 2) * NCAT + g * 64) * 32; ldd = -NCAT; ld = DIN;
            const float* base = p.w_in + (long)l * D_ * DIN + (long)kt * 64 * DIN;
            if (g < 41) sp = base + in_group_src(g) + nn;
            else if (g == 41) sp = nn < 12 ? base + O_GA + nn : nn < 16 ? base + O_FB + nn - 12 : nn < 20 ? base + O_WI + nn - 16 : nullptr;
            else { const int gg = g - 42, i = gg >> 4, nt = gg & 15; sp = p.w_gate + ((long)(l * 4 + i) * D_ + kt * 64) * D_ + nt * 64 + nn; ld = D_; }
            return;
        }
        q -= J_CAT;
        if (q < J_UKV) {
            const int kt = q & 1, nt = (q >> 1) & 7, l = q >> 4;
            sp = p.dsa_w_ukv + (long)l * 128 * 512 + (long)kt * 64 * 512 + nt * 64 + nn; ld = 512;
            dst = p.Wukv() + ((long)l * 512 + nt * 64) * 128 + kt * 64; ldd = 128; ks = p.dsa_kv_norm + l * 128 + kt * 64;
            return;
        }
        q -= J_UKV;
        if (q < J_W1) {
            const int kt = q & 31, nt = (q >> 5) & 3, kv = (q >> 7) & 1, l = q >> 8;
            sp = (kv ? p.nsa_w1_v : p.nsa_w1_k) + (long)l * 2048 * 256 + (long)kt * 64 * 256 + nt * 64 + nn; ld = 256;
            dst = p.W1t() + ((long)(l * 2 + kv) * 256 + nt * 64) * 2048 + kt * 64; ldd = 2048;
            pe = (kv ? p.nsa_pe_v : p.nsa_pe_k) + l * 2048 + kt * 64; pp = p.pebp() + ((long)((l * 2 + kv) * 32 + kt)) * 256 + nt * 64;
            return;
        }
        q -= J_W1;
        if (q < J_W2) {
            const int kt = q & 3, kv = (q >> 2) & 1, l = q >> 3;
            sp = (kv ? p.nsa_w2_v : p.nsa_w2_k) + (long)l * 256 * 64 + (long)kt * 64 * 64 + nn; ld = 64;
            dst = p.W2t() + ((long)(l * 2 + kv) * 64) * 256 + kt * 64; ldd = 256;
            return;
        }
        q -= J_W2;
        if (q < J_WB) {
            const int kt = q & 3, nt = (q >> 2) & 15, i = (q >> 6) & 3, l = q >> 8;
            sp = p.w_branch + ((long)(l * 4 + i) * 256 + kt * 64) * D_ + nt * 64 + nn; ld = D_;
            dst = p.Wbt() + (long)l * 1024 * 1024 + ((long)(i * 8 + kt * 2) * 1024 + nt * 64) * 32; ldd = -1024;
            return;
        }
        q -= J_WB;
        {
            const int kt = q & 15, nt = (q >> 4) & 15, l = q >> 8;
            sp = p.w_out + ((long)l * D_ + kt * 64) * D_ + nt * 64 + nn; ld = D_;
            dst = p.Wot() + (long)l * 1024 * 1024 + ((long)(kt * 2) * 1024 + nt * 64) * 32; ldd = -1024;
        }
    };
    if (part & 2) for (int j0 = bid; j0 < total; j0 += 4 * nblk) {
        float v[4][16];
#pragma unroll
        for (int u = 0; u < 4; ++u) {
            const int j = j0 + u * nblk;
            if (j < total) {
                const float* sp; int ld; const float* ks; bf16_t* dst; int ldd; const float* pe; float* pp;
                desc(j, sp, ld, ks, dst, ldd, pe, pp);
#pragma unroll
                for (int i = 0; i < 16; ++i) {
                    const int kk = i * 4 + (tid >> 6);
                    float x = sp ? sp[(long)kk * ld] : 0.f;
                    if (ks) x *= ks[kk];
                    v[u][i] = x;
                }
            } else {
#pragma unroll
                for (int i = 0; i < 16; ++i) v[u][i] = 0.f;
            }
        }
        __syncthreads();
#pragma unroll
        for (int u = 0; u < 4; ++u) {
            float (*tile)[65] = (float (*)[65])(lds + u * 16640);
#pragma unroll
            for (int i = 0; i < 16; ++i) tile[i * 4 + (tid >> 6)][tid & 63] = v[u][i];
        }
        __syncthreads();
#pragma unroll
        for (int u = 0; u < 4; ++u) {
            const int j = j0 + u * nblk;
            if (j < total) {
                const float* sp; int ld; const float* ks; bf16_t* dst; int ldd; const float* pe; float* pp;
                desc(j, sp, ld, ks, dst, ldd, pe, pp);
                float (*tile)[65] = (float (*)[65])(lds + u * 16640);
                if (pe && tid < 64) {
                    float a = 0.f;
#pragma unroll 16
                    for (int kk = 0; kk < 64; ++kk) a += pe[kk] * tile[kk][tid];
                    pp[tid] = a;
                }
#pragma unroll
                for (int i = 0; i < 2; ++i) {
                    const int c = tid + 256 * i; const int nn = c >> 3, kc = (c & 7) * 8;
                    u32x4 o4;
                    o4.x = cvtpk(tile[kc + 0][nn], tile[kc + 1][nn]); o4.y = cvtpk(tile[kc + 2][nn], tile[kc + 3][nn]);
                    o4.z = cvtpk(tile[kc + 4][nn], tile[kc + 5][nn]); o4.w = cvtpk(tile[kc + 6][nn], tile[kc + 7][nn]);
                    if (ldd < 0) *(u32x4*)(dst + ((long)(kc >> 5) * (-ldd) + nn) * 32 + (kc & 31)) = o4;
                    else *(u32x4*)(dst + (long)nn * ldd + kc) = o4;
                }
            }
        }
    }
    __syncthreads();
    if (part & 4) for (int idx0 = bid * 256 + tid; idx0 < 2 * 80 * 1024; idx0 += 2 * nblk * 256)
#pragma unroll
    for (int u_ = 0; u_ < 2; ++u_) {
        const int idx = idx0 + u_ * nblk * 256;
        if (idx >= 2 * 80 * 1024) continue;
        int k = idx & 1023, jn = (idx >> 10) % 80, l = idx / (80 * 1024);
        float v = 0.f;
        if (jn < 8) v = p.moe_w_group[((long)l * D_ + k) * 8 + jn];
        else if (jn < 72) v = p.moe_w_expert[((long)l * D_ + k) * 64 + jn - 8];
        v *= p.ffn_norm[l * D_ + k];
        const bf16_t hb = f2bf(v); const bf16_t lb = f2bf(v - bf2f(hb));
        bf16_t* wh = (bf16_t*)p.Wrt(); bf16_t* wl = wh + 2 * 80 * 1024;
        wh[idx] = hb; wl[idx] = lb;
    }
}

__device__ __forceinline__ long hn_panel_off(long row, int c) { return ((long)(c >> 5) * T_ + row) * 32 + (c & 31); }
__device__ __forceinline__ void phase_norm(const Params& p, int l, int bid, int nblk) {
    const int tid = otid(), lane = tid & 63, w = tid >> 6;
    for (int row0 = (bid * 4 + w) * 4; row0 < T_; row0 += nblk * 16) {
        f32x4 v[4][4];
#pragma unroll
        for (int k = 0; k < 4; ++k) {
            const float* x = (l == 0 ? p.x : (const float*)p.h()) + (long)(row0 + k) * D_;
#pragma unroll
            for (int i = 0; i < 4; ++i) v[k][i] = *(const f32x4*)(x + i * 256 + lane * 4);
        }
#pragma unroll
        for (int k = 0; k < 4; ++k) {
            const int row = row0 + k;
            float ss = 0.f;
#pragma unroll
            for (int i = 0; i < 4; ++i) ss += v[k][i][0] * v[k][i][0] + v[k][i][1] * v[k][i][1] + v[k][i][2] * v[k][i][2] + v[k][i][3] * v[k][i][3];
            for (int o = 32; o > 0; o >>= 1) ss += __shfl_xor(ss, o);
            const float rs = rsqrtf(ss / (float)D_ + 1e-6f);
#pragma unroll
            for (int i = 0; i < 4; ++i) {
                const f32x4 g = *(const f32x4*)(p.attn_norm + l * D_ + i * 256 + lane * 4);
                u32x2 o2; o2.x = cvtpk(v[k][i][0] * rs * g[0], v[k][i][1] * rs * g[1]); o2.y = cvtpk(v[k][i][2] * rs * g[2], v[k][i][3] * rs * g[3]);
                *(u32x2*)(p.hn() + hn_panel_off(row, i * 256 + lane * 4)) = o2;
            }
        }
    }
}

__device__ __forceinline__ void st4(bf16_t* dst, float a, float b, float c, float d) { u32x2 v; v.x = cvtpk(a, b); v.y = cvtpk(c, d); *(u32x2*)dst = v; }

__device__ __forceinline__ void epi_tok(const f32x16 (&acc)[2][2], int m_base, int kind, float scale, bf16_t* dst, int ld, int col0, const float* cs, const float* sn) {
    const int lane = otid() & 63, r32 = lane & 31, hi = lane >> 5;
#pragma unroll
    for (int mi = 0; mi < 2; ++mi) {
        const long m = m_base + mi * 32 + r32;
#pragma unroll
        for (int rg = 0; rg < 4; ++rg) {
            float x1[4], x2[4];
#pragma unroll
            for (int j = 0; j < 4; ++j) { x1[j] = acc[0][mi][rg * 4 + j]; x2[j] = acc[1][mi][rg * 4 + j]; }
            const int i0 = 8 * rg + 4 * hi;
            if (kind == 1) {
                f32x4 c = *(const f32x4*)(cs + m * 32 + i0), s = *(const f32x4*)(sn + m * 32 + i0);
#pragma unroll
                for (int j = 0; j < 4; ++j) { float a = x1[j] * c[j] - x2[j] * s[j]; float b = x2[j] * c[j] + x1[j] * s[j]; x1[j] = a; x2[j] = b; }
            }
            st4(dst + m * ld + col0 + i0, x1[0] * scale, x1[1] * scale, x1[2] * scale, x1[3] * scale);
            st4(dst + m * ld + col0 + 32 + i0, x2[0] * scale, x2[1] * scale, x2[2] * scale, x2[3] * scale);
        }
    }
}
#define EPI_PITCH 136
__device__ __forceinline__ void epi_tok_staged(const f32x16 (&acc)[2][2], int m_base, int kind, int act, float scale, bf16_t* dst, int ld, int col0,
                                               const float* cs, const float* sn, char* wlds) {
    const int lane = otid() & 63, r32 = lane & 31, hi = lane >> 5;
#pragma unroll
    for (int mi = 0; mi < 2; ++mi) {
#pragma unroll
        for (int ni = 0; ni < 2; ++ni)
#pragma unroll
            for (int rg = 0; rg < 4; ++rg) {
                float v0 = acc[ni][mi][rg * 4 + 0], v1 = acc[ni][mi][rg * 4 + 1], v2 = acc[ni][mi][rg * 4 + 2], v3 = acc[ni][mi][rg * 4 + 3];
                if (act == 1) { v0 = sigmoidf_(v0); v1 = sigmoidf_(v1); v2 = sigmoidf_(v2); v3 = sigmoidf_(v3); }
                u32x2 pk; pk.x = cvtpk(v0 * scale, v1 * scale); pk.y = cvtpk(v2 * scale, v3 * scale);
                *(u32x2*)(wlds + r32 * EPI_PITCH + (ni * 32 + 8 * rg + 4 * hi) * 2) = pk;
            }
        __builtin_amdgcn_s_waitcnt(0xc07f);
        if (kind == 1) {
#pragma unroll
            for (int it = 0; it < 2; ++it) {
                const int row = it * 16 + (lane >> 2), c = lane & 3; const long m = m_base + mi * 32 + row;
                const u32x4 a = *(const u32x4*)(wlds + row * EPI_PITCH + c * 16), b = *(const u32x4*)(wlds + row * EPI_PITCH + 64 + c * 16);
                const f32x4 c0 = *(const f32x4*)(cs + m * 32 + 8 * c), c1 = *(const f32x4*)(cs + m * 32 + 8 * c + 4);
                const f32x4 s0 = *(const f32x4*)(sn + m * 32 + 8 * c), s1 = *(const f32x4*)(sn + m * 32 + 8 * c + 4);
                const float cc[8] = {c0[0], c0[1], c0[2], c0[3], c1[0], c1[1], c1[2], c1[3]};
                const float ss[8] = {s0[0], s0[1], s0[2], s0[3], s1[0], s1[1], s1[2], s1[3]};
                u32x4 oa, ob;
#pragma unroll
                for (int j = 0; j < 4; ++j) {
                    const float x1l = __uint_as_float(a[j] << 16), x1h = __uint_as_float(a[j] & 0xffff0000u);
                    const float x2l = __uint_as_float(b[j] << 16), x2h = __uint_as_float(b[j] & 0xffff0000u);
                    oa[j] = cvtpk(x1l * cc[2 * j] - x2l * ss[2 * j], x1h * cc[2 * j + 1] - x2h * ss[2 * j + 1]);
                    ob[j] = cvtpk(x2l * cc[2 * j] + x1l * ss[2 * j], x2h * cc[2 * j + 1] + x1h * ss[2 * j + 1]);
                }
                *(u32x4*)(dst + m * ld + col0 + 8 * c) = oa;
                *(u32x4*)(dst + m * ld + col0 + 32 + 8 * c) = ob;
            }
        } else {
#pragma unroll
            for (int it = 0; it < 4; ++it) {
                const int row = it * 8 + (lane >> 3), c = lane & 7; const long m = m_base + mi * 32 + row;
                *(u32x4*)(dst + m * ld + col0 + 8 * c) = *(const u32x4*)(wlds + row * EPI_PITCH + c * 16);
            }
        }
    }
}
__device__ __forceinline__ void epi_vt(const f32x16 (&acc)[2][2], int m_base, bf16_t* dst, int nh, int hh) {
    const int lane = otid() & 63, r32 = lane & 31, hi = lane >> 5;
    const int b = m_base / S_; const int t0 = m_base % S_;
    bf16_t* ubase = uni_ptr(dst + ((long)(b * nh + hh) * 64) * S_);
#pragma unroll
    for (int mi = 0; mi < 2; ++mi) {
        const unsigned off0 = (unsigned)vtpos(t0 + mi * 32 + r32) + (unsigned)(4 * hi) * S_;
#pragma unroll
        for (int ni = 0; ni < 2; ++ni)
#pragma unroll
            for (int r = 0; r < 16; ++r) ubase[off0 + (unsigned)((ni * 32 + (r & 3) + 8 * (r >> 2)) * S_)] = f2bf(acc[ni][mi][r]);
    }
}

__device__ __forceinline__ bool raster_tile(int it, int bid, int nblk, int ntm, int ntn, int& tm, int& tn, bool& done) {
    done = false;
    if (nblk != 512) {
        const int tile = bid + it * nblk;
        if (tile >= ntm * ntn) { done = true; return false; }
        tn = tile / ntm; tm = tile % ntm; return true;
    }
    const int gm = (ntm + 7) >> 3, gn = (ntn + 7) >> 3;
    const int st = it * 8 + (bid & 7);
    if (it * 8 >= gm * gn) { done = true; return false; }
    if (st >= gm * gn) return false;
    const int sm = st % gm, sn = st / gm;
    const int j = bid >> 3;
    tm = sm * 8 + (j & 7); tn = sn * 8 + (j >> 3);
    return tm < ntm && tn < ntn;
}
template <int VAR = 0>
__device__ __forceinline__ void phase_inproj(const Params& p, int l, int bid, int nblk, char* lds) {
    const int tid = otid(), lane = tid & 63, w = tid >> 6, r32 = lane & 31, hi = lane >> 5;
    const int wm = w & 1, wn = w >> 1;
    const bf16_t* Wc = p.Wcat() + (long)l * NCAT * 1024;
    const int NT_N = NCAT / 128, NT_M = T_ / 256;
    int it = 0, tm = 0, tn = 0; bool have = false;
    for (;; ++it) { bool done; if (raster_tile(it, bid, nblk, NT_M, NT_N, tm, tn, done)) { have = true; break; } if (done) break; }
    const long KSA = (long)T_ * 32, KSB = (long)NCAT * 32;
    if (have) gemm_big_issue01(p.hn() + (long)tm * 256 * 32, 32, Wc + (long)tn * 128 * 32, 32, lds, KSA, KSB);
    while (have) {
        const int m0 = tm * 256, n0 = tn * 128;
        f32x16 accb[2][2][2];
#pragma unroll
        for (int c = 0; c < 2; ++c)
#pragma unroll
            for (int a = 0; a < 2; ++a)
#pragma unroll
                for (int b = 0; b < 2; ++b)
#pragma unroll
                    for (int r = 0; r < 16; ++r) accb[c][a][b][r] = 0.f;
        const bf16_t* A = p.hn() + (long)m0 * 32;
        const bf16_t* Bt = Wc + (long)n0 * 32;
        gemm_big(accb, A, 32, Bt, 32, D_, lds, KSA, KSB);
        const int g = tn * 2 + wn;
        have = false;
        for (++it;; ++it) { bool done; if (raster_tile(it, bid, nblk, NT_M, NT_N, tm, tn, done)) { have = true; break; } if (done) break; }
        if (have) gemm_big_issue01(p.hn() + (long)tm * 256 * 32, 32, Wc + (long)tn * 128 * 32, 32, lds, KSA, KSB);
        char* wl = lds + 2 * BSTG + w * 4352;
        const float* cs = p.cs(); const float* sn = p.sn();
        int mode = 0, kind = 0, act = 0, ld = 256, col0 = 0, nh = 1, hh = 0; float scale = 1.f; bf16_t* dst = nullptr;
        if (g < 4) { kind = 1; scale = QSCALE; dst = p.qa(); col0 = g * 64; }
        else if (g == 4) { kind = 1; dst = p.kcmp(); ld = 64; }
        else if (g == 5) { dst = p.vcmp(); ld = 64; }
        else if (g == 6) { kind = 1; dst = p.ksel(); ld = 64; }
        else if (g == 7) { mode = 1; dst = p.vselT(); }
        else if (g == 8) { kind = 1; dst = p.kwin(); ld = 64; }
        else if (g == 9) { mode = 1; dst = p.vwinT(); }
        else if (g < 14) { scale = QSCALE; dst = p.qb(); col0 = (g - 10) * 64; }
        else if (g < 18) { dst = p.kb(); col0 = (g - 14) * 64; }
        else if (g < 22) { mode = 1; dst = p.vbT(); nh = 4; hh = g - 18; }
        else if (g < 26) { kind = 1; scale = QSCALE; dst = p.qc(); col0 = (g - 22) * 64; }
        else if (g < 28) { dst = p.ckv(); ld = 128; col0 = (g - 26) * 64; }
        else if (g < 32) { kind = 1; dst = p.qi(); col0 = (g - 28) * 64; }
        else if (g == 32) { kind = 1; dst = p.ki(); ld = 64; }
        else if (g < 37) { kind = 1; scale = QSCALE; dst = p.qd(); col0 = (g - 33) * 64; }
        else if (g < 39) { kind = 1; dst = p.kd(); ld = 128; col0 = (g - 37) * 64; }
        else if (g < 41) { mode = 1; dst = p.vdT(); nh = 2; hh = g - 39; }
        else if (g == 41) { mode = 2; }
        else { mode = 3; dst = p.gates(); col0 = (g - 42) * 64; }
#pragma unroll
        for (int mh = 0; mh < 2; ++mh) {
        const f32x16 (&acc)[2][2] = accb[mh];
        const int mb = m0 + wm * 128 + mh * 64;
        if (mode == 0) epi_tok_staged(acc, mb, kind, act, scale, dst, ld, col0, cs, sn, wl);
        else if (mode == 1) epi_vt(acc, mb, dst, nh, hh);
        else if (mode == 3) {
#pragma unroll
            for (int mi = 0; mi < 2; ++mi)
#pragma unroll
                for (int ni = 0; ni < 2; ++ni) {
                    const long blk = (long)((mb >> 5) + mi) * 128 + (col0 >> 5) + ni;
                    bf16_t* gd = dst + blk * 1024 + lane * 8;
#pragma unroll
                    for (int hf = 0; hf < 2; ++hf) {
                        u32x4 pk;
                        pk.x = cvtpk_t(sigmoidf_(acc[ni][mi][hf * 8 + 0]), sigmoidf_(acc[ni][mi][hf * 8 + 1])); pk.y = cvtpk_t(sigmoidf_(acc[ni][mi][hf * 8 + 2]), sigmoidf_(acc[ni][mi][hf * 8 + 3]));
                        pk.z = cvtpk_t(sigmoidf_(acc[ni][mi][hf * 8 + 4]), sigmoidf_(acc[ni][mi][hf * 8 + 5])); pk.w = cvtpk_t(sigmoidf_(acc[ni][mi][hf * 8 + 6]), sigmoidf_(acc[ni][mi][hf * 8 + 7]));
                        st16_asm(gd + hf * 512, pk);
                    }
                }
        }
        else {
#pragma unroll
            for (int mi = 0; mi < 2; ++mi) {
                const long m = mb + mi * 32 + r32;
#pragma unroll
                for (int r = 0; r < 16; ++r) {
                    const int c = crow(r, hi); const float v = acc[0][mi][r];
                    if (c < 12) p.ga()[m * 12 + c] = sigmoidf_(v);
                    else if (c < 16) { float xx = v + p.fox_bias[l * 4 + c - 12]; p.logf()[m * 4 + c - 12] = fminf(xx, 0.f) - __logf(1.f + __expf(-fabsf(xx))); }
                    else if (c < 20) p.wi()[m * 4 + c - 16] = v * 0.0625f;
                }
            }
        }
        }
    }
}

enum { A_FOX = 0, A_DSA = 1, A_SEL = 2, A_WIN = 3, A_SWA = 4, A_CMP = 5 };
struct AttnDesc {
    const bf16_t* q;
    const bf16_t* k; int ldk;
    const bf16_t* vt; int ldvt;
    int kt_lo, kt_hi;
    int wkt_lo, wkt_hi;
    int tq;
    unsigned tilemask;
    unsigned selm;
    const unsigned* dmask;
    const float* kbias;
    int window;
};
__device__ __forceinline__ float hswap_max(float v) { auto rr = __builtin_amdgcn_permlane32_swap(__float_as_uint(v), __float_as_uint(v), false, false); return fmaxf(__uint_as_float(rr[0]), __uint_as_float(rr[1])); }
__device__ __forceinline__ float hswap_sum(float v) { auto rr = __builtin_amdgcn_permlane32_swap(__float_as_uint(v), __float_as_uint(v), false, false); return __uint_as_float(rr[0]) + __uint_as_float(rr[1]); }

template <int MODE>
__device__ __forceinline__ void attn_core(const AttnDesc& u, f32x16 (&o)[2], float& m_out, float& l_out, char* lds) {
    const int tid = otid(), lane = tid & 63, w = tid >> 6, r32 = lane & 31, hi = lane >> 5;
    const unsigned lds0 = (unsigned)(uintptr_t)lds;
    bf16x8 qf[4];
#pragma unroll
    for (int ds = 0; ds < 4; ++ds) qf[ds] = *(const bf16x8*)(u.q + ds * 16 + hi * 8);
#pragma unroll
    for (int r = 0; r < 16; ++r) { o[0][r] = 0.f; o[1][r] = 0.f; }
    float m = -1e30f, l = 0.f;
    const int srow = 8 * w + (lane >> 3), sslot = lane & 7;
    const int key = (r32 >> 1) & 7;
    const bool bias_wave = ((MODE == A_FOX) && (w == 0)) || (MODE == A_DSA);
    auto issue = [&](int st) {
        const int kt = u.kt_lo + st;
        const unsigned base = lds0 + (st & 3) * 16384 + 8 * w * 128;
#pragma unroll
        for (int half = 0; half < 2; ++half) {
            const int r = 32 * half + srow; const int ch = (sslot ^ ((r >> 1) & 7)) * 8;
            glds16(u.k + (long)(kt * 64 + r) * u.ldk + ch, (unsigned)__builtin_amdgcn_readfirstlane(base + 32 * half * 128));
            glds16(u.vt + (long)r * u.ldvt + kt * 64 + ch, (unsigned)__builtin_amdgcn_readfirstlane(base + 8192 + 32 * half * 128));
        }
        if (MODE == A_FOX) { if (w == 0) glds4(u.kbias + kt * 64 + lane, (unsigned)__builtin_amdgcn_readfirstlane(lds0 + LDS_AUX + 1024 + (st & 3) * 256)); }
        if (MODE == A_DSA) glds4(u.dmask + kt * 2 + hi, (unsigned)__builtin_amdgcn_readfirstlane(lds0 + LDS_AUX + 2048 + (st & 3) * 1024 + w * 256));
    };
    const int nsteps = u.kt_hi - u.kt_lo + 1;
    asm volatile("s_waitcnt vmcnt(0)" ::: "memory");
#pragma unroll
    for (int i = 0; i < 3; ++i) if (i < nsteps) issue(i);
    for (int st = 0; st < nsteps; ++st) {
        const int ahead = nsteps - 1 - st;
        if (ahead >= 2) { if (bias_wave) asm volatile("s_waitcnt vmcnt(10) lgkmcnt(0)\n\ts_barrier" ::: "memory"); else asm volatile("s_waitcnt vmcnt(8) lgkmcnt(0)\n\ts_barrier" ::: "memory"); }
        else if (ahead == 1) { if (bias_wave) asm volatile("s_waitcnt vmcnt(5) lgkmcnt(0)\n\ts_barrier" ::: "memory"); else asm volatile("s_waitcnt vmcnt(4) lgkmcnt(0)\n\ts_barrier" ::: "memory"); }
        else asm volatile("s_waitcnt vmcnt(0) lgkmcnt(0)\n\ts_barrier" ::: "memory");
        if (st + 3 < nsteps) issue(st + 3);
        const int kt = u.kt_lo + st;
        u32x2 dm = {0u, 0u};
        if (MODE == A_DSA) { const unsigned* mw = (const unsigned*)(lds + LDS_AUX + 2048 + (st & 3) * 1024 + w * 256); dm.x = mw[r32]; dm.y = mw[32 + r32]; }
        const bool active = kt >= u.wkt_lo && kt <= u.wkt_hi && (MODE != A_SEL || ((u.tilemask >> kt) & 1u));
        if (active) {
            const char* ldsK = lds + (st & 3) * 16384; const char* ldsV = ldsK + 8192;
            f32x16 p[2];
            if (MODE == A_FOX) {
#pragma unroll
                for (int sub = 0; sub < 2; ++sub)
#pragma unroll
                    for (int rg = 0; rg < 4; ++rg) {
                        const f32x4 bv = *(const f32x4*)(lds + LDS_AUX + 1024 + (st & 3) * 256 + (32 * sub + 8 * rg + 4 * hi) * 4);
                        p[sub][rg * 4 + 0] = bv[0]; p[sub][rg * 4 + 1] = bv[1]; p[sub][rg * 4 + 2] = bv[2]; p[sub][rg * 4 + 3] = bv[3];
                    }
            } else {
#pragma unroll
                for (int r = 0; r < 16; ++r) { p[0][r] = 0.f; p[1][r] = 0.f; }
            }
#pragma unroll
            for (int ds = 0; ds < 4; ++ds) {
                const int coff = ((ds * 2 + hi) ^ key) * 16;
                const bf16x8 k0 = *(const bf16x8*)(ldsK + r32 * 128 + coff);
                const bf16x8 k1 = *(const bf16x8*)(ldsK + (32 + r32) * 128 + coff);
                p[0] = MFMA32(k0, qf[ds], p[0]);
                p[1] = MFMA32(k1, qf[ds], p[1]);
            }
            const int key0 = kt * 64 + 4 * hi;
            if (MODE == A_FOX || MODE == A_SEL || MODE == A_WIN || MODE == A_SWA || MODE == A_CMP || MODE == A_DSA) {
                if (MODE == A_CMP || kt * 64 + 63 > u.tq - r32) {
#pragma unroll
                    for (int sub = 0; sub < 2; ++sub)
#pragma unroll
                        for (int r = 0; r < 16; ++r) { const int kk = key0 + 32 * sub + (r & 3) + 8 * (r >> 2); if (kk > u.tq) p[sub][r] = -INFINITY; }
                }
            }
            if (MODE == A_WIN || MODE == A_SWA) {
                if (kt * 64 <= u.tq - r32 + 31 - u.window) {
#pragma unroll
                    for (int sub = 0; sub < 2; ++sub)
#pragma unroll
                        for (int r = 0; r < 16; ++r) { const int kk = key0 + 32 * sub + (r & 3) + 8 * (r >> 2); if (kk <= u.tq - u.window) p[sub][r] = -INFINITY; }
                }
            }
            if (MODE == A_SEL) {
                if (!((u.selm >> kt) & 1u)) {
#pragma unroll
                    for (int r = 0; r < 16; ++r) { p[0][r] = -INFINITY; p[1][r] = -INFINITY; }
                }
            }
            if (MODE == A_DSA) {
                const unsigned w0 = dm.x >> (4 * hi), w1 = dm.y >> (4 * hi);
#pragma unroll
                for (int r = 0; r < 16; ++r) {
                    const unsigned bit = 1u << ((r & 3) + 8 * (r >> 2));
                    if (!(w0 & bit)) p[0][r] = -INFINITY;
                    if (!(w1 & bit)) p[1][r] = -INFINITY;
                }
            }
            float mloc = p[0][0];
#pragma unroll
            for (int r = 1; r < 16; ++r) mloc = fmaxf(mloc, p[0][r]);
#pragma unroll
            for (int r = 0; r < 16; ++r) mloc = fmaxf(mloc, p[1][r]);
            mloc = hswap_max(mloc);
            const float mn = fmaxf(m, mloc);
            if (__any(mloc > m)) {
                const float alpha = __builtin_amdgcn_exp2f(m - mn);
                l *= alpha;
#pragma unroll
                for (int r = 0; r < 16; ++r) { o[0][r] *= alpha; o[1][r] *= alpha; }
            }
            m = mn;
            float ls = 0.f;
#pragma unroll
            for (int sub = 0; sub < 2; ++sub)
#pragma unroll
                for (int r = 0; r < 16; ++r) { const float e = __builtin_amdgcn_exp2f(p[sub][r] - mn); p[sub][r] = e; ls += e; }
            l += ls;
#pragma unroll
            for (int ks = 0; ks < 4; ++ks) {
                const int sub = ks >> 1, rb = 8 * (ks & 1);
                u32x4 pw;
                pw.x = cvtpk(p[sub][rb + 0], p[sub][rb + 1]); pw.y = cvtpk(p[sub][rb + 2], p[sub][rb + 3]);
                pw.z = cvtpk(p[sub][rb + 4], p[sub][rb + 5]); pw.w = cvtpk(p[sub][rb + 6], p[sub][rb + 7]);
                const bf16x8 pf = __builtin_bit_cast(bf16x8, pw);
                const int coff = ((ks * 2 + hi) ^ key) * 16;
                const bf16x8 v0 = *(const bf16x8*)(ldsV + r32 * 128 + coff);
                const bf16x8 v1 = *(const bf16x8*)(ldsV + (32 + r32) * 128 + coff);
                o[0] = MFMA32(v0, pf, o[0]);
                o[1] = MFMA32(v1, pf, o[1]);
            }
        }
    }
    __syncthreads();
    m_out = m; l_out = hswap_sum(l);
}

__device__ __forceinline__ void st_o(bf16_t* obase, long row, int col0, const f32x16 (&o)[2], float sc, int hi) {
#pragma unroll
    for (int dh = 0; dh < 2; ++dh) {
        bf16_t* dst = obase + ((long)((col0 >> 5) + dh) * T_ + row) * 32 + 4 * hi;
#pragma unroll
        for (int rg = 0; rg < 4; ++rg)
            st4(dst + 8 * rg, o[dh][rg * 4 + 0] * sc, o[dh][rg * 4 + 1] * sc, o[dh][rg * 4 + 2] * sc, o[dh][rg * 4 + 3] * sc);
    }
}
__device__ __forceinline__ void unit_fox(const Params& p, int unit, char* lds) {
    const int tid = otid(), lane = tid & 63, w = tid >> 6, r32 = lane & 31, hi = lane >> 5;
    const int qb = unit & 15, h = (unit >> 4) & 3, b = unit >> 6;
    const int q0 = qb * 128 + w * 32;
    AttnDesc u{};
    const long row = (long)b * S_ + q0 + r32;
    u.q = p.qb() + row * 256 + h * 64;
    u.k = p.kb() + (long)b * S_ * 256 + h * 64; u.ldk = 256;
    u.vt = p.vbT() + ((long)(b * 4 + h) * 64) * S_; u.ldvt = S_;
    u.kt_lo = 0; u.kt_hi = (qb * 128 + 127) >> 6; u.wkt_lo = 0; u.wkt_hi = (q0 + 31) >> 6;
    u.tq = q0 + r32;
    u.kbias = p.kbias() + (long)(b * 4 + h) * S_;
    f32x16 o[2]; float m, l;
    attn_core<A_FOX>(u, o, m, l, lds);
    st_o(p.o(), row, 256 + h * 64, o, 1.f / l, hi);
}
__device__ __forceinline__ void phase_fox(const Params& p, int bid, int nblk, char* lds) {
    for (int i = bid; i < B_ * 4 * 16; i += nblk) unit_fox(p, ((i & 31) << 4) | (15 - (i >> 5)), lds);
}
__device__ __forceinline__ void phase_cumsum(const Params& p, int bid, int nblk, int single = -1) {
    const int tid = otid(), lane = tid & 63, w = tid >> 6;
    for (int seq_ = bid * 4 + w; seq_ < (single >= 0 ? bid * 4 + w + 1 : B_ * 4); seq_ += nblk * 4) {
        const int seq = single >= 0 ? single * 4 + w : seq_;
        const int b = seq >> 2, h = seq & 3;
        float v[32]; float tot = 0.f;
#pragma unroll
        for (int i = 0; i < 32; ++i) { v[i] = p.logf()[((long)b * S_ + lane * 32 + i) * 4 + h]; tot += v[i]; }
        float inc = tot;
#pragma unroll
        for (int o = 1; o < 64; o <<= 1) { float t = __shfl_up(inc, o); if (lane >= o) inc += t; }
        float run = inc - tot;
#pragma unroll
        for (int i = 0; i < 32; ++i) { run += v[i]; p.kbias()[(long)(b * 4 + h) * S_ + lane * 32 + i] = -run * LOG2E; }
    }
}

__device__ __forceinline__ void unit_swa(const Params& p, int l, int unit, char* lds) {
    const int tid = otid(), lane = tid & 63, w = tid >> 6, r32 = lane & 31, hi = lane >> 5;
    const int qb = unit & 31, kvh = (unit >> 5) & 1, b = unit >> 6;
    const int h = kvh * 2 + (w & 1);
    const int q0 = qb * 64 + 32 * (w >> 1);
    AttnDesc u{};
    const long row = (long)b * S_ + q0 + r32;
    u.q = p.qd() + row * 256 + h * 64;
    u.k = p.kd() + (long)b * S_ * 128 + kvh * 64; u.ldk = 128;
    u.vt = p.vdT() + ((long)(b * 2 + kvh) * 64) * S_; u.ldvt = S_;
    int lo = qb * 64 - 127; if (lo < 0) lo = 0;
    u.kt_lo = lo >> 6; u.kt_hi = qb;
    int wlo = q0 - 127; if (wlo < 0) wlo = 0;
    u.wkt_lo = wlo >> 6; u.wkt_hi = (q0 + 31) >> 6;
    u.tq = q0 + r32; u.window = 128;
    f32x16 o[2]; float m, lsum;
    attn_core<A_SWA>(u, o, m, lsum, lds);
    const float sk = p.swa_sinks[l * 4 + h] * LOG2E;
    const float mn = fmaxf(m, sk); const float a = __builtin_amdgcn_exp2f(m - mn);
    st_o(p.o(), row, 768 + h * 64, o, a / (lsum * a + __builtin_amdgcn_exp2f(sk - mn)), hi);
}
__device__ __forceinline__ void phase_swa(const Params& p, int l, int bid, int nblk, char* lds) {
    for (int unit = bid; unit < B_ * 2 * 32; unit += nblk) unit_swa(p, l, unit, lds);
}
__device__ __forceinline__ void unit_win(const Params& p, int unit, char* lds) {
    const int tid = otid(), lane = tid & 63, w = tid >> 6, r32 = lane & 31, hi = lane >> 5;
    const int qb = unit & 63, b = unit >> 6;
    const int h = w, q0 = qb * 32;
    AttnDesc u{};
    const long row = (long)b * S_ + q0 + r32;
    u.q = p.qa() + row * 256 + h * 64;
    u.k = p.kwin() + (long)b * S_ * 64; u.ldk = 64;
    u.vt = p.vwinT() + ((long)b * 64) * S_; u.ldvt = S_;
    int lo = q0 - 511; if (lo < 0) lo = 0;
    u.kt_lo = lo >> 6; u.kt_hi = (q0 + 31) >> 6; u.wkt_lo = u.kt_lo; u.wkt_hi = u.kt_hi;
    u.tq = q0 + r32; u.window = 512;
    f32x16 o[2]; float m, lsum;
    attn_core<A_WIN>(u, o, m, lsum, lds);
    const float sc = p.ga()[row * 12 + h * 3 + 2] / lsum;
    float* dst = p.owin() + row * 256 + h * 64;
#pragma unroll
    for (int dh = 0; dh < 2; ++dh)
#pragma unroll
        for (int rg = 0; rg < 4; ++rg) {
            f32x4 v = {o[dh][rg * 4 + 0] * sc, o[dh][rg * 4 + 1] * sc, o[dh][rg * 4 + 2] * sc, o[dh][rg * 4 + 3] * sc};
            *(f32x4*)(dst + dh * 32 + 8 * rg + 4 * hi) = v;
        }
}
__device__ __forceinline__ void phase_win(const Params& p, int bid, int nblk, char* lds) {
    for (int unit = bid; unit < B_ * 64; unit += nblk) unit_win(p, unit, lds);
}
__device__ __forceinline__ void unit_sel(const Params& p, int unit, char* lds) {
    const int tid = otid(), lane = tid & 63, w = tid >> 6, r32 = lane & 31, hi = lane >> 5;
    const int qb = unit & 63, b = unit >> 6;
    const int h = w, q0 = qb * 32;
    AttnDesc u{};
    const long row = (long)b * S_ + q0 + r32;
    u.q = p.qa() + row * 256 + h * 64;
    u.k = p.ksel() + (long)b * S_ * 64; u.ldk = 64;
    u.vt = p.vselT() + ((long)b * 64) * S_; u.ldvt = S_;
    u.kt_lo = 0; u.kt_hi = (q0 + 31) >> 6; u.wkt_lo = 0; u.wkt_hi = u.kt_hi;
    u.tq = q0 + r32;
    u.selm = p.selmask()[row];
    unsigned orv = u.selm;
#pragma unroll
    for (int o_ = 32; o_ > 0; o_ >>= 1) orv |= (unsigned)__shfl_xor((int)orv, o_);
    u.tilemask = (unsigned)__builtin_amdgcn_readfirstlane((int)orv);
    f32x16 o[2]; float m, lsum;
    attn_core<A_SEL>(u, o, m, lsum, lds);
    const float sc = p.ga()[row * 12 + h * 3 + 1] / lsum;
    const float* oc = p.ocmp() + row * 256 + h * 64; const float* ow = p.owin() + row * 256 + h * 64;
#pragma unroll
    for (int dh = 0; dh < 2; ++dh)
#pragma unroll
        for (int rg = 0; rg < 4; ++rg) {
            const int c = dh * 32 + 8 * rg + 4 * hi;
            const f32x4 a = *(const f32x4*)(oc + c), bb = *(const f32x4*)(ow + c);
            bf16_t* dst = p.o() + ((long)(h * 2 + dh) * T_ + row) * 32 - dh * 32;
            st4(dst + c, o[dh][rg * 4 + 0] * sc + a[0] + bb[0], o[dh][rg * 4 + 1] * sc + a[1] + bb[1], o[dh][rg * 4 + 2] * sc + a[2] + bb[2],
                o[dh][rg * 4 + 3] * sc + a[3] + bb[3]);
        }
}
__device__ __forceinline__ void phase_sel(const Params& p, int bid, int nblk, char* lds) {
    for (int i = bid; i < B_ * 64; i += nblk) unit_sel(p, ((i & 7) << 6) | (63 - (i >> 3)), lds);
}
__device__ __forceinline__ void unit_dsa(const Params& p, int unit, char* lds) {
    const int tid = otid(), lane = tid & 63, w = tid >> 6, r32 = lane & 31, hi = lane >> 5;
    const int qb = unit & 15, h = (unit >> 4) & 3, b = unit >> 6;
    const int q0 = qb * 128 + w * 32;
    AttnDesc u{};
    const long row = (long)b * S_ + q0 + r32;
    u.q = p.qc() + row * 256 + h * 64;
    u.k = p.kcc() + (long)b * S_ * 256 + h * 64; u.ldk = 256;
    u.vt = p.vcT() + ((long)(b * 4 + h) * 64) * S_; u.ldvt = S_;
    u.kt_lo = 0; u.kt_hi = (qb * 128 + 127) >> 6; u.wkt_lo = 0; u.wkt_hi = (q0 + 31) >> 6;
    u.tq = q0 + r32;
    u.dmask = p.dmask() + row * 64;
    f32x16 o[2]; float m, lsum;
    attn_core<A_DSA>(u, o, m, lsum, lds);
    st_o(p.o(), row, 512 + h * 64, o, 1.f / lsum, hi);
}
__device__ __forceinline__ void phase_dsa(const Params& p, int bid, int nblk, char* lds) {
    for (int i = bid; i < B_ * 4 * 16; i += nblk) unit_dsa(p, ((i & 31) << 4) | (15 - (i >> 5)), lds);
}
__device__ __forceinline__ void phase_kvc(const Params& p, int l, int bid, int nblk, char* lds, int single = -1) {
    const int tid = otid(), lane = tid & 63, w = tid >> 6, r32 = lane & 31;
    const int wm = w & 1, wn = w >> 1;
    float* rsv = (float*)(lds + LDS_AUX);
    for (int unit_ = bid; unit_ < (single >= 0 ? bid + 1 : (T_ / 128) * 4); unit_ += nblk) {
        const int unit = single >= 0 ? single : unit_;
        const int tn = unit & 3, tm = unit >> 2;
        const int m0 = tm * 128;
        __syncthreads();
        {
            const int row = tid >> 1, half = tid & 1;
            const bf16_t* src = p.ckv() + (long)(m0 + row) * 128 + half * 64;
            float ss = 0.f;
#pragma unroll
            for (int i = 0; i < 8; ++i) {
                u32x4 v = *(const u32x4*)(src + i * 8);
#pragma unroll
                for (int j = 0; j < 4; ++j) { float a = __uint_as_float(v[j] << 16), b2 = __uint_as_float(v[j] & 0xffff0000u); ss += a * a + b2 * b2; }
            }
            ss += __shfl_xor(ss, 1);
            if (half == 0) rsv[row] = rsqrtf(ss / 128.f + 1e-6f);
        }
        f32x16 acc[2][2];
#pragma unroll
        for (int a = 0; a < 2; ++a)
#pragma unroll
            for (int b2 = 0; b2 < 2; ++b2)
#pragma unroll
                for (int r = 0; r < 16; ++r) acc[a][b2][r] = 0.f;
        const bf16_t* A = p.ckv() + (long)m0 * 128;
        const bf16_t* Bt = p.Wukv() + ((long)l * 512 + tn * 128) * 128;
        gemm_glds<BMODE_BF16_NK>(acc, [&](int r) { return A + (long)r * 128; }, [&](int r) { return Bt + (long)r * 128; }, 128, lds);
#pragma unroll
        for (int mi = 0; mi < 2; ++mi) {
            const float rs = rsv[wm * 64 + mi * 32 + r32];
#pragma unroll
            for (int ni = 0; ni < 2; ++ni)
#pragma unroll
                for (int r = 0; r < 16; ++r) acc[ni][mi][r] *= rs;
        }
        const int g = tn * 2 + wn;
        if (g < 4) epi_tok(acc, m0 + wm * 64, 1, 1.f, p.kcc(), 256, g * 64, p.cs(), p.sn());
        else epi_vt(acc, m0 + wm * 64, p.vcT(), 4, g - 4);
    }
}

#define SC_PER_B 2162688
__device__ __forceinline__ long sc_row_off(int b, int t) { const int qt = t >> 6; return (long)b * SC_PER_B + 2048L * qt * (qt + 1) + (long)(t & 63) * (qt + 1) * 64; }
__device__ __forceinline__ void idx_unit(const Params& p, int b, int qt, int kt0, int kt1, char* lds) {
    const int tid = otid(), lane = tid & 63, w = tid >> 6, r32 = lane & 31, hi = lane >> 5;
    const int qg = w & 1, ksub = w >> 1;
    const int lrow = tid >> 3, lch = tid & 7;
    if (kt1 <= kt0) return;
    const int t = qt * 64 + 32 * qg + r32; const long row = (long)b * S_ + t;
    bf16x8 qf[4][4];
#pragma unroll
    for (int h = 0; h < 4; ++h)
#pragma unroll
        for (int ds = 0; ds < 4; ++ds) qf[h][ds] = *(const bf16x8*)(p.qi() + row * 256 + h * 64 + ds * 16 + hi * 8);
    const f32x4 wv = *(const f32x4*)(p.wi() + row * 4);
    float* dst = p.sc() + sc_row_off(b, t) + 32 * ksub + 4 * hi;
    const bf16_t* kbase = p.ki() + (long)b * S_ * 64;
    u32x4 rk[2];
#pragma unroll
    for (int i = 0; i < 2; ++i) rk[i] = *(const u32x4*)(kbase + (long)(kt0 * 64 + lrow + 32 * i) * 64 + lch * 8);
    for (int kt = kt0; kt < kt1; ++kt) {
        __syncthreads();
#pragma unroll
        for (int i = 0; i < 2; ++i) *(u32x4*)(lds + (lrow + 32 * i) * TSTR + lch * 16) = rk[i];
        __syncthreads();
        if (kt + 1 < kt1) {
#pragma unroll
            for (int i = 0; i < 2; ++i) rk[i] = *(const u32x4*)(kbase + (long)((kt + 1) * 64 + lrow + 32 * i) * 64 + lch * 8);
        }
        bf16x8 kf[4];
#pragma unroll
        for (int ds = 0; ds < 4; ++ds) kf[ds] = *(const bf16x8*)(lds + (32 * ksub + r32) * TSTR + ds * 32 + hi * 16);
        f32x16 score;
#pragma unroll
        for (int r = 0; r < 16; ++r) score[r] = 0.f;
#pragma unroll
        for (int h = 0; h < 4; ++h) {
            f32x16 sacc;
#pragma unroll
            for (int r = 0; r < 16; ++r) sacc[r] = 0.f;
#pragma unroll
            for (int ds = 0; ds < 4; ++ds) sacc = MFMA32(kf[ds], qf[h][ds], sacc);
#pragma unroll
            for (int r = 0; r < 16; ++r) score[r] += wv[h] * fmaxf(sacc[r], 0.f);
        }
#pragma unroll
        for (int rg = 0; rg < 4; ++rg) {
            f32x4 v = {score[rg * 4 + 0], score[rg * 4 + 1], score[rg * 4 + 2], score[rg * 4 + 3]};
            *(f32x4*)(dst + kt * 64 + 8 * rg) = v;
        }
    }
    __syncthreads();
}
__device__ __forceinline__ void idx_pair(const Params& p, int pi, char* lds) {
    const int part = pi & 3, j = (pi >> 2) % 14, b = pi / 56;
    const int qa = 4 + j, qb = 31 - j;
    idx_unit(p, b, qb, ((qb + 1) * part) >> 2, ((qb + 1) * (part + 1)) >> 2, lds);
    idx_unit(p, b, qa, ((qa + 1) * part) >> 2, ((qa + 1) * (part + 1)) >> 2, lds);
}
__device__ __forceinline__ int wave_sum_i(int v) {
    v += __builtin_amdgcn_update_dpp(0, v, 0xB1, 0xF, 0xF, true);
    v += __builtin_amdgcn_update_dpp(0, v, 0x4E, 0xF, 0xF, true);
    v += __builtin_amdgcn_update_dpp(0, v, 0x141, 0xF, 0xF, true);
    v += __builtin_amdgcn_update_dpp(0, v, 0x140, 0xF, 0xF, true);
    return __builtin_amdgcn_readlane(v, 0) + __builtin_amdgcn_readlane(v, 16) + __builtin_amdgcn_readlane(v, 32) + __builtin_amdgcn_readlane(v, 48);
}
__device__ __forceinline__ void phase_dsel(const Params& p, int bid, int nblk, char* lds, int single = -1) {
    const int tid = otid(), lane = tid & 63, w = tid >> 6;
    float* wl = (float*)lds + w * 2304;
    for (int rowid_ = bid * 4 + w; rowid_ < (single >= 0 ? (bid * 4 + w) + 8 * nblk * 4 : T_); rowid_ += nblk * 4) {
        const int rowid = single >= 0 ? ((single & 7) * S_ + 32 * (63 - (single >> 3)) + ((rowid_ - (bid * 4 + w)) / (nblk * 4)) * 4 + w) : rowid_;
        const int b = rowid / S_, t = rowid % S_;
        unsigned word;
        if (t < 256) {
            const int lo = 32 * lane;
            word = (lo + 31 <= t) ? 0xffffffffu : (lo <= t ? ((1u << (t - lo + 1)) - 1u) : 0u);
        } else {
            const float* base = p.sc() + sc_row_off(b, t);
            const int rowlen = ((t >> 6) + 1) * 64;
#pragma unroll
            for (int i = 0; i < 8; ++i) {
                const int e = i * 256 + 4 * lane;
                if (e < rowlen) *(f32x4*)(wl + e + 4 * (e >> 5)) = *(const f32x4*)(base + e);
            }
            __builtin_amdgcn_s_waitcnt(0xc07f);
            unsigned u[32];
            if (32 * lane <= t) {
#pragma unroll
                for (int i = 0; i < 8; ++i) {
                    f32x4 v = *(const f32x4*)(wl + 36 * lane + 4 * i);
#pragma unroll
                    for (int j = 0; j < 4; ++j) {
                        unsigned bits = __float_as_uint(v[j]);
                        unsigned x = bits ^ ((bits >> 31) ? 0xffffffffu : 0x80000000u);
                        u[31 - (4 * i + j)] = (32 * lane + 4 * i + j <= t) ? x : 0u;
                    }
                }
            } else {
#pragma unroll
                for (int i = 0; i < 32; ++i) u[i] = 0u;
            }
            __builtin_amdgcn_s_waitcnt(0xc07f);
    { const unsigned t_ = (u[0] ^ (u[16] >> 16)) & 0x0000ffffu; u[0] ^= t_; u[16] ^= (t_ << 16); }
    { const unsigned t_ = (u[1] ^ (u[17] >> 16)) & 0x0000ffffu; u[1] ^= t_; u[17] ^= (t_ << 16); }
    { const unsigned t_ = (u[2] ^ (u[18] >> 16)) & 0x0000ffffu; u[2] ^= t_; u[18] ^= (t_ << 16); }
    { const unsigned t_ = (u[3] ^ (u[19] >> 16)) & 0x0000ffffu; u[3] ^= t_; u[19] ^= (t_ << 16); }
    { const unsigned t_ = (u[4] ^ (u[20] >> 16)) & 0x0000ffffu; u[4] ^= t_; u[20] ^= (t_ << 16); }
    { const unsigned t_ = (u[5] ^ (u[21] >> 16)) & 0x0000ffffu; u[5] ^= t_; u[21] ^= (t_ << 16); }
    { const unsigned t_ = (u[6] ^ (u[22] >> 16)) & 0x0000ffffu; u[6] ^= t_; u[22] ^= (t_ << 16); }
    { const unsigned t_ = (u[7] ^ (u[23] >> 16)) & 0x0000ffffu; u[7] ^= t_; u[23] ^= (t_ << 16); }
    { const unsigned t_ = (u[8] ^ (u[24] >> 16)) & 0x0000ffffu; u[8] ^= t_; u[24] ^= (t_ << 16); }
    { const unsigned t_ = (u[9] ^ (u[25] >> 16)) & 0x0000ffffu; u[9] ^= t_; u[25] ^= (t_ << 16); }
    { const unsigned t_ = (u[10] ^ (u[26] >> 16)) & 0x0000ffffu; u[10] ^= t_; u[26] ^= (t_ << 16); }
    { const unsigned t_ = (u[11] ^ (u[27] >> 16)) & 0x0000ffffu; u[11] ^= t_; u[27] ^= (t_ << 16); }
    { const unsigned t_ = (u[12] ^ (u[28] >> 16)) & 0x0000ffffu; u[12] ^= t_; u[28] ^= (t_ << 16); }
    { const unsigned t_ = (u[13] ^ (u[29] >> 16)) & 0x0000ffffu; u[13] ^= t_; u[29] ^= (t_ << 16); }
    { const unsigned t_ = (u[14] ^ (u[30] >> 16)) & 0x0000ffffu; u[14] ^= t_; u[30] ^= (t_ << 16); }
    { const unsigned t_ = (u[15] ^ (u[31] >> 16)) & 0x0000ffffu; u[15] ^= t_; u[31] ^= (t_ << 16); }
    { const unsigned t_ = (u[0] ^ (u[8] >> 8)) & 0x00ff00ffu; u[0] ^= t_; u[8] ^= (t_ << 8); }
    { const unsigned t_ = (u[1] ^ (u[9] >> 8)) & 0x00ff00ffu; u[1] ^= t_; u[9] ^= (t_ << 8); }
    { const unsigned t_ = (u[2] ^ (u[10] >> 8)) & 0x00ff00ffu; u[2] ^= t_; u[10] ^= (t_ << 8); }
    { const unsigned t_ = (u[3] ^ (u[11] >> 8)) & 0x00ff00ffu; u[3] ^= t_; u[11] ^= (t_ << 8); }
    { const unsigned t_ = (u[4] ^ (u[12] >> 8)) & 0x00ff00ffu; u[4] ^= t_; u[12] ^= (t_ << 8); }
    { const unsigned t_ = (u[5] ^ (u[13] >> 8)) & 0x00ff00ffu; u[5] ^= t_; u[13] ^= (t_ << 8); }
    { const unsigned t_ = (u[6] ^ (u[14] >> 8)) & 0x00ff00ffu; u[6] ^= t_; u[14] ^= (t_ << 8); }
    { const unsigned t_ = (u[7] ^ (u[15] >> 8)) & 0x00ff00ffu; u[7] ^= t_; u[15] ^= (t_ << 8); }
    { const unsigned t_ = (u[16] ^ (u[24] >> 8)) & 0x00ff00ffu; u[16] ^= t_; u[24] ^= (t_ << 8); }
    { const unsigned t_ = (u[17] ^ (u[25] >> 8)) & 0x00ff00ffu; u[17] ^= t_; u[25] ^= (t_ << 8); }
    { const unsigned t_ = (u[18] ^ (u[26] >> 8)) & 0x00ff00ffu; u[18] ^= t_; u[26] ^= (t_ << 8); }
    { const unsigned t_ = (u[19] ^ (u[27] >> 8)) & 0x00ff00ffu; u[19] ^= t_; u[27] ^= (t_ << 8); }
    { const unsigned t_ = (u[20] ^ (u[28] >> 8)) & 0x00ff00ffu; u[20] ^= t_; u[28] ^= (t_ << 8); }
    { const unsigned t_ = (u[21] ^ (u[29] >> 8)) & 0x00ff00ffu; u[21] ^= t_; u[29] ^= (t_ << 8); }
    { const unsigned t_ = (u[22] ^ (u[30] >> 8)) & 0x00ff00ffu; u[22] ^= t_; u[30] ^= (t_ << 8); }
    { const unsigned t_ = (u[23] ^ (u[31] >> 8)) & 0x00ff00ffu; u[23] ^= t_; u[31] ^= (t_ << 8); }
    { const unsigned t_ = (u[0] ^ (u[4] >> 4)) & 0x0f0f0f0fu; u[0] ^= t_; u[4] ^= (t_ << 4); }
    { const unsigned t_ = (u[1] ^ (u[5] >> 4)) & 0x0f0f0f0fu; u[1] ^= t_; u[5] ^= (t_ << 4); }
    { const unsigned t_ = (u[2] ^ (u[6] >> 4)) & 0x0f0f0f0fu; u[2] ^= t_; u[6] ^= (t_ << 4); }
    { const unsigned t_ = (u[3] ^ (u[7] >> 4)) & 0x0f0f0f0fu; u[3] ^= t_; u[7] ^= (t_ << 4); }
    { const unsigned t_ = (u[8] ^ (u[12] >> 4)) & 0x0f0f0f0fu; u[8] ^= t_; u[12] ^= (t_ << 4); }
    { const unsigned t_ = (u[9] ^ (u[13] >> 4)) & 0x0f0f0f0fu; u[9] ^= t_; u[13] ^= (t_ << 4); }
    { const unsigned t_ = (u[10] ^ (u[14] >> 4)) & 0x0f0f0f0fu; u[10] ^= t_; u[14] ^= (t_ << 4); }
    { const unsigned t_ = (u[11] ^ (u[15] >> 4)) & 0x0f0f0f0fu; u[11] ^= t_; u[15] ^= (t_ << 4); }
    { const unsigned t_ = (u[16] ^ (u[20] >> 4)) & 0x0f0f0f0fu; u[16] ^= t_; u[20] ^= (t_ << 4); }
    { const unsigned t_ = (u[17] ^ (u[21] >> 4)) & 0x0f0f0f0fu; u[17] ^= t_; u[21] ^= (t_ << 4); }
    { const unsigned t_ = (u[18] ^ (u[22] >> 4)) & 0x0f0f0f0fu; u[18] ^= t_; u[22] ^= (t_ << 4); }
    { const unsigned t_ = (u[19] ^ (u[23] >> 4)) & 0x0f0f0f0fu; u[19] ^= t_; u[23] ^= (t_ << 4); }
    { const unsigned t_ = (u[24] ^ (u[28] >> 4)) & 0x0f0f0f0fu; u[24] ^= t_; u[28] ^= (t_ << 4); }
    { const unsigned t_ = (u[25] ^ (u[29] >> 4)) & 0x0f0f0f0fu; u[25] ^= t_; u[29] ^= (t_ << 4); }
    { const unsigned t_ = (u[26] ^ (u[30] >> 4)) & 0x0f0f0f0fu; u[26] ^= t_; u[30] ^= (t_ << 4); }
    { const unsigned t_ = (u[27] ^ (u[31] >> 4)) & 0x0f0f0f0fu; u[27] ^= t_; u[31] ^= (t_ << 4); }
    { const unsigned t_ = (u[0] ^ (u[2] >> 2)) & 0x33333333u; u[0] ^= t_; u[2] ^= (t_ << 2); }
    { const unsigned t_ = (u[1] ^ (u[3] >> 2)) & 0x33333333u; u[1] ^= t_; u[3] ^= (t_ << 2); }
    { const unsigned t_ = (u[4] ^ (u[6] >> 2)) & 0x33333333u; u[4] ^= t_; u[6] ^= (t_ << 2); }
    { const unsigned t_ = (u[5] ^ (u[7] >> 2)) & 0x33333333u; u[5] ^= t_; u[7] ^= (t_ << 2); }
    { const unsigned t_ = (u[8] ^ (u[10] >> 2)) & 0x33333333u; u[8] ^= t_; u[10] ^= (t_ << 2); }
    { const unsigned t_ = (u[9] ^ (u[11] >> 2)) & 0x33333333u; u[9] ^= t_; u[11] ^= (t_ << 2); }
    { const unsigned t_ = (u[12] ^ (u[14] >> 2)) & 0x33333333u; u[12] ^= t_; u[14] ^= (t_ << 2); }
    { const unsigned t_ = (u[13] ^ (u[15] >> 2)) & 0x33333333u; u[13] ^= t_; u[15] ^= (t_ << 2); }
    { const unsigned t_ = (u[16] ^ (u[18] >> 2)) & 0x33333333u; u[16] ^= t_; u[18] ^= (t_ << 2); }
    { const unsigned t_ = (u[17] ^ (u[19] >> 2)) & 0x33333333u; u[17] ^= t_; u[19] ^= (t_ << 2); }
    { const unsigned t_ = (u[20] ^ (u[22] >> 2)) & 0x33333333u; u[20] ^= t_; u[22] ^= (t_ << 2); }
    { const unsigned t_ = (u[21] ^ (u[23] >> 2)) & 0x33333333u; u[21] ^= t_; u[23] ^= (t_ << 2); }
    { const unsigned t_ = (u[24] ^ (u[26] >> 2)) & 0x33333333u; u[24] ^= t_; u[26] ^= (t_ << 2); }
    { const unsigned t_ = (u[25] ^ (u[27] >> 2)) & 0x33333333u; u[25] ^= t_; u[27] ^= (t_ << 2); }
    { const unsigned t_ = (u[28] ^ (u[30] >> 2)) & 0x33333333u; u[28] ^= t_; u[30] ^= (t_ << 2); }
    { const unsigned t_ = (u[29] ^ (u[31] >> 2)) & 0x33333333u; u[29] ^= t_; u[31] ^= (t_ << 2); }
    { const unsigned t_ = (u[0] ^ (u[1] >> 1)) & 0x55555555u; u[0] ^= t_; u[1] ^= (t_ << 1); }
    { const unsigned t_ = (u[2] ^ (u[3] >> 1)) & 0x55555555u; u[2] ^= t_; u[3] ^= (t_ << 1); }
    { const unsigned t_ = (u[4] ^ (u[5] >> 1)) & 0x55555555u; u[4] ^= t_; u[5] ^= (t_ << 1); }
    { const unsigned t_ = (u[6] ^ (u[7] >> 1)) & 0x55555555u; u[6] ^= t_; u[7] ^= (t_ << 1); }
    { const unsigned t_ = (u[8] ^ (u[9] >> 1)) & 0x55555555u; u[8] ^= t_; u[9] ^= (t_ << 1); }
    { const unsigned t_ = (u[10] ^ (u[11] >> 1)) & 0x55555555u; u[10] ^= t_; u[11] ^= (t_ << 1); }
    { const unsigned t_ = (u[12] ^ (u[13] >> 1)) & 0x55555555u; u[12] ^= t_; u[13] ^= (t_ << 1); }
    { const unsigned t_ = (u[14] ^ (u[15] >> 1)) & 0x55555555u; u[14] ^= t_; u[15] ^= (t_ << 1); }
    { const unsigned t_ = (u[16] ^ (u[17] >> 1)) & 0x55555555u; u[16] ^= t_; u[17] ^= (t_ << 1); }
    { const unsigned t_ = (u[18] ^ (u[19] >> 1)) & 0x55555555u; u[18] ^= t_; u[19] ^= (t_ << 1); }
    { const unsigned t_ = (u[20] ^ (u[21] >> 1)) & 0x55555555u; u[20] ^= t_; u[21] ^= (t_ << 1); }
    { const unsigned t_ = (u[22] ^ (u[23] >> 1)) & 0x55555555u; u[22] ^= t_; u[23] ^= (t_ << 1); }
    { const unsigned t_ = (u[24] ^ (u[25] >> 1)) & 0x55555555u; u[24] ^= t_; u[25] ^= (t_ << 1); }
    { const unsigned t_ = (u[26] ^ (u[27] >> 1)) & 0x55555555u; u[26] ^= t_; u[27] ^= (t_ << 1); }
    { const unsigned t_ = (u[28] ^ (u[29] >> 1)) & 0x55555555u; u[28] ^= t_; u[29] ^= (t_ << 1); }
    { const unsigned t_ = (u[30] ^ (u[31] >> 1)) & 0x55555555u; u[30] ^= t_; u[31] ^= (t_ << 1); }
            unsigned gtm = 0u, eqm = 0xffffffffu; int cgt = 0; bool exact = false;
#pragma unroll
            for (int bit = 31; bit >= 0; --bit) {
                if (!exact) {
                    const unsigned m1 = eqm & u[31 - bit];
                    const int c = cgt + wave_sum_i(__builtin_popcount(m1));
                    if (c >= 256) { eqm = m1; if (c == 256) { exact = true; gtm |= m1; eqm = 0u; } }
                    else { gtm |= m1; eqm &= ~u[31 - bit]; cgt = c; }
                }
            }
            const unsigned gt = gtm, eq = eqm;
            unsigned take = 0u;
            if (!exact) {
                const int need = 256 - cgt;
                const int e = __builtin_popcount(eq);
                int inc = e;
#pragma unroll
                for (int o_ = 1; o_ < 64; o_ <<= 1) { int tt = __shfl_up(inc, o_); if (lane >= o_) inc += tt; }
                int k = need - (inc - e); if (k > e) k = e;
                unsigned x = eq;
                while (k > 0) { unsigned low = x & (0u - x); take |= low; x ^= low; --k; }
            }
            word = gt | take;
        }
        p.dmask()[(long)rowid * 64 + lane] = word;
    }
}
#define HSTR 528
__device__ __forceinline__ float gelu_tanh_f(float x) {
    const float u = 0.7978845608028654f * (x + 0.044715f * x * x * x);
    const float e = __expf(2.f * u);
    const float th = 1.f - 2.f / (e + 1.f);
    return 0.5f * x * (1.f + th);
}
#define CSTG 18432
__device__ __forceinline__ void phase_compress(const Params& p, int l, int bid, int nblk, char* lds, int single = -1) {
    const int tid = otid(), lane = tid & 63, w = tid >> 6, r32 = lane & 31, hi = lane >> 5;
    const unsigned lds0 = (unsigned)(uintptr_t)lds;
    for (int unit_ = bid; unit_ < (single >= 0 ? bid + 1 : 64); unit_ += nblk) {
        const int unit = single >= 0 ? single : unit_;
        const int kv = unit & 1, rt = unit >> 1;
        const bf16_t* src = kv ? p.vcmp() : p.kcmp();
        const bf16_t* Bt = p.W1t() + (long)(l * 2 + kv) * 256 * 2048;
        const int lrow = lane >> 2, lch = ((lane & 3) ^ ((lane >> 4) & 3)) * 8;
        const bf16_t* ap = nullptr;
        if (w < 2) { int R = rt * 32 + 16 * w + lrow; if (R > 1015) R = 1015; const int b = R / NCMP, c = R % NCMP; ap = src + ((long)b * S_ + 16 * c) * 64 + lch; }
        const bf16_t* bp[4];
#pragma unroll
        for (int i = 0; i < 4; ++i) bp[i] = Bt + (long)(64 * w + 16 * i + lrow) * 2048 + lch;
        auto issue = [&](int s_, int stg) {
            const unsigned base = lds0 + stg * CSTG;
            if (w < 2) glds16(ap + s_ * 32, (unsigned)__builtin_amdgcn_readfirstlane(base + (16 * w) * 64));
#pragma unroll
            for (int i = 0; i < 4; ++i) glds16(bp[i] + s_ * 32, (unsigned)__builtin_amdgcn_readfirstlane(base + 2048 + (64 * w + 16 * i) * 64));
        };
        f32x16 acc[2];
#pragma unroll
        for (int r = 0; r < 16; ++r) { acc[0][r] = 0.f; acc[1][r] = 0.f; }
        const int n = 2048 / 32;
        issue(0, 0); issue(1, 1);
        const int key = (r32 >> 2) & 3;
        int stg = 0;
        for (int s_ = 0; s_ < n; ++s_) {
            if (s_ + 1 < n) { if (w < 2) asm volatile("s_waitcnt vmcnt(5) lgkmcnt(0)\n\ts_barrier" ::: "memory"); else asm volatile("s_waitcnt vmcnt(4) lgkmcnt(0)\n\ts_barrier" ::: "memory"); }
            else asm volatile("s_waitcnt vmcnt(0) lgkmcnt(0)\n\ts_barrier" ::: "memory");
            if (s_ + 2 < n) { int st2 = stg + 2; if (st2 >= 3) st2 -= 3; issue(s_ + 2, st2); }
            const char* bufA = lds + stg * CSTG; const char* bufB = bufA + 2048;
#pragma unroll
            for (int ks = 0; ks < 2; ++ks) {
                const int coff = (((ks * 2 + hi) ^ key) * 16);
                const bf16x8 af = *(const bf16x8*)(bufA + r32 * 64 + coff);
#pragma unroll
                for (int ni = 0; ni < 2; ++ni) acc[ni] = MFMA32(*(const bf16x8*)(bufB + (w * 64 + ni * 32 + r32) * 64 + coff), af, acc[ni]);
            }
            if (++stg == 3) stg = 0;
        }
        __syncthreads();
        const float* peb = p.peb() + (l * 2 + kv) * 256;
#pragma unroll
        for (int ni = 0; ni < 2; ++ni)
#pragma unroll
            for (int rg = 0; rg < 4; ++rg) {
                const int nn = w * 64 + ni * 32 + 8 * rg + 4 * hi;
                const f32x4 bv = *(const f32x4*)(peb + nn);
                u32x2 v;
                v.x = cvtpk(gelu_tanh_f(acc[ni][rg * 4 + 0] + bv[0]), gelu_tanh_f(acc[ni][rg * 4 + 1] + bv[1]));
                v.y = cvtpk(gelu_tanh_f(acc[ni][rg * 4 + 2] + bv[2]), gelu_tanh_f(acc[ni][rg * 4 + 3] + bv[3]));
                *(u32x2*)(lds + r32 * HSTR + nn * 2) = v;
            }
        __syncthreads();
        if (w < 2) {
            const int ni2 = w;
            const bf16_t* W2 = p.W2t() + (long)(l * 2 + kv) * 64 * 256 + (long)(ni2 * 32 + r32) * 256 + hi * 8;
            f32x16 a2;
#pragma unroll
            for (int r = 0; r < 16; ++r) a2[r] = 0.f;
#pragma unroll
            for (int ks = 0; ks < 16; ++ks) {
                const bf16x8 bf = *(const bf16x8*)(W2 + ks * 16);
                const bf16x8 af = *(const bf16x8*)(lds + r32 * HSTR + ks * 32 + hi * 16);
                a2 = MFMA32(bf, af, a2);
            }
            const int R = rt * 32 + r32;
            if (R < 1016) {
                const int b = R / NCMP, c = R % NCMP;
                if (kv == 0) {
#pragma unroll
                    for (int rg = 0; rg < 4; ++rg) st4(p.kcb() + ((long)b * 128 + c) * 64 + ni2 * 32 + 8 * rg + 4 * hi, a2[rg * 4 + 0], a2[rg * 4 + 1], a2[rg * 4 + 2], a2[rg * 4 + 3]);
                } else {
#pragma unroll
                    for (int r = 0; r < 16; ++r) p.vcbT()[((long)b * 64 + ni2 * 32 + crow(r, hi)) * 128 + vtpos(c)] = f2bf(a2[r]);
                }
            }
        }
        __syncthreads();
    }
}
__device__ __forceinline__ void phase_cmp(const Params& p, int bid, int nblk, char* lds, int single = -1) {
    const int tid = otid(), lane = tid & 63, w = tid >> 6, r32 = lane & 31, hi = lane >> 5;
    float* slab = (float*)(lds + 40960);
    for (int unit_ = bid; unit_ < (single >= 0 ? bid + 1 : B_ * 64); unit_ += nblk) {
        const int unit = single >= 0 ? single : unit_;
        const int qb = unit & 63, b = unit >> 6;
        const int h = w, q0 = qb * 32;
        AttnDesc u{};
        const int t = q0 + r32; const long row = (long)b * S_ + t;
        u.q = p.qa() + row * 256 + h * 64;
        u.k = p.kcb() + (long)b * 128 * 64; u.ldk = 64;
        u.vt = p.vcbT() + (long)b * 64 * 128; u.ldvt = 128;
        int lim = (t - 31) >> 4; if (lim > 126) lim = 126;
        int maxlim = (q0 + 31 - 31) >> 4; if (maxlim > 126) maxlim = 126;
        u.kt_lo = 0; u.kt_hi = (maxlim >= 64) ? 1 : 0; u.wkt_lo = 0; u.wkt_hi = u.kt_hi;
        u.tq = lim;
        f32x16 o[2]; float m, lsum;
        attn_core<A_CMP>(u, o, m, lsum, lds);
        const float inv = (lsum > 0.f) ? 1.f / lsum : 0.f;
        {
            const float sc = p.ga()[row * 12 + h * 3 + 0] * inv;
            float* dst = p.ocmp() + row * 256 + h * 64;
#pragma unroll
            for (int dh = 0; dh < 2; ++dh)
#pragma unroll
                for (int rg = 0; rg < 4; ++rg) {
                    f32x4 v = {o[dh][rg * 4 + 0] * sc, o[dh][rg * 4 + 1] * sc, o[dh][rg * 4 + 2] * sc, o[dh][rg * 4 + 3] * sc};
                    *(f32x4*)(dst + dh * 32 + 8 * rg + 4 * hi) = v;
                }
        }
        {
            const int lrow = tid >> 3, lch = tid & 7;
#pragma unroll
            for (int i = 0; i < 4; ++i) *(u32x4*)(lds + (lrow + 32 * i) * TSTR + lch * 16) = *(const u32x4*)(u.k + (long)(lrow + 32 * i) * 64 + lch * 8);
        }
        __syncthreads();
        bf16x8 qf[4];
#pragma unroll
        for (int ds = 0; ds < 4; ++ds) qf[ds] = *(const bf16x8*)(u.q + ds * 16 + hi * 8);
        float G[16], Lst[16];
#pragma unroll
        for (int s4 = 0; s4 < 4; ++s4) {
            f32x16 sa;
#pragma unroll
            for (int r = 0; r < 16; ++r) sa[r] = 0.f;
#pragma unroll
            for (int ds = 0; ds < 4; ++ds) sa = MFMA32(*(const bf16x8*)(lds + (32 * s4 + r32) * TSTR + ds * 32 + hi * 16), qf[ds], sa);
#pragma unroll
            for (int rg = 0; rg < 4; ++rg) {
                float g = 0.f, last = 0.f;
#pragma unroll
                for (int j = 0; j < 4; ++j) {
                    const int c = 32 * s4 + 8 * rg + 4 * hi + j;
                    const float pn = (c <= lim) ? __builtin_amdgcn_exp2f(sa[rg * 4 + j] - m) * inv : 0.f;
                    g += pn; last = pn;
                }
                G[s4 * 4 + rg] = g; Lst[s4 * 4 + rg] = last;
            }
        }
        float* myslab = slab + (h * 32 + r32) * 33;
#pragma unroll
        for (int i = 0; i < 16; ++i) { const int jj = 8 * (i >> 2) + 2 * (i & 3) + hi; myslab[jj] = G[i]; }
        __builtin_amdgcn_s_waitcnt(0xc07f);
#pragma unroll
        for (int i = 0; i < 16; ++i) { const int jj = 8 * (i >> 2) + 2 * (i & 3) + hi; if (jj + 1 < 32) atomicAdd(&myslab[jj + 1], Lst[i]); }
        __syncthreads();
        {
            const int j = lane & 31, half = lane >> 5;
#pragma unroll
            for (int i = 0; i < 4; ++i) {
                const int q = w * 8 + i * 2 + half; const int tt = q0 + q; const int cur = tt >> 6;
                float a = slab[(0 * 32 + q) * 33 + j] + slab[(1 * 32 + q) * 33 + j] + slab[(2 * 32 + q) * 33 + j] + slab[(3 * 32 + q) * 33 + j];
                if (j == 0 || j == cur || j == cur - 1) a = 1e4f;
                if (j > cur) a = -1e4f;
                int rank = 0;
#pragma unroll
                for (int j2 = 0; j2 < 32; ++j2) { const float uu = __shfl(a, j2 + 32 * half); rank += ((uu > a) || (uu == a && j2 < j)) ? 1 : 0; }
                const unsigned long long bal = __ballot(rank < 16);
                if (j == 0) p.selmask()[(long)b * S_ + tt] = (unsigned)(bal >> (32 * half));
            }
        }
        __syncthreads();
    }
}

__device__ __forceinline__ void phase_merge(const Params& p, int l, int bid, int nblk, char* lds) {
    const int tid = otid(), lane = tid & 63, w = tid >> 6, r32 = lane & 31, hi = lane >> 5;
    const int wm = w & 1, wn = w >> 1;
    for (int it = 0;; ++it) {
        int tm, tn; bool done;
        if (!raster_tile(it, bid, nblk, T_ / 128, 8, tm, tn, done)) { if (done) break; continue; }
        const int m0 = tm * 128, n0 = tn * 128;
        f32x16 acc[2][2], tot[2][2];
#pragma unroll
        for (int a = 0; a < 2; ++a)
#pragma unroll
            for (int b2 = 0; b2 < 2; ++b2)
#pragma unroll
                for (int r = 0; r < 16; ++r) { acc[a][b2][r] = 0.f; tot[a][b2][r] = 0.f; }
        const bf16_t* A = p.o() + (long)m0 * 32;
        const bf16_t* Bt = p.Wbt() + (long)l * 1024 * 1024 + (long)n0 * 32;
        u32x4 gq[2][2][2];
        auto loadg = [&](int i) {
#pragma unroll
            for (int mi = 0; mi < 2; ++mi)
#pragma unroll
                for (int ni = 0; ni < 2; ++ni) {
                    const long blk = (long)(((m0 + wm * 64) >> 5) + mi) * 128 + ((i * 1024 + n0 + wn * 64) >> 5) + ni;
                    const bf16_t* gp = p.gates() + blk * 1024 + lane * 8;
                    gq[mi][ni][0] = *(const u32x4*)gp; gq[mi][ni][1] = *(const u32x4*)(gp + 512);
                }
        };
        loadg(0);
        auto hook = [&](int kt) {
            if ((kt & 7) == 7) {
                const int i = kt >> 3;
#pragma unroll
                for (int mi = 0; mi < 2; ++mi) {
#pragma unroll
                    for (int ni = 0; ni < 2; ++ni) {
#pragma unroll
                        for (int hf = 0; hf < 2; ++hf) {
                            const u32x4 gv = gq[mi][ni][hf];
#pragma unroll
                            for (int j = 0; j < 4; ++j) {
                                tot[ni][mi][hf * 8 + 2 * j] += acc[ni][mi][hf * 8 + 2 * j] * __uint_as_float(gv[j] << 16);
                                tot[ni][mi][hf * 8 + 2 * j + 1] += acc[ni][mi][hf * 8 + 2 * j + 1] * __uint_as_float(gv[j] & 0xffff0000u);
                                acc[ni][mi][hf * 8 + 2 * j] = 0.f; acc[ni][mi][hf * 8 + 2 * j + 1] = 0.f;
                            }
                        }
                    }
                }
                if (i + 1 < 4) loadg(i + 1);
            }
        };
        gemm_mid(acc, A, [&](int r) { return r * 32; }, Bt, [&](int r) { return r * 32; }, 1024, lds, (long)T_ * 32, (long)1024 * 32, hook);
#pragma unroll
        for (int mi = 0; mi < 2; ++mi) {
            const long mrow = m0 + wm * 64 + mi * 32 + r32;
#pragma unroll
            for (int ni = 0; ni < 2; ++ni) {
                bf16_t* dst = p.merged() + ((long)((n0 + wn * 64 + ni * 32) >> 5) * T_ + mrow) * 32 + 4 * hi;
#pragma unroll
                for (int rg = 0; rg < 4; ++rg) st4(dst + 8 * rg, tot[ni][mi][rg * 4 + 0], tot[ni][mi][rg * 4 + 1], tot[ni][mi][rg * 4 + 2], tot[ni][mi][rg * 4 + 3]);
            }
        }
    }
}
__device__ __forceinline__ void phase_outproj(const Params& p, int l, int bid, int nblk, char* lds) {
    const int tid = otid(), lane = tid & 63, w = tid >> 6, r32 = lane & 31, hi = lane >> 5;
    const int wm = w & 1, wn = w >> 1;
    for (int it = 0;; ++it) {
        int tm, tn; bool done;
        if (!raster_tile(it, bid, nblk, T_ / 256, 8, tm, tn, done)) { if (done) break; continue; }
        const int m0 = tm * 256, n0 = tn * 128;
        f32x16 accb[2][2][2];
#pragma unroll
        for (int c = 0; c < 2; ++c)
#pragma unroll
            for (int a = 0; a < 2; ++a)
#pragma unroll
                for (int b2 = 0; b2 < 2; ++b2)
#pragma unroll
                    for (int r = 0; r < 16; ++r) accb[c][a][b2][r] = 0.f;
        const bf16_t* A = p.merged() + (long)m0 * 32;
        const bf16_t* Bt = p.Wot() + (long)l * 1024 * 1024 + (long)n0 * 32;
        gemm_big_issue01(A, 32, Bt, 32, lds, (long)T_ * 32, (long)1024 * 32);
        gemm_big(accb, A, 32, Bt, 32, 1024, lds, (long)T_ * 32, (long)1024 * 32);
#pragma unroll
        for (int mh = 0; mh < 2; ++mh)
#pragma unroll
            for (int mi = 0; mi < 2; ++mi) {
                const long eo = (long)(m0 + wm * 128 + mh * 64 + mi * 32 + r32) * D_ + n0 + wn * 64 + 4 * hi;
                float* dst = p.h() + eo;
                const float* rsrc = (l == 0 ? p.x : (const float*)p.h()) + eo;
#pragma unroll
                for (int ni = 0; ni < 2; ++ni)
#pragma unroll
                    for (int rg = 0; rg < 4; ++rg) {
                        f32x4 v = *(const f32x4*)(rsrc + ni * 32 + 8 * rg);
                        v[0] += accb[mh][ni][mi][rg * 4 + 0]; v[1] += accb[mh][ni][mi][rg * 4 + 1]; v[2] += accb[mh][ni][mi][rg * 4 + 2]; v[3] += accb[mh][ni][mi][rg * 4 + 3];
                        *(f32x4*)(dst + ni * 32 + 8 * rg) = v;
                    }
            }
    }
}
__device__ __forceinline__ void phase_router(const Params& p, int l, int bid, int nblk, char* lds) {
    const int tid = otid(), lane = tid & 63, w = tid >> 6;
    const int ti = lane & 15, kq = lane >> 4;
    const int kh = w & 1, tw = w >> 1;
    float* xch = (float*)lds + tw * (21 * 64);
    char* xsv = lds + 10752 + w * 16384;
    float* lgw = (float*)xsv;
    const float* Wr = p.Wrt() + (long)l * 80 * 1024;
    for (int task_ = bid * 2; task_ < T_ / 16; task_ += nblk * 2) {
        const int task = task_ + tw;
        const int t0 = task * 16;
        const float* xr = p.h() + (long)(t0 + ti) * D_ + 4 * kq + kh * 512;
        f32x4 acc[5];
#pragma unroll
        for (int nt = 0; nt < 5; ++nt) acc[nt] = (f32x4){0.f, 0.f, 0.f, 0.f};
        float ss = 0.f;
        const float* xr8 = p.h() + (long)(t0 + ti) * D_ + 8 * kq + kh * 512;
        const bf16_t* whp = (const bf16_t*)p.Wrt() + (long)l * 80 * 1024 + (long)ti * 1024 + kh * 512 + 8 * kq;
        const bf16_t* wlp = whp + 2 * 80 * 1024;
        typedef f32x4 f4_;
        f4_ xa[4][2]; bf16x8 wh_[3][5], wl_[3][5];
#define RT_LOADX(slot, c) do { xa[slot][0] = *(const f4_*)(xr8 + (c) * 32); xa[slot][1] = *(const f4_*)(xr8 + (c) * 32 + 4); } while (0)
#define RT_LOADW(set, c) do { \
            _Pragma("unroll") for (int nt = 0; nt < 5; ++nt) { wh_[set][nt] = *(const bf16x8*)(whp + (long)nt * 16 * 1024 + (c) * 32); wl_[set][nt] = *(const bf16x8*)(wlp + (long)nt * 16 * 1024 + (c) * 32); } } while (0)
#define RT_MMA(set, slot, cidx) do { \
            float xv[8] = {xa[slot][0][0], xa[slot][0][1], xa[slot][0][2], xa[slot][0][3], xa[slot][1][0], xa[slot][1][1], xa[slot][1][2], xa[slot][1][3]}; \
            if ((cidx) + 4 < 16) RT_LOADX(slot, (cidx) + 4); \
            u32x4 ph, pl; \
            _Pragma("unroll") for (int j = 0; j < 4; ++j) { \
                ss += xv[2 * j] * xv[2 * j] + xv[2 * j + 1] * xv[2 * j + 1]; \
                const unsigned hw = cvtpk(xv[2 * j], xv[2 * j + 1]); ph[j] = hw; \
                pl[j] = cvtpk(xv[2 * j] - __uint_as_float(hw << 16), xv[2 * j + 1] - __uint_as_float(hw & 0xffff0000u)); } \
            *(u32x4*)(xsv + (cidx) * 1024 + lane * 16) = ph; \
            const bf16x8 xh = __builtin_bit_cast(bf16x8, ph), xl = __builtin_bit_cast(bf16x8, pl); \
            _Pragma("unroll") for (int nt = 0; nt < 5; ++nt) acc[nt] = __builtin_amdgcn_mfma_f32_16x16x32_bf16(xh, wh_[set][nt], acc[nt], 0, 0, 0); \
            _Pragma("unroll") for (int nt = 0; nt < 5; ++nt) acc[nt] = __builtin_amdgcn_mfma_f32_16x16x32_bf16(xh, wl_[set][nt], acc[nt], 0, 0, 0); \
            _Pragma("unroll") for (int nt = 0; nt < 5; ++nt) acc[nt] = __builtin_amdgcn_mfma_f32_16x16x32_bf16(xl, wh_[set][nt], acc[nt], 0, 0, 0); } while (0)
        RT_LOADX(0, 0); RT_LOADX(1, 1); RT_LOADX(2, 2); RT_LOADX(3, 3);
        RT_LOADW(0, 0); RT_LOADW(1, 1);
        RT_LOADW(2, 2); RT_MMA(0, 0, 0);
        RT_LOADW(0, 3); RT_MMA(1, 1, 1);
        RT_LOADW(1, 4); RT_MMA(2, 2, 2);
        RT_LOADW(2, 5); RT_MMA(0, 3, 3);
        RT_LOADW(0, 6); RT_MMA(1, 0, 4);
        RT_LOADW(1, 7); RT_MMA(2, 1, 5);
        RT_LOADW(2, 8); RT_MMA(0, 2, 6);
        RT_LOADW(0, 9); RT_MMA(1, 3, 7);
        RT_LOADW(1, 10); RT_MMA(2, 0, 8);
        RT_LOADW(2, 11); RT_MMA(0, 1, 9);
        RT_LOADW(0, 12); RT_MMA(1, 2, 10);
        RT_LOADW(1, 13); RT_MMA(2, 3, 11);
        RT_LOADW(2, 14); RT_MMA(0, 0, 12);
        RT_LOADW(0, 15); RT_MMA(1, 1, 13);
        RT_MMA(2, 2, 14);
        RT_MMA(0, 3, 15);
#undef RT_LOADX
#undef RT_LOADW
#undef RT_MMA
        ss += __shfl_xor(ss, 16); ss += __shfl_xor(ss, 32);
        __syncthreads();
        if (kh == 1) {
#pragma unroll
            for (int nt = 0; nt < 5; ++nt)
#pragma unroll
                for (int r = 0; r < 4; ++r) xch[(nt * 4 + r) * 64 + lane] = acc[nt][r];
            xch[20 * 64 + lane] = ss;
        }
        __syncthreads();
        float ss_other;
        if (kh == 0) {
#pragma unroll
            for (int nt = 0; nt < 5; ++nt)
#pragma unroll
                for (int r = 0; r < 4; ++r) acc[nt][r] += xch[(nt * 4 + r) * 64 + lane];
            ss_other = xch[20 * 64 + lane];
        }
        __syncthreads();
        if (kh == 0) xch[20 * 64 + lane] = ss;
        __syncthreads();
        if (kh == 1) ss_other = xch[20 * 64 + lane];
        ss += ss_other;
        const float rs = rsqrtf(ss / (float)D_ + 1e-6f);
#pragma unroll 4
        for (int c = 0; c < 16; ++c) {
            const float* gp = p.ffn_norm + l * D_ + kh * 512 + c * 32 + 8 * kq;
            const f32x4 g0 = *(const f32x4*)gp, g1 = *(const f32x4*)(gp + 4);
            const u32x4 xs = *(const u32x4*)(xsv + c * 1024 + lane * 16);
            u32x4 ov;
            ov.x = cvtpk(__uint_as_float(xs.x << 16) * rs * g0[0], __uint_as_float(xs.x & 0xffff0000u) * rs * g0[1]);
            ov.y = cvtpk(__uint_as_float(xs.y << 16) * rs * g0[2], __uint_as_float(xs.y & 0xffff0000u) * rs * g0[3]);
            ov.z = cvtpk(__uint_as_float(xs.z << 16) * rs * g1[0], __uint_as_float(xs.z & 0xffff0000u) * rs * g1[1]);
            ov.w = cvtpk(__uint_as_float(xs.w << 16) * rs * g1[2], __uint_as_float(xs.w & 0xffff0000u) * rs * g1[3]);
            *(u32x4*)(p.hn() + (long)(t0 + ti) * D_ + kh * 512 + c * 32 + 8 * kq) = ov;
        }
        if (kh == 0) {
#pragma unroll
        for (int reg = 0; reg < 4; ++reg) {
            const int tok = 4 * kq + reg;
            const float rst = __shfl(rs, tok);
#pragma unroll
            for (int nt = 0; nt < 5; ++nt) lgw[tok * 81 + nt * 16 + ti] = acc[nt][reg] * rst;
        }
        __builtin_amdgcn_s_waitcnt(0xc07f);
        if (lane < 16) {
            const float* lg = lgw + lane * 81;
            float g[8]; float mx = -1e30f; int gi = 0;
#pragma unroll
            for (int i = 0; i < 8; ++i) { g[i] = lg[i] + p.moe_b_group[l * 8 + i]; if (g[i] > mx) { mx = g[i]; gi = i; } }
            float den = 0.f;
#pragma unroll
            for (int i = 0; i < 8; ++i) den += expf(g[i] - mx);
            const float pg = 1.f / den;
            float v0 = -1e30f, v1 = -1e30f; int i0 = 0, i1 = 0;
            for (int i = 0; i < 8; ++i) { const float e = lg[8 + gi * 8 + i] + p.moe_b_expert[l * 64 + gi * 8 + i]; if (e > v0) { v1 = v0; i1 = i0; v0 = e; i0 = i; } else if (e > v1) { v1 = e; i1 = i; } }
            const float x = expf(v1 - v0);
            const float w0 = pg / (1.f + x), w1 = pg * x / (1.f + x);
            const int t = t0 + lane;
            const int e0 = gi * 8 + i0, e1 = gi * 8 + i1;
            unsigned* cnt = p.ecnt() + l * 64;
            const unsigned p0 = atomicAdd(&cnt[e0], 1u);
            p.elist()[(long)e0 * T_ + p0] = t * 2;
            const unsigned p1 = atomicAdd(&cnt[e1], 1u);
            p.elist()[(long)e1 * T_ + p1] = t * 2 + 1;
            p.slotw()[t * 2] = w0; p.slotw()[t * 2 + 1] = w1;
        }
        __builtin_amdgcn_s_waitcnt(0xc07f);
        }
    }
}
__device__ __forceinline__ int moe_tiles(const Params& p, int l, int* tstart  ) {
    __syncthreads();
    if (otid() == 0) {
        int acc = 0;
        for (int e = 0; e < 64; ++e) { tstart[e] = acc; acc += (int)((p.ecnt()[l * 64 + e] + 127u) >> 7); }
        tstart[64] = acc;
    }
    __syncthreads();
    return tstart[64];
}
__device__ __forceinline__ int moe_find(const int* tstart, int ti) { int e = 0; for (int i = 0; i < 64; ++i) if (tstart[i + 1] <= ti) e = i + 1; return e; }
__device__ __forceinline__ void phase_moe_up(const Params& p, int l, int bid, int nblk, char* lds) {
    const int tid = otid(), lane = tid & 63, w = tid >> 6, r32 = lane & 31, hi = lane >> 5;
    const int wm = w & 1, wn = w >> 1;
    int* tstart = (int*)(lds + LDS_AUX + 512);
    const int ntl = moe_tiles(p, l, tstart);
    const int srow_ = 8 * w + (lane >> 3);
    auto fetch = [&](int unit, int& e, int& rt, int& cnt, int (&as)[4]) {
        const int ti = unit >> 2;
        e = moe_find(tstart, ti); rt = ti - tstart[e];
        cnt = (int)p.ecnt()[l * 64 + e];
        const int* lst = p.elist() + (long)e * T_;
#pragma unroll
        for (int i = 0; i < 4; ++i) { int rr = rt * 128 + 32 * i + srow_; if (rr >= cnt) rr = 0; as[i] = lst[rr]; }
    };
    int e = 0, rt = 0, cnt = 0, aslot[4] = {0, 0, 0, 0};
    if (bid < ntl * 4) fetch(bid, e, rt, cnt, aslot);
    for (int unit = bid; unit < ntl * 4; unit += nblk) {
        const int nt = unit & 3, ti = unit >> 2;
        int e2 = 0, rt2 = 0, cnt2 = 0, aslot2[4] = {0, 0, 0, 0};
        if (unit + nblk < ntl * 4) fetch(unit + nblk, e2, rt2, cnt2, aslot2);
        f32x16 acc[2][2];
#pragma unroll
        for (int a = 0; a < 2; ++a)
#pragma unroll
            for (int b2 = 0; b2 < 2; ++b2)
#pragma unroll
                for (int r = 0; r < 16; ++r) acc[a][b2][r] = 0.f;
        const float* wgate = p.moe_w_gate + ((long)l * 64 + e) * 1024 * 256;
        const float* wup = p.moe_w_up + ((long)l * 64 + e) * 1024 * 256;
        gemm_glds<BMODE_F32_KN>(acc,
            [&](int r) { const int i = r >> 5; const int sl_ = i == 0 ? aslot[0] : i == 1 ? aslot[1] : i == 2 ? aslot[2] : aslot[3]; return p.hn() + (long)(sl_ >> 1) * D_; },
            [&](int nb, int& ld) { ld = 256; const int col = nt * 64 + (nb >> 6) * 32 + (nb & 31); return ((nb & 32) ? wup : wgate) + col; },
            1024, lds);
#pragma unroll
        for (int mi = 0; mi < 2; ++mi) {
            bf16_t* dst = p.hid() + ((long)ti * 128 + wm * 64 + mi * 32 + r32) * 256 + nt * 64 + wn * 32 + 4 * hi;
#pragma unroll
            for (int rg = 0; rg < 4; ++rg) {
                float v[4];
#pragma unroll
                for (int j = 0; j < 4; ++j) { const float g = acc[0][mi][rg * 4 + j], uu = acc[1][mi][rg * 4 + j]; v[j] = g / (1.f + __expf(-g)) * uu; }
                st4(dst + 8 * rg, v[0], v[1], v[2], v[3]);
            }
        }
        e = e2; rt = rt2; cnt = cnt2;
#pragma unroll
        for (int i = 0; i < 4; ++i) aslot[i] = aslot2[i];
    }
}
__device__ __forceinline__ void phase_moe_down(const Params& p, int l, int bid, int nblk, char* lds) {
    const int tid = otid(), lane = tid & 63, w = tid >> 6, r32 = lane & 31, hi = lane >> 5;
    const int wm = w & 1, wn = w >> 1;
    int* tstart = (int*)(lds + LDS_AUX + 512);
    const int ntl = moe_tiles(p, l, tstart);
    for (int unit = bid; unit < ntl * 8; unit += nblk) {
        const int nt = unit & 7, ti = unit >> 3;
        const int e = moe_find(tstart, ti); const int rt = ti - tstart[e];
        const int cnt = (int)p.ecnt()[l * 64 + e];
        const int* lst = p.elist() + (long)e * T_;
        f32x16 acc[2][2];
#pragma unroll
        for (int a = 0; a < 2; ++a)
#pragma unroll
            for (int b2 = 0; b2 < 2; ++b2)
#pragma unroll
                for (int r = 0; r < 16; ++r) acc[a][b2][r] = 0.f;
        const bf16_t* A = p.hid() + (long)ti * 128 * 256;
        const float* wd = p.moe_w_down + ((long)l * 64 + e) * 256 * 1024 + nt * 128;
        int eslot[2]; float ewgt[2];
#pragma unroll
        for (int mi = 0; mi < 2; ++mi) {
            const int rr = rt * 128 + wm * 64 + mi * 32 + r32;
            eslot[mi] = (rr < cnt) ? lst[rr] : 0; ewgt[mi] = p.slotw()[eslot[mi]];
        }
        gemm_glds<BMODE_F32_KN>(acc, [&](int r) { return A + (long)r * 256; }, [&](int nb, int& ld) { ld = 1024; return wd + nb; }, 256, lds);
#pragma unroll
        for (int mi = 0; mi < 2; ++mi) {
            const int rr = rt * 128 + wm * 64 + mi * 32 + r32;
            if (rr < cnt) {
                const int slot = eslot[mi]; const float wgt = ewgt[mi];
                bf16_t* dst = p.y() + (long)slot * D_ + nt * 128 + wn * 64 + 4 * hi;
#pragma unroll
                for (int ni = 0; ni < 2; ++ni)
#pragma unroll
                    for (int rg = 0; rg < 4; ++rg)
                        st4(dst + ni * 32 + 8 * rg, acc[ni][mi][rg * 4 + 0] * wgt, acc[ni][mi][rg * 4 + 1] * wgt, acc[ni][mi][rg * 4 + 2] * wgt, acc[ni][mi][rg * 4 + 3] * wgt);
            }
        }
    }
}
__device__ __forceinline__ void phase_combine(const Params& p, int lnext, int bid, int nblk) {
    const int tid = otid(), lane = tid & 63, w = tid >> 6;
    float* hb = p.h(); const bf16_t* yb = p.y(); bf16_t* hnb = p.hn();
    for (int row0 = (bid * 4 + w) * 2; row0 < T_; row0 += nblk * 8) {
        f32x4 v[2][4]; float ss[2] = {0.f, 0.f};
        u32x2 ya[2][4], yc[2][4];
#pragma unroll
        for (int r = 0; r < 2; ++r)
#pragma unroll
            for (int i = 0; i < 4; ++i) {
                const int c = i * 256 + lane * 4; const long row = row0 + r;
                v[r][i] = *(const f32x4*)(hb + row * D_ + c);
                ya[r][i] = *(const u32x2*)(yb + (row * 2) * D_ + c); yc[r][i] = *(const u32x2*)(yb + (row * 2 + 1) * D_ + c);
            }
#pragma unroll
        for (int r = 0; r < 2; ++r) {
#pragma unroll
            for (int i = 0; i < 4; ++i) {
                const u32x2 a = ya[r][i], b2 = yc[r][i];
                v[r][i][0] += __uint_as_float(a.x << 16) + __uint_as_float(b2.x << 16);
                v[r][i][1] += __uint_as_float(a.x & 0xffff0000u) + __uint_as_float(b2.x & 0xffff0000u);
                v[r][i][2] += __uint_as_float(a.y << 16) + __uint_as_float(b2.y << 16);
                v[r][i][3] += __uint_as_float(a.y & 0xffff0000u) + __uint_as_float(b2.y & 0xffff0000u);
                ss[r] += v[r][i][0] * v[r][i][0] + v[r][i][1] * v[r][i][1] + v[r][i][2] * v[r][i][2] + v[r][i][3] * v[r][i][3];
            }
            for (int o_ = 32; o_ > 0; o_ >>= 1) ss[r] += __shfl_xor(ss[r], o_);
        }
#pragma unroll
        for (int r = 0; r < 2; ++r) {
            const float rs = rsqrtf(ss[r] / (float)D_ + 1e-6f); const long row = row0 + r;
#pragma unroll
            for (int i = 0; i < 4; ++i) {
                const int c = i * 256 + lane * 4;
                if (lnext < 2) {
                    const f32x4 g = *(const f32x4*)(p.attn_norm + lnext * D_ + c);
                    *(f32x4*)(hb + row * D_ + c) = v[r][i];
                    st4(hnb + hn_panel_off(row, c), v[r][i][0] * rs * g[0], v[r][i][1] * rs * g[1], v[r][i][2] * rs * g[2], v[r][i][3] * rs * g[3]);
                } else {
                    const f32x4 g = *(const f32x4*)(p.final_norm + c);
                    f32x4 ov = {v[r][i][0] * rs * g[0], v[r][i][1] * rs * g[1], v[r][i][2] * rs * g[2], v[r][i][3] * rs * g[3]};
                    *(f32x4*)(p.out + row * D_ + c) = ov;
                }
            }
        }
    }
}

__device__ __forceinline__ const Params& opq(const Params& p) { return p; }
__device__ __forceinline__ int next_item(unsigned* ctr, int* slot) {
    __syncthreads();
    if (otid() == 0) *slot = (int)atomicAdd(ctr, 1u);
    __syncthreads();
    return *slot;
}
__device__ __forceinline__ void phase_x1(const Params& p, int l, char* lds, unsigned* ctr, int bid) {
    int* slot = (int*)(lds + LDS_AUX + 1000);
    const int b = bid & 7;
    constexpr int N_CP = 8, N_IDX = 76, N_WIN = 64, N_SWA = 64, N_KVC = 64, N_CS = 1;
    constexpr int E0 = N_CP, E1 = E0 + N_IDX, E2 = E1 + N_WIN, E3 = E2 + N_SWA, E4 = E3 + N_KVC, E5 = E4 + N_CS;
    for (;;) {
        const int it = next_item(ctr + b, slot);
        if (it >= E5) break;
        if (it < E0) phase_compress(p, l, 0, 1, lds, ((b * 4 + (it >> 1)) << 1) | (it & 1));
        else if (it < E1) {
            const int j = it - E0; int qt, pc, np;
            if (j < 32) { qt = 31 - (j >> 2); pc = j & 3; np = 4; }
            else if (j < 56) { qt = 23 - (j - 32) / 3; pc = (j - 32) % 3; np = 3; }
            else if (j < 72) { qt = 15 - ((j - 56) >> 1); pc = (j - 56) & 1; np = 2; }
            else { qt = 7 - (j - 72); pc = 0; np = 1; }
            idx_unit(p, b, qt, ((qt + 1) * pc) / np, ((qt + 1) * (pc + 1)) / np, lds);
        }
        else if (it < E2) unit_win(p, (b << 6) | (63 - (it - E1)), lds);
        else if (it < E3) unit_swa(p, l, (b << 6) | (it - E2), lds);
        else if (it < E4) phase_kvc(p, l, 0, 1, lds, b * 64 + (it - E3));
        else phase_cumsum(p, 0, 1, b);
    }
}
__device__ __forceinline__ void phase_x2(const Params& p, char* lds, unsigned* ctr, int bid) {
    int* slot = (int*)(lds + LDS_AUX + 1000);
    const int b = bid & 7;
    constexpr int N_FOX = 4 * 16, N_CMP = 64, N_DS = 64;
    for (;;) {
        const int it = next_item(ctr + b, slot);
        if (it >= N_FOX + N_CMP + N_DS) break;
        if (it < N_FOX) { const int qb = 15 - (it >> 2), h = it & 3; unit_fox(p, ((b * 4 + h) << 4) | qb, lds); }
        else if (it < N_FOX + N_DS) phase_dsel(p, 0, 1, lds, ((it - N_FOX) << 3) | b);
        else phase_cmp(p, 0, 1, lds, (b << 6) | (it - N_FOX - N_DS));
    }
}
__device__ __forceinline__ void phase_x3(const Params& p, char* lds, unsigned* ctr, int bid) {
    int* slot = (int*)(lds + LDS_AUX + 1000);
    const int b = bid & 7;
    for (;;) {
        const int it = next_item(ctr + b, slot);
        if (it >= 16 * 8) break;
        const int g = it >> 3, j = it & 7;
        if (j < 4) unit_dsa(p, ((b * 4 + j) << 4) | (15 - g), lds);
        else unit_sel(p, (b << 6) | (63 - (g * 4 + (j - 4))), lds);
    }
}
#if DIAG_K >= 0
#define TS(i) do { if (blockIdx.x == 0 && threadIdx.x == 0) tsv[i] = __builtin_amdgcn_s_memrealtime(); } while (0)
#else
#define TS(i) do {} while (0)
#endif
__global__ __launch_bounds__(256, 2) void k_mega(Params pk) {
    __shared__ __attribute__((aligned(16))) char lds[LDS_AUX + 6144];
    __shared__ uint4 xbw;
    __shared__ Params sp;
    if (threadIdx.x == 0) sp = pk;
    const Params& p = sp;
#if DIAG_K >= 0
    __shared__ unsigned long long tsv[32];
#endif
    cg::grid_group grid = cg::this_grid();
    const int bid = blockIdx.x, nblk = gridDim.x;
    if (threadIdx.x == 0) xbw = make_uint4(0u, 0u, 0u, 0u);
    __syncthreads();
    (void)xcd_barrier_post((unsigned*)(pk.ws + OFF_bar), (volatile LAS unsigned*)&xbw);
    auto rot = [&](int off) { return osgpr((bid + off) % nblk); };
    TS(0);
    phase_prep(opq(p), osgpr(bid), nblk, lds, 7);
    phase_norm(opq(p), 0, osgpr(bid), nblk);
    if (pk.ws == nullptr) grid.sync();
    xcd_barrier2(p.ws + OFF_bar, (volatile LAS unsigned*)&xbw);
    TS(1);
    if (bid >= nblk - 4) {
        const int o_ = (bid - (nblk - 4)) * 256 + (int)threadIdx.x;
        const float* pp = p.pebp() + (long)(o_ >> 8) * 32 * 256 + (o_ & 255);
        float a = 0.f;
#pragma unroll
        for (int kt = 0; kt < 32; ++kt) a += pp[kt * 256];
        p.peb()[o_] = a;
    }
    for (int l = 0; l < 2; ++l) {
        phase_inproj(opq(p), l, osgpr(bid), nblk, lds);
        xcd_barrier2(p.ws + OFF_bar, (volatile LAS unsigned*)&xbw);
        TS(2 + 10 * l);
        unsigned* ctrs = (unsigned*)(p.ws + OFF_bar) + 3600 + l * 32;
        phase_x1(p, l, lds, ctrs + 0, bid);
        xcd_barrier2(p.ws + OFF_bar, (volatile LAS unsigned*)&xbw);
        TS(3 + 10 * l);
        phase_x2(p, lds, ctrs + 8, bid);
        xcd_barrier2(p.ws + OFF_bar, (volatile LAS unsigned*)&xbw);
        TS(4 + 10 * l);
        phase_x3(p, lds, ctrs + 16, bid);
        xcd_barrier2(p.ws + OFF_bar, (volatile LAS unsigned*)&xbw);
        TS(5 + 10 * l);
        phase_merge(opq(p), l, osgpr(bid), nblk, lds);
        xcd_barrier2(p.ws + OFF_bar, (volatile LAS unsigned*)&xbw);
        TS(6 + 10 * l);
        phase_outproj(opq(p), l, osgpr(bid), nblk, lds);
        xcd_barrier2(p.ws + OFF_bar, (volatile LAS unsigned*)&xbw);
        TS(7 + 10 * l);
        phase_router(opq(p), l, osgpr(bid), nblk, lds);
        xcd_barrier2(p.ws + OFF_bar, (volatile LAS unsigned*)&xbw);
        TS(8 + 10 * l);
        phase_moe_up(opq(p), l, osgpr(bid), nblk, lds);
        xcd_barrier2(p.ws + OFF_bar, (volatile LAS unsigned*)&xbw);
        TS(9 + 10 * l);
        phase_moe_down(opq(p), l, osgpr(bid), nblk, lds);
#ifdef SHADOW_VAR
        if (l == 1) {
            xcd_barrier2(p.ws + OFF_bar, (volatile LAS unsigned*)&xbw);
            TS(21);
            phase_inproj<SHADOW_VAR>(opq(p), 1, osgpr(bid), nblk, lds);
            xcd_barrier2(p.ws + OFF_bar, (volatile LAS unsigned*)&xbw);
            TS(22);
        }
#endif
#if DIAG_K >= 0
        if (l == 1 && blockIdx.x == 0 && threadIdx.x == 0) {
            tsv[20] = __builtin_amdgcn_s_memrealtime();
            const float tot = (float)(tsv[20] - tsv[0]);
#ifdef SHADOW_VAR
            const float f = (float)(tsv[DIAG_K + 1] - tsv[DIAG_K]) / 100000.f;
#else
            const float f = (float)(tsv[DIAG_K + 1] - tsv[DIAG_K]) / tot;
#endif
            *(float*)(p.ws + OFF_bar + 3500 * 4) = f;
        }
#endif
        xcd_barrier2(p.ws + OFF_bar, (volatile LAS unsigned*)&xbw);
        TS(10 + 10 * l);
        phase_combine(opq(p), l + 1, osgpr(bid), nblk);
        if (l == 0) { xcd_barrier2(p.ws + OFF_bar, (volatile LAS unsigned*)&xbw); TS(11); }
    }
}

extern "C" void kernel_launch(void* const* d_in, const int* in_sizes, int n_in, void* d_out, int out_size, void* d_ws, size_t ws_size,
                              hipStream_t stream) {
    Params p{};
    p.x = (const float*)d_in[0]; p.positions = (const int*)d_in[1]; p.attn_norm = (const float*)d_in[2]; p.w_in = (const float*)d_in[3];
    p.nsa_pe_k = (const float*)d_in[4]; p.nsa_w1_k = (const float*)d_in[5]; p.nsa_w2_k = (const float*)d_in[6];
    p.nsa_pe_v = (const float*)d_in[7]; p.nsa_w1_v = (const float*)d_in[8]; p.nsa_w2_v = (const float*)d_in[9];
    p.fox_bias = (const float*)d_in[10]; p.dsa_kv_norm = (const float*)d_in[11]; p.dsa_w_ukv = (const float*)d_in[12]; p.swa_sinks = (const float*)d_in[13];
    p.w_branch = (const float*)d_in[14]; p.w_gate = (const float*)d_in[15]; p.w_out = (const float*)d_in[16]; p.ffn_norm = (const float*)d_in[17];
    p.moe_w_group = (const float*)d_in[18]; p.moe_b_group = (const float*)d_in[19]; p.moe_w_expert = (const float*)d_in[20]; p.moe_b_expert = (const float*)d_in[21];
    p.moe_w_gate = (const float*)d_in[22]; p.moe_w_up = (const float*)d_in[23]; p.moe_w_down = (const float*)d_in[24]; p.final_norm = (const float*)d_in[25];
    p.out = (float*)d_out;

    p.ws = (char*)d_ws;

    hipMemsetAsync(p.ws + OFF_bar, 0, XCD_BAR_WORDS * 4, stream);
    static int grid_blocks = 0;
    if (!grid_blocks) {
        int dev = 0, cus = 0, per_cu = 0;
        hipGetDevice(&dev);
        hipDeviceGetAttribute(&cus, hipDeviceAttributeMultiprocessorCount, dev);
        hipOccupancyMaxActiveBlocksPerMultiprocessor(&per_cu, k_mega, 256, 0);
        if (per_cu > 2) per_cu = 2;
        if (per_cu < 1) per_cu = 1;
        grid_blocks = cus * per_cu;
    }
    void* args[] = {(void*)&p};
    hipLaunchCooperativeKernel((void*)k_mega, dim3(grid_blocks), dim3(256), args, 0, stream);
}
```

```cpp
#include <hip/hip_runtime.h>
#ifndef DIAG_K
#define DIAG_K -1
#endif
#ifndef DIAG_PH
#define DIAG_PH 0
#endif
#include <hip/hip_cooperative_groups.h>
#include <stdint.h>
namespace cg = cooperative_groups;

typedef unsigned short bf16_t;
__device__ __forceinline__ float bf2f(bf16_t b) { return __uint_as_float((unsigned)b << 16); }
__device__ __forceinline__ float ldf(const float* p, long i) { return p[i]; }
__device__ __forceinline__ float ldf(const bf16_t* p, long i) { return bf2f(p[i]); }
__device__ __forceinline__ int vtpos(int t) { int x = t & 15; int sub = x >> 2; int ns = ((sub & 1) << 1) | (sub >> 1); return (t & ~15) | (ns << 2) | (x & 3); }
#define LOG2E 1.4426950408889634f
__device__ __forceinline__ bf16_t f2bf_host_dev(float x) { unsigned u = __float_as_uint(x); u += 0x7fffu + ((u >> 16) & 1u); return (bf16_t)(u >> 16); }

#define B_ 8
#define S_ 2048
#define D_ 1024
#define T_ (B_ * S_)
#define DIN 2644
#define O_QA 0
#define O_KCMP 256
#define O_VCMP 320
#define O_KSEL 384
#define O_VSEL 448
#define O_KWIN 512
#define O_VWIN 576
#define O_GA 640
#define O_QB 652
#define O_KB 908
#define O_VB 1164
#define O_FB 1420
#define O_QC 1424
#define O_CKV 1680
#define O_QI 1808
#define O_KI 2064
#define O_WI 2128
#define O_QD 2132
#define O_KD 2388
#define O_VD 2516
#define NCMP 127

#define XB_TMO 128
#define XB_XCNT(j) (256 + 64 * (j))
#define XB_XSUB(j) (1280 + 64 * (j))
#define XB_XGEN(j) (2304 + 64 * (j))
#define XB_TOP 3328
#define XB_TOPGEN 3392
#define XCD_BAR_WORDS 3456
#define XB_SPIN_CAP (1u << 18)
#define LAS __attribute__((address_space(3)))
__device__ __forceinline__ unsigned xb_ld(unsigned* p) { return __hip_atomic_load(p, __ATOMIC_RELAXED, __HIP_MEMORY_SCOPE_AGENT); }
__device__ __forceinline__ unsigned xb_add(unsigned* p, unsigned v) { return __hip_atomic_fetch_add(p, v, __ATOMIC_RELAXED, __HIP_MEMORY_SCOPE_AGENT); }
__device__ __forceinline__ unsigned xb_xcc_id() { return (unsigned)__builtin_amdgcn_s_getreg((3 << 11) | 20) & 0xFu; }
#define XB_SPIN(cond, bar) do { unsigned _sp = 0; while (cond) { __builtin_amdgcn_s_sleep(1); \
    if ((++_sp & 255u) == 0u) { if (xb_ld(&(bar)[XB_TMO])) break; if (_sp > XB_SPIN_CAP) { atomicAdd(&(bar)[XB_TMO], 1u); break; } } } } while (0)
struct XcdBarrier { unsigned* bar; unsigned x; volatile LAS unsigned* st; };
__device__ __forceinline__ XcdBarrier xcd_barrier_post(unsigned* bar, volatile LAS unsigned* st) {
    XcdBarrier b; b.bar = bar; b.x = xb_xcc_id(); b.st = st;
    if (threadIdx.x == 0) (void)xb_add(&bar[XB_XCNT(b.x)], 1u);
    return b;
}
__device__ __forceinline__ void xb_st(unsigned* p, unsigned v) { __hip_atomic_store(p, v, __ATOMIC_RELAXED, __HIP_MEMORY_SCOPE_AGENT); }
__device__ __forceinline__ void xcd_barrier_complete(unsigned* bar, unsigned x, unsigned& nloc, unsigned& nx, unsigned& mask) {
    const unsigned G = gridDim.x * gridDim.y * gridDim.z;
    unsigned sum, cnt, mine, mk, sp = 0u;
    for (;;) {
        sum = 0u; cnt = 0u; mine = 0u; mk = 0u;
#pragma unroll
        for (unsigned j = 0; j < 16; ++j) { const unsigned c = xb_ld(&bar[XB_XCNT(j)]); sum += c; cnt += (c > 0u) ? 1u : 0u; mk |= (c > 0u) ? (1u << j) : 0u; mine = (j == x) ? c : mine; }
        if (sum == G) break;
        __builtin_amdgcn_s_sleep(1);
        if ((++sp & 255u) == 0u) { if (xb_ld(&bar[XB_TMO])) break; if (sp > XB_SPIN_CAP) { atomicAdd(&bar[XB_TMO], 1u); break; } }
    }
    nloc = mine > 0u ? mine : 1u; nx = cnt > 0u ? cnt : 1u; mask = mk;
}
__device__ __forceinline__ void xcd_barrier_impl(const XcdBarrier& b) {
    asm volatile("s_waitcnt vmcnt(0)" ::: "memory");
    __syncthreads();
    if (threadIdx.x == 0) {
        unsigned* bar = b.bar;
        __builtin_amdgcn_s_waitcnt(0);
        unsigned nloc = b.st[0], nx = b.st[1], mask = b.st[2];
        if (nloc == 0u) { xcd_barrier_complete(bar, b.x, nloc, nx, mask); b.st[0] = nloc; b.st[1] = nx; b.st[2] = mask; }
        asm volatile("buffer_inv sc1" ::: "memory");
        const unsigned old = xb_add(&bar[XB_XSUB(b.x)], 1u);
        const unsigned gen = old / nloc;
        if (old + 1u == (gen + 1u) * nloc) {
            __builtin_amdgcn_fence(__ATOMIC_RELEASE, "agent");
            asm volatile("s_waitcnt vmcnt(0)" ::: "memory");
            xb_st(&bar[XB_XGEN(b.x)], gen + 1u);
        }
        unsigned sp = 0u;
        for (;;) {
            unsigned ok = 1u;
#pragma unroll
            for (unsigned j = 0; j < 16; ++j) if ((mask >> j) & 1u) { const unsigned v = xb_ld(&bar[XB_XGEN(j)]); ok &= ((int)(v - (gen + 1u)) >= 0) ? 1u : 0u; }
            if (ok) break;
            __builtin_amdgcn_s_sleep(1);
            if ((++sp & 255u) == 0u) { if (xb_ld(&bar[XB_TMO])) break; if (sp > XB_SPIN_CAP) { atomicAdd(&bar[XB_TMO], 1u); break; } }
        }
        asm volatile("s_waitcnt vmcnt(0)" ::: "memory");
    }
    __syncthreads();
}

__device__ __forceinline__ void xcd_barrier2(char* ws, volatile LAS unsigned* st) {
    XcdBarrier b; b.bar = (unsigned*)ws; b.x = xb_xcc_id(); b.st = st;
    xcd_barrier_impl(b);
}
__device__ __forceinline__ int otid() { int t = threadIdx.x; asm volatile("" : "+v"(t)); return t; }
__device__ __forceinline__ int osgpr(int v) { asm volatile("" : "+s"(v)); return v; }
typedef short bf16x8 __attribute__((ext_vector_type(8)));
typedef float f32x16 __attribute__((ext_vector_type(16)));
typedef float f32x4 __attribute__((ext_vector_type(4)));
typedef unsigned u32x4 __attribute__((ext_vector_type(4)));
typedef unsigned u32x2 __attribute__((ext_vector_type(2)));
#define MFMA32(a, b, c) __builtin_amdgcn_mfma_f32_32x32x16_bf16(a, b, c, 0, 0, 0)
__device__ __forceinline__ unsigned cvtpk(float lo, float hi) { unsigned r; asm("v_cvt_pk_bf16_f32 %0, %1, %2" : "=v"(r) : "v"(lo), "v"(hi)); return r; }
__device__ __forceinline__ unsigned cvtpk_t(float lo, float hi) { unsigned r; asm("s_nop 1\n\tv_cvt_pk_bf16_f32 %0, %1, %2" : "=v"(r) : "v"(lo), "v"(hi)); return r; }
__device__ __forceinline__ bf16_t f2bf(float x) { return (bf16_t)(cvtpk(x, x) & 0xffffu); }
__device__ __forceinline__ int crow(int r, int hi) { return (r & 3) + 8 * (r >> 2) + 4 * hi; }
__device__ __forceinline__ void st16_asm(void* ptr, u32x4 v) { asm volatile("global_store_dwordx4 %0, %1, off\n\ts_nop 1" :: "v"(ptr), "v"(v) : "memory"); }
__device__ __forceinline__ float sigmoidf_(float x) { return __builtin_amdgcn_rcpf(1.f + __expf(-x)); }

#define NG_IN 106
#define NCAT (NG_IN * 64)
#define QSCALE 0.18033688011112042f

constexpr size_t wsal(size_t x) { return (x + 255) & ~(size_t)255; }
constexpr size_t OFF_bar = 0;
constexpr size_t OFF_cs = OFF_bar + wsal(XCD_BAR_WORDS * 4 + 1024);
constexpr size_t OFF_sn = OFF_cs + wsal((size_t)T_ * 32 * 4);
constexpr size_t OFF_Wcat = OFF_sn + wsal((size_t)T_ * 32 * 4);
constexpr size_t OFF_Wukv = OFF_Wcat + wsal((size_t)2 * NCAT * 1024 * 2);
constexpr size_t OFF_W1t = OFF_Wukv + wsal((size_t)2 * 512 * 128 * 2);
constexpr size_t OFF_W2t = OFF_W1t + wsal((size_t)2 * 2 * 256 * 2048 * 2);
constexpr size_t OFF_peb = OFF_W2t + wsal((size_t)2 * 2 * 64 * 256 * 2);
constexpr size_t OFF_pebp = OFF_peb + wsal((size_t)2 * 2 * 256 * 4);
constexpr size_t OFF_Wbt = OFF_pebp + wsal((size_t)4 * 32 * 256 * 4);
constexpr size_t OFF_Wot = OFF_Wbt + wsal((size_t)2 * 1024 * 1024 * 2);
constexpr size_t OFF_Wrt = OFF_Wot + wsal((size_t)2 * 1024 * 1024 * 2);
constexpr size_t OFF_h = OFF_Wrt + wsal((size_t)2 * 80 * 1024 * 4);
constexpr size_t OFF_hn = OFF_h + wsal((size_t)T_ * D_ * 4);
constexpr size_t OFF_qa = OFF_hn + wsal((size_t)T_ * D_ * 2);
constexpr size_t OFF_kcmp = OFF_qa + wsal((size_t)T_ * 256 * 2);
constexpr size_t OFF_vcmp = OFF_kcmp + wsal((size_t)T_ * 64 * 2);
constexpr size_t OFF_ksel = OFF_vcmp + wsal((size_t)T_ * 64 * 2);
constexpr size_t OFF_vselT = OFF_ksel + wsal((size_t)T_ * 64 * 2);
constexpr size_t OFF_kwin = OFF_vselT + wsal((size_t)T_ * 64 * 2);
constexpr size_t OFF_vwinT = OFF_kwin + wsal((size_t)T_ * 64 * 2);
constexpr size_t OFF_qb = OFF_vwinT + wsal((size_t)T_ * 64 * 2);
constexpr size_t OFF_kb = OFF_qb + wsal((size_t)T_ * 256 * 2);
constexpr size_t OFF_vbT = OFF_kb + wsal((size_t)T_ * 256 * 2);
constexpr size_t OFF_qc = OFF_vbT + wsal((size_t)T_ * 256 * 2);
constexpr size_t OFF_ckv = OFF_qc + wsal((size_t)T_ * 256 * 2);
constexpr size_t OFF_qi = OFF_ckv + wsal((size_t)T_ * 128 * 2);
constexpr size_t OFF_ki = OFF_qi + wsal((size_t)T_ * 256 * 2);
constexpr size_t OFF_qd = OFF_ki + wsal((size_t)T_ * 64 * 2);
constexpr size_t OFF_kd = OFF_qd + wsal((size_t)T_ * 256 * 2);
constexpr size_t OFF_vdT = OFF_kd + wsal((size_t)T_ * 128 * 2);
constexpr size_t OFF_ga = OFF_vdT + wsal((size_t)T_ * 128 * 2);
constexpr size_t OFF_logf = OFF_ga + wsal((size_t)T_ * 12 * 4);
constexpr size_t OFF_wi = OFF_logf + wsal((size_t)T_ * 4 * 4);
constexpr size_t OFF_kcc = OFF_wi + wsal((size_t)T_ * 4 * 4);
constexpr size_t OFF_vcT = OFF_kcc + wsal((size_t)T_ * 256 * 2);
constexpr size_t OFF_gates = OFF_vcT + wsal((size_t)T_ * 256 * 2);
constexpr size_t OFF_o = OFF_gates + wsal((size_t)T_ * 4096 * 2);
constexpr size_t OFF_kbias = OFF_o + wsal((size_t)T_ * D_ * 2);
constexpr size_t OFF_ocmp = OFF_kbias + wsal((size_t)B_ * 4 * S_ * 4);
constexpr size_t OFF_owin = OFF_ocmp + wsal((size_t)T_ * 256 * 4);
constexpr size_t OFF_sc = OFF_owin + wsal((size_t)T_ * 256 * 4);
constexpr size_t OFF_kcb = OFF_sc + wsal((size_t)B_ * 2162688 * 4);
constexpr size_t OFF_vcbT = OFF_kcb + wsal((size_t)B_ * 128 * 64 * 2);
constexpr size_t OFF_dmask = OFF_vcbT + wsal((size_t)B_ * 64 * 128 * 2);
constexpr size_t OFF_selmask = OFF_dmask + wsal((size_t)T_ * 64 * 4);
constexpr size_t OFF_ecnt = OFF_selmask + wsal((size_t)T_ * 4);
constexpr size_t OFF_elist = OFF_ecnt + wsal(128 * 64 * 4);
constexpr size_t OFF_slotw = OFF_elist + wsal((size_t)64 * T_ * 4);
constexpr size_t WS_TOTAL = OFF_slotw + wsal((size_t)2 * T_ * 4);
constexpr size_t OFF_merged = OFF_qa;
constexpr size_t OFF_hid = OFF_qa + (size_t)T_ * D_ * 2;
constexpr size_t OFF_y = OFF_gates;
static_assert(OFF_hid + (size_t)328 * 128 * 256 * 2 <= OFF_ga, "hid must fit inside the dead z region");
static_assert(WS_TOTAL < (size_t)548 * 1000 * 1000, "workspace must stay below the guaranteed ws_size");
struct Params {
    const float* x; const int* positions; const float* attn_norm; const float* w_in;
    const float* nsa_pe_k; const float* nsa_w1_k; const float* nsa_w2_k; const float* nsa_pe_v; const float* nsa_w1_v; const float* nsa_w2_v;
    const float* fox_bias; const float* dsa_kv_norm; const float* dsa_w_ukv; const float* swa_sinks; const float* w_branch; const float* w_gate;
    const float* w_out; const float* ffn_norm; const float* moe_w_group; const float* moe_b_group; const float* moe_w_expert; const float* moe_b_expert;
    const float* moe_w_gate; const float* moe_w_up; const float* moe_w_down; const float* final_norm;
    float* out;
    char* ws;
    __device__ __forceinline__ unsigned* bar() const { return (unsigned*)(ws + OFF_bar); }
    __device__ __forceinline__ float* cs() const { return (float*)(ws + OFF_cs); }
    __device__ __forceinline__ float* sn() const { return (float*)(ws + OFF_sn); }
    __device__ __forceinline__ bf16_t* Wcat() const { return (bf16_t*)(ws + OFF_Wcat); }
    __device__ __forceinline__ bf16_t* Wukv() const { return (bf16_t*)(ws + OFF_Wukv); }
    __device__ __forceinline__ bf16_t* W1t() const { return (bf16_t*)(ws + OFF_W1t); }
    __device__ __forceinline__ bf16_t* W2t() const { return (bf16_t*)(ws + OFF_W2t); }
    __device__ __forceinline__ float* peb() const { return (float*)(ws + OFF_peb); }
    __device__ __forceinline__ float* pebp() const { return (float*)(ws + OFF_pebp); }
    __device__ __forceinline__ bf16_t* Wbt() const { return (bf16_t*)(ws + OFF_Wbt); }
    __device__ __forceinline__ bf16_t* Wot() const { return (bf16_t*)(ws + OFF_Wot); }
    __device__ __forceinline__ float* Wrt() const { return (float*)(ws + OFF_Wrt); }
    __device__ __forceinline__ float* h() const { return (float*)(ws + OFF_h); }
    __device__ __forceinline__ bf16_t* hn() const { return (bf16_t*)(ws + OFF_hn); }
    __device__ __forceinline__ bf16_t* qa() const { return (bf16_t*)(ws + OFF_qa); }
    __device__ __forceinline__ bf16_t* kcmp() const { return (bf16_t*)(ws + OFF_kcmp); }
    __device__ __forceinline__ bf16_t* vcmp() const { return (bf16_t*)(ws + OFF_vcmp); }
    __device__ __forceinline__ bf16_t* ksel() const { return (bf16_t*)(ws + OFF_ksel); }
    __device__ __forceinline__ bf16_t* vselT() const { return (bf16_t*)(ws + OFF_vselT); }
    __device__ __forceinline__ bf16_t* kwin() const { return (bf16_t*)(ws + OFF_kwin); }
    __device__ __forceinline__ bf16_t* vwinT() const { return (bf16_t*)(ws + OFF_vwinT); }
    __device__ __forceinline__ bf16_t* qb() const { return (bf16_t*)(ws + OFF_qb); }
    __device__ __forceinline__ bf16_t* kb() const { return (bf16_t*)(ws + OFF_kb); }
    __device__ __forceinline__ bf16_t* vbT() const { return (bf16_t*)(ws + OFF_vbT); }
    __device__ __forceinline__ bf16_t* qc() const { return (bf16_t*)(ws + OFF_qc); }
    __device__ __forceinline__ bf16_t* ckv() const { return (bf16_t*)(ws + OFF_ckv); }
    __device__ __forceinline__ bf16_t* qi() const { return (bf16_t*)(ws + OFF_qi); }
    __device__ __forceinline__ bf16_t* ki() const { return (bf16_t*)(ws + OFF_ki); }
    __device__ __forceinline__ bf16_t* qd() const { return (bf16_t*)(ws + OFF_qd); }
    __device__ __forceinline__ bf16_t* kd() const { return (bf16_t*)(ws + OFF_kd); }
    __device__ __forceinline__ bf16_t* vdT() const { return (bf16_t*)(ws + OFF_vdT); }
    __device__ __forceinline__ float* ga() const { return (float*)(ws + OFF_ga); }
    __device__ __forceinline__ float* logf() const { return (float*)(ws + OFF_logf); }
    __device__ __forceinline__ float* wi() const { return (float*)(ws + OFF_wi); }
    __device__ __forceinline__ bf16_t* kcc() const { return (bf16_t*)(ws + OFF_kcc); }
    __device__ __forceinline__ bf16_t* vcT() const { return (bf16_t*)(ws + OFF_vcT); }
    __device__ __forceinline__ bf16_t* gates() const { return (bf16_t*)(ws + OFF_gates); }
    __device__ __forceinline__ bf16_t* o() const { return (bf16_t*)(ws + OFF_o); }
    __device__ __forceinline__ float* kbias() const { return (float*)(ws + OFF_kbias); }
    __device__ __forceinline__ float* ocmp() const { return (float*)(ws + OFF_ocmp); }
    __device__ __forceinline__ float* owin() const { return (float*)(ws + OFF_owin); }
    __device__ __forceinline__ float* sc() const { return (float*)(ws + OFF_sc); }
    __device__ __forceinline__ bf16_t* kcb() const { return (bf16_t*)(ws + OFF_kcb); }
    __device__ __forceinline__ bf16_t* vcbT() const { return (bf16_t*)(ws + OFF_vcbT); }
    __device__ __forceinline__ unsigned* dmask() const { return (unsigned*)(ws + OFF_dmask); }
    __device__ __forceinline__ unsigned* selmask() const { return (unsigned*)(ws + OFF_selmask); }
    __device__ __forceinline__ unsigned* ecnt() const { return (unsigned*)(ws + OFF_ecnt); }
    __device__ __forceinline__ int* elist() const { return (int*)(ws + OFF_elist); }
    __device__ __forceinline__ float* slotw() const { return (float*)(ws + OFF_slotw); }
    __device__ __forceinline__ bf16_t* merged() const { return (bf16_t*)(ws + OFF_merged); }
    __device__ __forceinline__ bf16_t* hid() const { return (bf16_t*)(ws + OFF_hid); }
    __device__ __forceinline__ bf16_t* y() const { return (bf16_t*)(ws + OFF_y); }
};

#define TSTR 144
enum { BMODE_BF16_NK = 0, BMODE_F32_KN = 1 };

struct NoHook { __device__ __forceinline__ void operator()(int) const {} };
template <int BM, int BN, int BMODE, class AROW, class BSRC, class HOOK = NoHook>
__device__ __forceinline__ void gemm_core(f32x16 (&acc)[2][2], AROW arow, BSRC bsrc, int K, char* lds, HOOK hook = HOOK()) {
    constexpr int WM = BM / 64;
    constexpr int NA = BM / 32, NB = BN / 32;
    const int tid = otid(), lane = tid & 63, w = tid >> 6, r32 = lane & 31, hi = lane >> 5;
    const int wm = w % WM, wn = w / WM;
    char* ldsA = lds; char* ldsB = lds + BM * TSTR;
    const bf16_t* ap[NA];
#pragma unroll
    for (int i = 0; i < NA; ++i) ap[i] = arow((tid >> 3) + 32 * i) + (tid & 7) * 8;
    const bf16_t* bp[NB];
    if constexpr (BMODE == BMODE_BF16_NK) {
#pragma unroll
        for (int i = 0; i < NB; ++i) bp[i] = (const bf16_t*)bsrc((tid >> 3) + 32 * i) + (tid & 7) * 8;
    }
    u32x4 ra[NA]; u32x4 rb[NB]; f32x4 rf[8];
    const int kg = tid >> 5, ng = tid & 31;
    const float* bfp = nullptr; int bld = 0;
    if constexpr (BMODE == BMODE_F32_KN) { bfp = (const float*)bsrc(ng * 4, bld); }
    auto load_regs = [&](int k0) {
#pragma unroll
        for (int i = 0; i < NA; ++i) ra[i] = *(const u32x4*)(ap[i] + k0);
        if (BMODE == BMODE_BF16_NK) {
#pragma unroll
            for (int i = 0; i < NB; ++i) rb[i] = *(const u32x4*)(bp[i] + k0);
        } else {
#pragma unroll
            for (int j = 0; j < 8; ++j) rf[j] = *(const f32x4*)(bfp + (long)(k0 + kg * 8 + j) * bld);
        }
    };
    auto store_lds = [&]() {
#pragma unroll
        for (int i = 0; i < NA; ++i) *(u32x4*)(ldsA + ((tid >> 3) + 32 * i) * TSTR + (tid & 7) * 16) = ra[i];
        if (BMODE == BMODE_BF16_NK) {
#pragma unroll
            for (int i = 0; i < NB; ++i) *(u32x4*)(ldsB + ((tid >> 3) + 32 * i) * TSTR + (tid & 7) * 16) = rb[i];
        } else {
#pragma unroll
            for (int i = 0; i < 4; ++i) {
                u32x4 v;
                v.x = cvtpk(rf[0][i], rf[1][i]); v.y = cvtpk(rf[2][i], rf[3][i]); v.z = cvtpk(rf[4][i], rf[5][i]); v.w = cvtpk(rf[6][i], rf[7][i]);
                *(u32x4*)(ldsB + (ng * 4 + i) * TSTR + kg * 16) = v;
            }
        }
    };
    const int nk = K / 64;
    load_regs(0);
    for (int kt = 0; kt < nk; ++kt) {
        __syncthreads();
        store_lds();
        __syncthreads();
        if (kt + 1 < nk) load_regs((kt + 1) * 64);
#pragma unroll
        for (int ks = 0; ks < 4; ++ks) {
            bf16x8 bf[2], af[2];
#pragma unroll
            for (int ni = 0; ni < 2; ++ni) bf[ni] = *(const bf16x8*)(ldsB + (wn * 64 + ni * 32 + r32) * TSTR + ks * 32 + hi * 16);
#pragma unroll
            for (int mi = 0; mi < 2; ++mi) af[mi] = *(const bf16x8*)(ldsA + (wm * 64 + mi * 32 + r32) * TSTR + ks * 32 + hi * 16);
#pragma unroll
            for (int ni = 0; ni < 2; ++ni)
#pragma unroll
                for (int mi = 0; mi < 2; ++mi) acc[ni][mi] = MFMA32(bf[ni], af[mi], acc[ni][mi]);
        }
        hook(kt);
    }
}

__device__ __forceinline__ void glds16(const void* g, unsigned lds_addr) {
    unsigned sv;
    asm volatile("s_mov_b32 %0, m0\n\ts_mov_b32 m0, %2\n\ts_nop 0\n\tglobal_load_lds_dwordx4 %1, off\n\ts_mov_b32 m0, %0" : "=&s"(sv) : "v"(g), "s"(lds_addr) : "memory");
}
__device__ __forceinline__ void glds4(const void* g, unsigned lds_addr) {
    unsigned sv;
    asm volatile("s_mov_b32 %0, m0\n\ts_mov_b32 m0, %2\n\ts_nop 0\n\tglobal_load_lds_dword %1, off\n\ts_mov_b32 m0, %0" : "=&s"(sv) : "v"(g), "s"(lds_addr) : "memory");
}
template <typename T> __device__ __forceinline__ T* uni_ptr(T* q) {
    const unsigned long long v = (unsigned long long)q;
    const unsigned lo = (unsigned)__builtin_amdgcn_readfirstlane((int)(unsigned)v), hi_ = (unsigned)__builtin_amdgcn_readfirstlane((int)(unsigned)(v >> 32));
    return (T*)(((unsigned long long)hi_ << 32) | lo);
}
__device__ __forceinline__ void glds16_so(const void* sbase, unsigned voff, unsigned lds_addr) {
    unsigned sv;
    asm volatile("s_mov_b32 %0, m0\n\ts_mov_b32 m0, %3\n\ts_nop 0\n\tglobal_load_lds_dwordx4 %1, %2\n\ts_mov_b32 m0, %0" : "=&s"(sv) : "v"(voff), "s"(sbase), "s"(lds_addr) : "memory");
}
__device__ __forceinline__ void glds16_so_x4(const void* sbase, unsigned voff, unsigned lds_addr) {
    unsigned sv;
    asm volatile("s_mov_b32 %0, m0\n\ts_mov_b32 m0, %3\n\ts_nop 0\n\tglobal_load_lds_dwordx4 %1, %2\n\tglobal_load_lds_dwordx4 %1, %2 offset:1024\n\tglobal_load_lds_dwordx4 %1, %2 offset:2048\n\tglobal_load_lds_dwordx4 %1, %2 offset:3072\n\ts_mov_b32 m0, %0"
                 : "=&s"(sv) : "v"(voff), "s"(sbase), "s"(lds_addr) : "memory");
}
__device__ __forceinline__ void glds16_so_x2(const void* sbase, unsigned voff, unsigned lds_addr) {
    unsigned sv;
    asm volatile("s_mov_b32 %0, m0\n\ts_mov_b32 m0, %3\n\ts_nop 0\n\tglobal_load_lds_dwordx4 %1, %2\n\tglobal_load_lds_dwordx4 %1, %2 offset:1024\n\ts_mov_b32 m0, %0"
                 : "=&s"(sv) : "v"(voff), "s"(sbase), "s"(lds_addr) : "memory");
}
#define DMA_WAIT_BARRIER() asm volatile("s_waitcnt vmcnt(0) lgkmcnt(0)\n\ts_barrier" ::: "memory")
#define GBUF 32768
#define LDS_AUX 73728
template <int BMODE, int VAR = 0, class AROW, class BSRC, class HOOK = NoHook>
__device__ __forceinline__ void gemm_glds(f32x16 (&acc)[2][2], AROW arow, BSRC bsrc, int K, char* lds, HOOK hook = HOOK()) {
    const int tid = otid(), lane = tid & 63, w = tid >> 6, r32 = lane & 31, hi = lane >> 5;
    const int wm = w & 1, wn = w >> 1;
    const int srow = 8 * w + (lane >> 3), sslot = lane & 7;
    const bf16_t* ap[4];
#pragma unroll
    for (int i = 0; i < 4; ++i) { const int r = 32 * i + srow; ap[i] = arow(r) + ((sslot ^ ((r >> 1) & 7)) * 8); }
    const bf16_t* bp[4];
    if constexpr (BMODE == BMODE_BF16_NK) {
#pragma unroll
        for (int i = 0; i < 4; ++i) { const int r = 32 * i + srow; bp[i] = (const bf16_t*)bsrc(r) + ((sslot ^ ((r >> 1) & 7)) * 8); }
    }
    f32x4 rf[8];
    const int kg = tid >> 5, ng = tid & 31;
    const float* bfp = nullptr; int bld = 0;
    if constexpr (BMODE == BMODE_F32_KN) { bfp = (const float*)bsrc(ng * 4, bld); }
    const unsigned lds0 = (unsigned)(uintptr_t)lds;
    auto issue = [&](int kt) {
        if (VAR & 4) return;
        const unsigned buf = lds0 + (kt & 1) * GBUF + 8 * w * 128;
#pragma unroll
        for (int i = 0; i < 4; ++i)
            glds16(ap[i] + kt * 64, (unsigned)__builtin_amdgcn_readfirstlane(buf + 32 * i * 128));
        if constexpr (BMODE == BMODE_BF16_NK) {
#pragma unroll
            for (int i = 0; i < 4; ++i)
                glds16(bp[i] + kt * 64, (unsigned)__builtin_amdgcn_readfirstlane(buf + 16384 + 32 * i * 128));
        } else {
#pragma unroll
            for (int j = 0; j < 8; ++j) rf[j] = *(const f32x4*)(bfp + (long)(kt * 64 + kg * 8 + j) * bld);
        }
    };
    auto store_b = [&](int kt) {
        char* bufB = lds + (kt & 1) * GBUF + 16384;
#pragma unroll
        for (int i = 0; i < 4; ++i) {
            u32x4 v;
            v.x = cvtpk(rf[0][i], rf[1][i]); v.y = cvtpk(rf[2][i], rf[3][i]); v.z = cvtpk(rf[4][i], rf[5][i]); v.w = cvtpk(rf[6][i], rf[7][i]);
            const int r = ng * 4 + i;
            *(u32x4*)(bufB + r * 128 + ((kg ^ ((r >> 1) & 7)) * 16)) = v;
        }
    };
    const int nk = K / 64;
    issue(0);
    if constexpr (BMODE == BMODE_F32_KN) store_b(0);
    const int akey = ((r32 >> 1) & 7);
    for (int kt = 0; kt < nk; ++kt) {
        DMA_WAIT_BARRIER();
        if (kt + 1 < nk) issue(kt + 1);
        const char* bufA = lds + (kt & 1) * GBUF; const char* bufB = bufA + 16384;
        if (!(VAR & 2)) {
            bf16x8 bf[2][2], af[2][2];
            {
                const int coff = ((hi ^ akey) * 16);
#pragma unroll
                for (int ni = 0; ni < 2; ++ni) bf[0][ni] = *(const bf16x8*)(bufB + (wn * 64 + ni * 32 + r32) * 128 + coff);
#pragma unroll
                for (int mi = 0; mi < 2; ++mi) af[0][mi] = *(const bf16x8*)(bufA + (wm * 64 + mi * 32 + r32) * 128 + coff);
            }
#pragma unroll
            for (int ks = 0; ks < 4; ++ks) {
                const int cur = ks & 1, nxt = cur ^ 1;
                if (ks < 3) {
                    const int coff = ((((ks + 1) * 2 + hi) ^ akey) * 16);
#pragma unroll
                    for (int ni = 0; ni < 2; ++ni) bf[nxt][ni] = *(const bf16x8*)(bufB + (wn * 64 + ni * 32 + r32) * 128 + coff);
#pragma unroll
                    for (int mi = 0; mi < 2; ++mi) af[nxt][mi] = *(const bf16x8*)(bufA + (wm * 64 + mi * 32 + r32) * 128 + coff);
                }
#pragma unroll
                for (int ni = 0; ni < 2; ++ni)
#pragma unroll
                    for (int mi = 0; mi < 2; ++mi) acc[ni][mi] = MFMA32(bf[cur][ni], af[cur][mi], acc[ni][mi]);
            }
        }
        hook(kt);
        if constexpr (BMODE == BMODE_F32_KN) { if (kt + 1 < nk) store_b(kt + 1); }
    }
    __syncthreads();
}

#define BSTG 24576
__device__ __forceinline__ void gemm_big_issue01(const bf16_t* Abase, int lda, const bf16_t* Bbase, int ldb, char* lds, long ksa = 32, long ksb = 32) {
    const int tid = otid(), lane = tid & 63, w = tid >> 6;
    const int lrow = lane >> 2, lch = ((lane & 3) ^ ((lane >> 4) & 3)) * 8;
    const unsigned lds0 = (unsigned)(uintptr_t)lds;
#pragma unroll
    for (int s_ = 0; s_ < 2; ++s_) {
        const unsigned base = lds0 + s_ * BSTG;
        const bf16_t* ab = uni_ptr(Abase + s_ * ksa); const bf16_t* bb = uni_ptr(Bbase + s_ * ksb);
        glds16_so_x4(ab, (unsigned)(((64 * w + lrow) * lda + lch) * 2), (unsigned)__builtin_amdgcn_readfirstlane(base + (64 * w) * 64));
        glds16_so_x2(bb, (unsigned)(((32 * w + lrow) * ldb + lch) * 2), (unsigned)__builtin_amdgcn_readfirstlane(base + 16384 + (32 * w) * 64));
    }
}
__device__ __forceinline__ void gemm_big(f32x16 (&acc)[2][2][2], const bf16_t* Abase, int lda, const bf16_t* Bbase, int ldb, int K, char* lds, long ksa = 32, long ksb = 32) {
    const int tid = otid(), lane = tid & 63, w = tid >> 6, r32 = lane & 31, hi = lane >> 5;
    const int wm = w & 1, wn = w >> 1;
    const int lrow = lane >> 2, lch = ((lane & 3) ^ ((lane >> 4) & 3)) * 8;
    const unsigned aoff0 = (unsigned)(((64 * w + lrow) * lda + lch) * 2), boff0 = (unsigned)(((32 * w + lrow) * ldb + lch) * 2);
    const unsigned lds0 = (unsigned)(uintptr_t)lds;
    const bf16_t* ab0 = uni_ptr(Abase); const bf16_t* bb0 = uni_ptr(Bbase);
    const unsigned la0 = (unsigned)__builtin_amdgcn_readfirstlane(lds0 + (64 * w) * 64), lb0 = (unsigned)__builtin_amdgcn_readfirstlane(lds0 + 16384 + (32 * w) * 64);
    auto issue = [&](int s_, int stg) {
        glds16_so_x4(ab0 + s_ * ksa, aoff0, la0 + stg * BSTG);
        glds16_so_x2(bb0 + s_ * ksb, boff0, lb0 + stg * BSTG);
    };
    const int n = K / 32;
    const int key = (r32 >> 2) & 3;
    const char* fa = lds + (wm * 128 + r32) * 64; const char* fb = lds + 16384 + (wn * 64 + r32) * 64;
    const int coff0 = ((hi ^ key) * 16), coff1 = (((2 + hi) ^ key) * 16);
    auto compute = [&](int stg) {
        const char* bufA = fa + stg * BSTG; const char* bufB = fb + stg * BSTG;
        bf16x8 bf[2][2], af[2][2][2];
#pragma unroll
        for (int ks = 0; ks < 2; ++ks) {
            const int coff = ks ? coff1 : coff0;
#pragma unroll
            for (int ni = 0; ni < 2; ++ni) bf[ks][ni] = *(const bf16x8*)(bufB + (ni * 32) * 64 + coff);
#pragma unroll
            for (int mh = 0; mh < 2; ++mh)
#pragma unroll
                for (int mi = 0; mi < 2; ++mi) af[ks][mh][mi] = *(const bf16x8*)(bufA + (mh * 64 + mi * 32) * 64 + coff);
        }
        __builtin_amdgcn_sched_barrier(0);
#pragma unroll
        for (int ks = 0; ks < 2; ++ks)
#pragma unroll
            for (int mh = 0; mh < 2; ++mh)
#pragma unroll
                for (int ni = 0; ni < 2; ++ni)
#pragma unroll
                    for (int mi = 0; mi < 2; ++mi) acc[mh][ni][mi] = MFMA32(bf[ks][ni], af[ks][mh][mi], acc[mh][ni][mi]);
        __builtin_amdgcn_sched_barrier(0);
    };
    asm volatile("s_waitcnt vmcnt(0) lgkmcnt(0)\n\ts_barrier" ::: "memory");
    if (2 < n) issue(2, 2);
    compute(0);
    int s_ = 1;
    for (; s_ + 3 < n; s_ += 3) {
        asm volatile("s_waitcnt vmcnt(6) lgkmcnt(0)\n\ts_barrier" ::: "memory");
        if (s_ + 2 < n) issue(s_ + 2, 0);
        compute(1);
        asm volatile("s_waitcnt vmcnt(6) lgkmcnt(0)\n\ts_barrier" ::: "memory");
        if (s_ + 3 < n) issue(s_ + 3, 1);
        compute(2);
        asm volatile("s_waitcnt vmcnt(6) lgkmcnt(0)\n\ts_barrier" ::: "memory");
        if (s_ + 4 < n) issue(s_ + 4, 2);
        compute(0);
    }
    for (; s_ < n; ++s_) {
        const int stg = s_ % 3;
        if (s_ + 1 < n) asm volatile("s_waitcnt vmcnt(6) lgkmcnt(0)\n\ts_barrier" ::: "memory");
        else asm volatile("s_waitcnt vmcnt(0) lgkmcnt(0)\n\ts_barrier" ::: "memory");
        if (s_ + 2 < n) issue(s_ + 2, (stg + 2) % 3);
        compute(stg);
    }
    __syncthreads();
}

#define MSTG 16384
template <class AROW, class BROW, class HOOK = NoHook>
__device__ __forceinline__ void gemm_mid(f32x16 (&acc)[2][2], const bf16_t* Abase, AROW arow, const bf16_t* Bbase, BROW brow, int K, char* lds, long ksa, long ksb, HOOK hook = HOOK()) {
    const int tid = otid(), lane = tid & 63, w = tid >> 6, r32 = lane & 31, hi = lane >> 5;
    const int wm = w & 1, wn = w >> 1;
    const int lrow = lane >> 2, lch = ((lane & 3) ^ ((lane >> 4) & 3)) * 8;
    unsigned aoff[2], boff[2];
#pragma unroll
    for (int i = 0; i < 2; ++i) { aoff[i] = (unsigned)((arow(32 * w + 16 * i + lrow) + lch) * 2); boff[i] = (unsigned)((brow(32 * w + 16 * i + lrow) + lch) * 2); }
    const unsigned lds0 = (unsigned)(uintptr_t)lds;
    auto issue = [&](int s_) {
        const unsigned base = lds0 + (s_ & 3) * MSTG + 32 * w * 64;
        const bf16_t* ab = uni_ptr(Abase + s_ * ksa); const bf16_t* bb = uni_ptr(Bbase + s_ * ksb);
        glds16_so_x2(ab, aoff[0], (unsigned)__builtin_amdgcn_readfirstlane(base));
        glds16_so_x2(bb, boff[0], (unsigned)__builtin_amdgcn_readfirstlane(base + 8192));
    };
    const int n = K / 32;
    const int key = (r32 >> 2) & 3;
#pragma unroll
    for (int i = 0; i < 3; ++i) if (i < n) issue(i);
    for (int s_ = 0; s_ < n; ++s_) {
        const int ahead = n - 1 - s_;
        if (s_ > 0 && ahead >= 2) asm volatile("s_waitcnt vmcnt(8) lgkmcnt(0)\n\ts_barrier" ::: "memory");
        else if (s_ > 0 && ahead == 1) asm volatile("s_waitcnt vmcnt(4) lgkmcnt(0)\n\ts_barrier" ::: "memory");
        else asm volatile("s_waitcnt vmcnt(0) lgkmcnt(0)\n\ts_barrier" ::: "memory");
        if (s_ + 3 < n) issue(s_ + 3);
        const char* bufA = lds + (s_ & 3) * MSTG; const char* bufB = bufA + 8192;
        bf16x8 bf[2][2], af[2][2];
#pragma unroll
        for (int ks = 0; ks < 2; ++ks) {
            const int coff = (((ks * 2 + hi) ^ key) * 16);
#pragma unroll
            for (int ni = 0; ni < 2; ++ni) bf[ks][ni] = *(const bf16x8*)(bufB + (wn * 64 + ni * 32 + r32) * 64 + coff);
#pragma unroll
            for (int mi = 0; mi < 2; ++mi) af[ks][mi] = *(const bf16x8*)(bufA + (wm * 64 + mi * 32 + r32) * 64 + coff);
        }
        __builtin_amdgcn_sched_barrier(0);
#pragma unroll
        for (int ks = 0; ks < 2; ++ks)
#pragma unroll
            for (int ni = 0; ni < 2; ++ni)
#pragma unroll
                for (int mi = 0; mi < 2; ++mi) acc[ni][mi] = MFMA32(bf[ks][ni], af[ks][mi], acc[ni][mi]);
        __builtin_amdgcn_sched_barrier(0);
        hook(s_);
    }
    __syncthreads();
}

__device__ __forceinline__ void tconv_tile(const float* __restrict__ src, int lds_, bf16_t* __restrict__ dst, int ldd, const float* kscale, bool zero, char* lds) {
    float (*tile)[65] = (float (*)[65])lds;
    const int tid = otid();
    __syncthreads();
#pragma unroll
    for (int i = 0; i < 16; ++i) {
        int kk = i * 4 + (tid >> 6), nn = tid & 63;
        float v = zero ? 0.f : src[(long)kk * lds_ + nn];
        if (kscale) v *= kscale[kk];
        tile[kk][nn] = v;
    }
    __syncthreads();
#pragma unroll
    for (int i = 0; i < 2; ++i) {
        int c = tid + 256 * i; int nn = c >> 3, kc = (c & 7) * 8;
        u32x4 v;
        v.x = cvtpk(tile[kc + 0][nn], tile[kc + 1][nn]); v.y = cvtpk(tile[kc + 2][nn], tile[kc + 3][nn]);
        v.z = cvtpk(tile[kc + 4][nn], tile[kc + 5][nn]); v.w = cvtpk(tile[kc + 6][nn], tile[kc + 7][nn]);
        *(u32x4*)(dst + (long)nn * ldd + kc) = v;
    }
}
__device__ __forceinline__ int in_group_src(int g) {
    if (g < 10) return g * 64;
    if (g < 22) return O_QB + (g - 10) * 64;
    if (g < 33) return O_QC + (g - 22) * 64;
    return O_QD + (g - 33) * 64;
}
__device__ __forceinline__ void phase_prep(const Params& p, int bid, int nblk, char* lds, int part) {
    const int tid = otid();
    if (bid == 0 && tid < 128) { p.ecnt()[tid * 64] = 0u; p.ecnt()[tid * 64 + 32] = 0u; }
    if (bid == 0 && tid < 96) ((unsigned*)(p.ws + OFF_bar))[3600 + tid] = (unsigned)(nblk >> 3);
    if (part & 1) for (int idx0 = bid * 256 + tid; idx0 < T_ * 32; idx0 += 4 * nblk * 256)
#pragma unroll
    for (int u_ = 0; u_ < 4; ++u_) {
        const int idx = idx0 + u_ * nblk * 256;
        if (idx >= T_ * 32) continue;
        int i = idx & 31, t = idx >> 5;
        float inv = powf(10000.f, -(float)i / 32.f);
        float ang = (float)p.positions[t] * inv;
        double a = (double)ang; double n = rint(a * 0.15915494309189535); float rf = (float)(a - n * 6.283185307179586);
        p.cs()[idx] = cosf(rf); p.sn()[idx] = sinf(rf);
    }
    const int J_CAT = 2 * NG_IN * 16;
    const int J_UKV = 2 * 8 * 2;
    const int J_W1 = 2 * 2 * 4 * 32;
    const int J_W2 = 2 * 2 * 1 * 4;
    const int J_WB = 2 * 4 * 16 * 4;
    const int J_WO = 2 * 16 * 16;
    const int total = J_CAT + J_UKV + J_W1 + J_W2 + J_WB + J_WO;
    auto desc = [&](int q, const float*& sp, int& ld, const float*& ks, bf16_t*& dst, int& ldd, const float*& pe, float*& pp) {
        const int nn = tid & 63;
        ks = nullptr; pe = nullptr; pp = nullptr;
        if (q < J_CAT) {
            const int kt = q & 15, g = (q >> 4) % NG_IN, l = (q >> 4) / NG_IN;
            dst = p.Wcat() + (long)l * NCAT * 1024 + ((long)(kt * 2) * NCAT + g * 64) * 32; ldd = -NCAT; ld = DIN;
            const float* base = p.w_in + (long)l * D_ * DIN + (long)kt * 64 * DIN;
            if (g < 41) sp = base + in_group_src(g) + nn;
            else if (g == 41) sp = nn < 12 ? base + O_GA + nn : nn < 16 ? base + O_FB + nn - 12 : nn < 20 ? base + O_WI + nn - 16 : nullptr;
            else { const int gg = g - 42, i = gg >> 4, nt = gg & 15; sp = p.w_gate + ((long)(l * 4 + i) * D_ + kt * 64) * D_ + nt * 64 + nn; ld = D_; }
            return;
        }
        q -= J_CAT;
        if (q < J_UKV) {
            const int kt = q & 1, nt = (q >> 1) & 7, l = q >> 4;
            sp = p.dsa_w_ukv + (long)l * 128 * 512 + (long)kt * 64 * 512 + nt * 64 + nn; ld = 512;
            dst = p.Wukv() + ((long)l * 512 + nt * 64) * 128 + kt * 64; ldd = 128; ks = p.dsa_kv_norm + l * 128 + kt * 64;
            return;
        }
        q -= J_UKV;
        if (q < J_W1) {
            const int kt = q & 31, nt = (q >> 5) & 3, kv = (q >> 7) & 1, l = q >> 8;
            sp = (kv ? p.nsa_w1_v : p.nsa_w1_k) + (long)l * 2048 * 256 + (long)kt * 64 * 256 + nt * 64 + nn; ld = 256;
            dst = p.W1t() + ((long)(l * 2 + kv) * 256 + nt * 64) * 2048 + kt * 64; ldd = 2048;
            pe = (kv ? p.nsa_pe_v : p.nsa_pe_k) + l * 2048 + kt * 64; pp = p.pebp() + ((long)((l * 2 + kv) * 32 + kt)) * 256 + nt * 64;
            return;
        }
        q -= J_W1;
        if (q < J_W2) {
            const int kt = q & 3, kv = (q >> 2) & 1, l = q >> 3;
            sp = (kv ? p.nsa_w2_v : p.nsa_w2_k) + (long)l * 256 * 64 + (long)kt * 64 * 64 + nn; ld = 64;
            dst = p.W2t() + ((long)(l * 2 + kv) * 64) * 256 + kt * 64; ldd = 256;
            return;
        }
        q -= J_W2;
        if (q < J_WB) {
            const int kt = q & 3, nt = (q >> 2) & 15, i = (q >> 6) & 3, l = q >> 8;
            sp = p.w_branch + ((long)(l * 4 + i) * 256 + kt * 64) * D_ + nt * 64 + nn; ld = D_;
            dst = p.Wbt() + (long)l * 1024 * 1024 + ((long)(i * 8 + kt * 2) * 1024 + nt * 64) * 32; ldd = -1024;
            return;
        }
        q -= J_WB;
        {
            const int kt = q & 15, nt = (q >> 4) & 15, l = q >> 8;
            sp = p.w_out + ((long)l * D_ + kt * 64) * D_ + nt * 64 + nn; ld = D_;
            dst = p.Wot() + (long)l * 1024 * 1024 + ((long)(kt * 2) * 1024 + nt * 64) * 32; ldd = -1024;
        }
    };
    if (part & 2) for (int j0 = bid; j0 < total; j0 += 4 * nblk) {
        float v[4][16];
#pragma unroll
        for (int u = 0; u < 4; ++u) {
            const int j = j0 + u * nblk;
            if (j < total) {
                const float* sp; int ld; const float* ks; bf16_t* dst; int ldd; const float* pe; float* pp;
                desc(j, sp, ld, ks, dst, ldd, pe, pp);
#pragma unroll
                for (int i = 0; i < 16; ++i) {
                    const int kk = i * 4 + (tid >> 6);
                    float x = sp ? sp[(long)kk * ld] : 0.f;
                    if (ks) x *= ks[kk];
                    v[u][i] = x;
                }
            } else {
#pragma unroll
                for (int i = 0; i < 16; ++i) v[u][i] = 0.f;
            }
        }
        __syncthreads();
#pragma unroll
        for (int u = 0; u < 4; ++u) {
            float (*tile)[65] = (float (*)[65])(lds + u * 16640);
#pragma unroll
            for (int i = 0; i < 16; ++i) tile[i * 4 + (tid >> 6)][tid & 63] = v[u][i];
        }
        __syncthreads();
#pragma unroll
        for (int u = 0; u < 4; ++u) {
            const int j = j0 + u * nblk;
            if (j < total) {
                const float* sp; int ld; const float* ks; bf16_t* dst; int ldd; const float* pe; float* pp;
                desc(j, sp, ld, ks, dst, ldd, pe, pp);
                float (*tile)[65] = (float (*)[65])(lds + u * 16640);
                if (pe && tid < 64) {
                    float a = 0.f;
#pragma unroll 16
                    for (int kk = 0; kk < 64; ++kk) a += pe[kk] * tile[kk][tid];
                    pp[tid] = a;
                }
#pragma unroll
                for (int i = 0; i < 2; ++i) {
                    const int c = tid + 256 * i; const int nn = c >> 3, kc = (c & 7) * 8;
                    u32x4 o4;
                    o4.x = cvtpk(tile[kc + 0][nn], tile[kc + 1][nn]); o4.y = cvtpk(tile[kc + 2][nn], tile[kc + 3][nn]);
                    o4.z = cvtpk(tile[kc + 4][nn], tile[kc + 5][nn]); o4.w = cvtpk(tile[kc + 6][nn], tile[kc + 7][nn]);
                    if (ldd < 0) *(u32x4*)(dst + ((long)(kc >> 5) * (-ldd) + nn) * 32 + (kc & 31)) = o4;
                    else *(u32x4*)(dst + (long)nn * ldd + kc) = o4;
                }
            }
        }
    }
    __syncthreads();
    if (part & 4) for (int idx0 = bid * 256 + tid; idx0 < 2 * 80 * 1024; idx0 += 2 * nblk * 256)
#pragma unroll
    for (int u_ = 0; u_ < 2; ++u_) {
        const int idx = idx0 + u_ * nblk * 256;
        if (idx >= 2 * 80 * 1024) continue;
        int k = idx & 1023, jn = (idx >> 10) % 80, l = idx / (80 * 1024);
        float v = 0.f;
        if (jn < 8) v = p.moe_w_group[((long)l * D_ + k) * 8 + jn];
        else if (jn < 72) v = p.moe_w_expert[((long)l * D_ + k) * 64 + jn - 8];
        v *= p.ffn_norm[l * D_ + k];
        const bf16_t hb = f2bf(v); const bf16_t lb = f2bf(v - bf2f(hb));
        bf16_t* wh = (bf16_t*)p.Wrt(); bf16_t* wl = wh + 2 * 80 * 1024;
        wh[idx] = hb; wl[idx] = lb;
    }
}

__device__ __forceinline__ long hn_panel_off(long row, int c) { return ((long)(c >> 5) * T_ + row) * 32 + (c & 31); }
__device__ __forceinline__ void phase_norm(const Params& p, int l, int bid, int nblk) {
    const int tid = otid(), lane = tid & 63, w = tid >> 6;
    for (int row0 = (bid * 4 + w) * 4; row0 < T_; row0 += nblk * 16) {
        f32x4 v[4][4];
#pragma unroll
        for (int k = 0; k < 4; ++k) {
            const float* x = (l == 0 ? p.x : (const float*)p.h()) + (long)(row0 + k) * D_;
#pragma unroll
            for (int i = 0; i < 4; ++i) v[k][i] = *(const f32x4*)(x + i * 256 + lane * 4);
        }
#pragma unroll
        for (int k = 0; k < 4; ++k) {
            const int row = row0 + k;
            float ss = 0.f;
#pragma unroll
            for (int i = 0; i < 4; ++i) ss += v[k][i][0] * v[k][i][0] + v[k][i][1] * v[k][i][1] + v[k][i][2] * v[k][i][2] + v[k][i][3] * v[k][i][3];
            for (int o = 32; o > 0; o >>= 1) ss += __shfl_xor(ss, o);
            const float rs = rsqrtf(ss / (float)D_ + 1e-6f);
#pragma unroll
            for (int i = 0; i < 4; ++i) {
                const f32x4 g = *(const f32x4*)(p.attn_norm + l * D_ + i * 256 + lane * 4);
                u32x2 o2; o2.x = cvtpk(v[k][i][0] * rs * g[0], v[k][i][1] * rs * g[1]); o2.y = cvtpk(v[k][i][2] * rs * g[2], v[k][i][3] * rs * g[3]);
                *(u32x2*)(p.hn() + hn_panel_off(row, i * 256 + lane * 4)) = o2;
            }
        }
    }
}

__device__ __forceinline__ void st4(bf16_t* dst, float a, float b, float c, float d) { u32x2 v; v.x = cvtpk(a, b); v.y = cvtpk(c, d); *(u32x2*)dst = v; }

__device__ __forceinline__ void epi_tok(const f32x16 (&acc)[2][2], int m_base, int kind, float scale, bf16_t* dst, int ld, int col0, const float* cs, const float* sn) {
    const int lane = otid() & 63, r32 = lane & 31, hi = lane >> 5;
#pragma unroll
    for (int mi = 0; mi < 2; ++mi) {
        const long m = m_base + mi * 32 + r32;
#pragma unroll
        for (int rg = 0; rg < 4; ++rg) {
            float x1[4], x2[4];
#pragma unroll
            for (int j = 0; j < 4; ++j) { x1[j] = acc[0][mi][rg * 4 + j]; x2[j] = acc[1][mi][rg * 4 + j]; }
            const int i0 = 8 * rg + 4 * hi;
            if (kind == 1) {
                f32x4 c = *(const f32x4*)(cs + m * 32 + i0), s = *(const f32x4*)(sn + m * 32 + i0);
#pragma unroll
                for (int j = 0; j < 4; ++j) { float a = x1[j] * c[j] - x2[j] * s[j]; float b = x2[j] * c[j] + x1[j] * s[j]; x1[j] = a; x2[j] = b; }
            }
            st4(dst + m * ld + col0 + i0, x1[0] * scale, x1[1] * scale, x1[2] * scale, x1[3] * scale);
            st4(dst + m * ld + col0 + 32 + i0, x2[0] * scale, x2[1] * scale, x2[2] * scale, x2[3] * scale);
        }
    }
}
#define EPI_PITCH 136
__device__ __forceinline__ void epi_tok_staged(const f32x16 (&acc)[2][2], int m_base, int kind, int act, float scale, bf16_t* dst, int ld, int col0,
                                               const float* cs, const float* sn, char* wlds) {
    const int lane = otid() & 63, r32 = lane & 31, hi = lane >> 5;
#pragma unroll
    for (int mi = 0; mi < 2; ++mi) {
#pragma unroll
        for (int ni = 0; ni < 2; ++ni)
#pragma unroll
            for (int rg = 0; rg < 4; ++rg) {
                float v0 = acc[ni][mi][rg * 4 + 0], v1 = acc[ni][mi][rg * 4 + 1], v2 = acc[ni][mi][rg * 4 + 2], v3 = acc[ni][mi][rg * 4 + 3];
                if (act == 1) { v0 = sigmoidf_(v0); v1 = sigmoidf_(v1); v2 = sigmoidf_(v2); v3 = sigmoidf_(v3); }
                u32x2 pk; pk.x = cvtpk(v0 * scale, v1 * scale); pk.y = cvtpk(v2 * scale, v3 * scale);
                *(u32x2*)(wlds + r32 * EPI_PITCH + (ni * 32 + 8 * rg + 4 * hi) * 2) = pk;
            }
        __builtin_amdgcn_s_waitcnt(0xc07f);
        if (kind == 1) {
#pragma unroll
            for (int it = 0; it < 2; ++it) {
                const int row = it * 16 + (lane >> 2), c = lane & 3; const long m = m_base + mi * 32 + row;
                const u32x4 a = *(const u32x4*)(wlds + row * EPI_PITCH + c * 16), b = *(const u32x4*)(wlds + row * EPI_PITCH + 64 + c * 16);
                const f32x4 c0 = *(const f32x4*)(cs + m * 32 + 8 * c), c1 = *(const f32x4*)(cs + m * 32 + 8 * c + 4);
                const f32x4 s0 = *(const f32x4*)(sn + m * 32 + 8 * c), s1 = *(const f32x4*)(sn + m * 32 + 8 * c + 4);
                const float cc[8] = {c0[0], c0[1], c0[2], c0[3], c1[0], c1[1], c1[2], c1[3]};
                const float ss[8] = {s0[0], s0[1], s0[2], s0[3], s1[0], s1[1], s1[2], s1[3]};
                u32x4 oa, ob;
#pragma unroll
                for (int j = 0; j < 4; ++j) {
                    const float x1l = __uint_as_float(a[j] << 16), x1h = __uint_as_float(a[j] & 0xffff0000u);
                    const float x2l = __uint_as_float(b[j] << 16), x2h = __uint_as_float(b[j] & 0xffff0000u);
                    oa[j] = cvtpk(x1l * cc[2 * j] - x2l * ss[2 * j], x1h * cc[2 * j + 1] - x2h * ss[2 * j + 1]);
                    ob[j] = cvtpk(x2l * cc[2 * j] + x1l * ss[2 * j], x2h * cc[2 * j + 1] + x1h * ss[2 * j + 1]);
                }
                *(u32x4*)(dst + m * ld + col0 + 8 * c) = oa;
                *(u32x4*)(dst + m * ld + col0 + 32 + 8 * c) = ob;
            }
        } else {
#pragma unroll
            for (int it = 0; it < 4; ++it) {
                const int row = it * 8 + (lane >> 3), c = lane & 7; const long m = m_base + mi * 32 + row;
                *(u32x4*)(dst + m * ld + col0 + 8 * c) = *(const u32x4*)(wlds + row * EPI_PITCH + c * 16);
            }
        }
    }
}
__device__ __forceinline__ void epi_vt(const f32x16 (&acc)[2][2], int m_base, bf16_t* dst, int nh, int hh) {
    const int lane = otid() & 63, r32 = lane & 31, hi = lane >> 5;
    const int b = m_base / S_; const int t0 = m_base % S_;
    bf16_t* ubase = uni_ptr(dst + ((long)(b * nh + hh) * 64) * S_);
#pragma unroll
    for (int mi = 0; mi < 2; ++mi) {
        const unsigned off0 = (unsigned)vtpos(t0 + mi * 32 + r32) + (unsigned)(4 * hi) * S_;
#pragma unroll
        for (int ni = 0; ni < 2; ++ni)
#pragma unroll
            for (int r = 0; r < 16; ++r) ubase[off0 + (unsigned)((ni * 32 + (r & 3) + 8 * (r >> 2)) * S_)] = f2bf(acc[ni][mi][r]);
    }
}

__device__ __forceinline__ bool raster_tile(int it, int bid, int nblk, int ntm, int ntn, int& tm, int& tn, bool& done) {
    done = false;
    if (nblk != 512) {
        const int tile = bid + it * nblk;
        if (tile >= ntm * ntn) { done = true; return false; }
        tn = tile / ntm; tm = tile % ntm; return true;
    }
    const int gm = (ntm + 7) >> 3, gn = (ntn + 7) >> 3;
    const int st = it * 8 + (bid & 7);
    if (it * 8 >= gm * gn) { done = true; return false; }
    if (st >= gm * gn) return false;
    const int sm = st % gm, sn = st / gm;
    const int j = bid >> 3;
    tm = sm * 8 + (j & 7); tn = sn * 8 + (j >> 3);
    return tm < ntm && tn < ntn;
}
template <int VAR = 0>
__device__ __forceinline__ void phase_inproj(const Params& p, int l, int bid, int nblk, char* lds) {
    const int tid = otid(), lane = tid & 63, w = tid >> 6, r32 = lane & 31, hi = lane >> 5;
    const int wm = w & 1, wn = w >> 1;
    const bf16_t* Wc = p.Wcat() + (long)l * NCAT * 1024;
    const int NT_N = NCAT / 128, NT_M = T_ / 256;
    auto rmap = [&](int it_) { return (nblk == 512 && it_ < 7) ? (it_ == 0 ? 6 : it_ < 4 ? it_ + 2 : it_ - 4) : it_; };
    int it = 0, tm = 0, tn = 0; bool have = false;
    for (;; ++it) { bool done; if (raster_tile(rmap(it), bid, nblk, NT_M, NT_N, tm, tn, done)) { have = true; break; } if (done) break; }
    const long KSA = (long)T_ * 32, KSB = (long)NCAT * 32;
    if (have) gemm_big_issue01(p.hn() + (long)tm * 256 * 32, 32, Wc + (long)tn * 128 * 32, 32, lds, KSA, KSB);
    while (have) {
        const int m0 = tm * 256, n0 = tn * 128;
        f32x16 accb[2][2][2];
#pragma unroll
        for (int c = 0; c < 2; ++c)
#pragma unroll
            for (int a = 0; a < 2; ++a)
#pragma unroll
                for (int b = 0; b < 2; ++b)
#pragma unroll
                    for (int r = 0; r < 16; ++r) accb[c][a][b][r] = 0.f;
        const bf16_t* A = p.hn() + (long)m0 * 32;
        const bf16_t* Bt = Wc + (long)n0 * 32;
        gemm_big(accb, A, 32, Bt, 32, D_, lds, KSA, KSB);
        const int g = tn * 2 + wn;
        have = false;
        for (++it;; ++it) { bool done; if (raster_tile(rmap(it), bid, nblk, NT_M, NT_N, tm, tn, done)) { have = true; break; } if (done) break; }
        if (have) gemm_big_issue01(p.hn() + (long)tm * 256 * 32, 32, Wc + (long)tn * 128 * 32, 32, lds, KSA, KSB);
        char* wl = lds + 2 * BSTG + w * 4352;
        const float* cs = p.cs(); const float* sn = p.sn();
        int mode = 0, kind = 0, act = 0, ld = 256, col0 = 0, nh = 1, hh = 0; float scale = 1.f; bf16_t* dst = nullptr;
        if (g < 4) { kind = 1; scale = QSCALE; dst = p.qa(); col0 = g * 64; }
        else if (g == 4) { kind = 1; dst = p.kcmp(); ld = 64; }
        else if (g == 5) { dst = p.vcmp(); ld = 64; }
        else if (g == 6) { kind = 1; dst = p.ksel(); ld = 64; }
        else if (g == 7) { mode = 1; dst = p.vselT(); }
        else if (g == 8) { kind = 1; dst = p.kwin(); ld = 64; }
        else if (g == 9) { mode = 1; dst = p.vwinT(); }
        else if (g < 14) { scale = QSCALE; dst = p.qb(); col0 = (g - 10) * 64; }
        else if (g < 18) { dst = p.kb(); col0 = (g - 14) * 64; }
        else if (g < 22) { mode = 1; dst = p.vbT(); nh = 4; hh = g - 18; }
        else if (g < 26) { kind = 1; scale = QSCALE; dst = p.qc(); col0 = (g - 22) * 64; }
        else if (g < 28) { dst = p.ckv(); ld = 128; col0 = (g - 26) * 64; }
        else if (g < 32) { kind = 1; dst = p.qi(); col0 = (g - 28) * 64; }
        else if (g == 32) { kind = 1; dst = p.ki(); ld = 64; }
        else if (g < 37) { kind = 1; scale = QSCALE; dst = p.qd(); col0 = (g - 33) * 64; }
        else if (g < 39) { kind = 1; dst = p.kd(); ld = 128; col0 = (g - 37) * 64; }
        else if (g < 41) { mode = 1; dst = p.vdT(); nh = 2; hh = g - 39; }
        else if (g == 41) { mode = 2; }
        else { mode = 3; dst = p.gates(); col0 = (g - 42) * 64; }
#pragma unroll
        for (int mh = 0; mh < 2; ++mh) {
        const f32x16 (&acc)[2][2] = accb[mh];
        const int mb = m0 + wm * 128 + mh * 64;
        if (mode == 0) epi_tok_staged(acc, mb, kind, act, scale, dst, ld, col0, cs, sn, wl);
        else if (mode == 1) epi_vt(acc, mb, dst, nh, hh);
        else if (mode == 3) {
#pragma unroll
            for (int mi = 0; mi < 2; ++mi)
#pragma unroll
                for (int ni = 0; ni < 2; ++ni) {
                    const long blk = (long)((mb >> 5) + mi) * 128 + (col0 >> 5) + ni;
                    bf16_t* gd = dst + blk * 1024 + lane * 8;
#pragma unroll
                    for (int hf = 0; hf < 2; ++hf) {
                        u32x4 pk;
                        pk.x = cvtpk_t(sigmoidf_(acc[ni][mi][hf * 8 + 0]), sigmoidf_(acc[ni][mi][hf * 8 + 1])); pk.y = cvtpk_t(sigmoidf_(acc[ni][mi][hf * 8 + 2]), sigmoidf_(acc[ni][mi][hf * 8 + 3]));
                        pk.z = cvtpk_t(sigmoidf_(acc[ni][mi][hf * 8 + 4]), sigmoidf_(acc[ni][mi][hf * 8 + 5])); pk.w = cvtpk_t(sigmoidf_(acc[ni][mi][hf * 8 + 6]), sigmoidf_(acc[ni][mi][hf * 8 + 7]));
                        st16_asm(gd + hf * 512, pk);
                    }
                }
        }
        else {
#pragma unroll
            for (int mi = 0; mi < 2; ++mi) {
                const long m = mb + mi * 32 + r32;
#pragma unroll
                for (int r = 0; r < 16; ++r) {
                    const int c = crow(r, hi); const float v = acc[0][mi][r];
                    if (c < 12) p.ga()[m * 12 + c] = sigmoidf_(v);
                    else if (c < 16) { float xx = v + p.fox_bias[l * 4 + c - 12]; p.logf()[m * 4 + c - 12] = fminf(xx, 0.f) - __logf(1.f + __expf(-fabsf(xx))); }
                    else if (c < 20) p.wi()[m * 4 + c - 16] = v * 0.0625f;
                }
            }
        }
        }
    }
}

enum { A_FOX = 0, A_DSA = 1, A_SEL = 2, A_WIN = 3, A_SWA = 4, A_CMP = 5 };
struct AttnDesc {
    const bf16_t* q;
    const bf16_t* k; int ldk;
    const bf16_t* vt; int ldvt;
    int kt_lo, kt_hi;
    int wkt_lo, wkt_hi;
    int tq;
    unsigned tilemask;
    unsigned selm;
    const unsigned* dmask;
    const float* kbias;
    int window;
};
__device__ __forceinline__ float hswap_max(float v) { auto rr = __builtin_amdgcn_permlane32_swap(__float_as_uint(v), __float_as_uint(v), false, false); return fmaxf(__uint_as_float(rr[0]), __uint_as_float(rr[1])); }
__device__ __forceinline__ float hswap_sum(float v) { auto rr = __builtin_amdgcn_permlane32_swap(__float_as_uint(v), __float_as_uint(v), false, false); return __uint_as_float(rr[0]) + __uint_as_float(rr[1]); }

template <int MODE>
__device__ __forceinline__ void attn_core(const AttnDesc& u, f32x16 (&o)[2], float& m_out, float& l_out, char* lds) {
    const int tid = otid(), lane = tid & 63, w = tid >> 6, r32 = lane & 31, hi = lane >> 5;
    const unsigned lds0 = (unsigned)(uintptr_t)lds;
    bf16x8 qf[4];
#pragma unroll
    for (int ds = 0; ds < 4; ++ds) qf[ds] = *(const bf16x8*)(u.q + ds * 16 + hi * 8);
#pragma unroll
    for (int r = 0; r < 16; ++r) { o[0][r] = 0.f; o[1][r] = 0.f; }
    float m = -1e30f, l = 0.f;
    const int srow = 8 * w + (lane >> 3), sslot = lane & 7;
    const int key = (r32 >> 1) & 7;
    const bool bias_wave = ((MODE == A_FOX) && (w == 0)) || (MODE == A_DSA);
    auto issue = [&](int st) {
        const int kt = u.kt_lo + st;
        const unsigned base = lds0 + (st & 3) * 16384 + 8 * w * 128;
#pragma unroll
        for (int half = 0; half < 2; ++half) {
            const int r = 32 * half + srow; const int ch = (sslot ^ ((r >> 1) & 7)) * 8;
            glds16(u.k + (long)(kt * 64 + r) * u.ldk + ch, (unsigned)__builtin_amdgcn_readfirstlane(base + 32 * half * 128));
            glds16(u.vt + (long)r * u.ldvt + kt * 64 + ch, (unsigned)__builtin_amdgcn_readfirstlane(base + 8192 + 32 * half * 128));
        }
        if (MODE == A_FOX) { if (w == 0) glds4(u.kbias + kt * 64 + lane, (unsigned)__builtin_amdgcn_readfirstlane(lds0 + LDS_AUX + 1024 + (st & 3) * 256)); }
        if (MODE == A_DSA) glds4(u.dmask + kt * 2 + hi, (unsigned)__builtin_amdgcn_readfirstlane(lds0 + LDS_AUX + 2048 + (st & 3) * 1024 + w * 256));
    };
    const int nsteps = u.kt_hi - u.kt_lo + 1;
    asm volatile("s_waitcnt vmcnt(0)" ::: "memory");
#pragma unroll
    for (int i = 0; i < 3; ++i) if (i < nsteps) issue(i);
    for (int st = 0; st < nsteps; ++st) {
        const int ahead = nsteps - 1 - st;
        if (ahead >= 2) { if (bias_wave) asm volatile("s_waitcnt vmcnt(10) lgkmcnt(0)\n\ts_barrier" ::: "memory"); else asm volatile("s_waitcnt vmcnt(8) lgkmcnt(0)\n\ts_barrier" ::: "memory"); }
        else if (ahead == 1) { if (bias_wave) asm volatile("s_waitcnt vmcnt(5) lgkmcnt(0)\n\ts_barrier" ::: "memory"); else asm volatile("s_waitcnt vmcnt(4) lgkmcnt(0)\n\ts_barrier" ::: "memory"); }
        else asm volatile("s_waitcnt vmcnt(0) lgkmcnt(0)\n\ts_barrier" ::: "memory");
        if (st + 3 < nsteps) issue(st + 3);
        const int kt = u.kt_lo + st;
        u32x2 dm = {0u, 0u};
        if (MODE == A_DSA) { const unsigned* mw = (const unsigned*)(lds + LDS_AUX + 2048 + (st & 3) * 1024 + w * 256); dm.x = mw[r32]; dm.y = mw[32 + r32]; }
        const bool active = kt >= u.wkt_lo && kt <= u.wkt_hi && (MODE != A_SEL || ((u.tilemask >> kt) & 1u));
        if (active) {
            const char* ldsK = lds + (st & 3) * 16384; const char* ldsV = ldsK + 8192;
            f32x16 p[2];
            if (MODE == A_FOX) {
#pragma unroll
                for (int sub = 0; sub < 2; ++sub)
#pragma unroll
                    for (int rg = 0; rg < 4; ++rg) {
                        const f32x4 bv = *(const f32x4*)(lds + LDS_AUX + 1024 + (st & 3) * 256 + (32 * sub + 8 * rg + 4 * hi) * 4);
                        p[sub][rg * 4 + 0] = bv[0]; p[sub][rg * 4 + 1] = bv[1]; p[sub][rg * 4 + 2] = bv[2]; p[sub][rg * 4 + 3] = bv[3];
                    }
            } else {
#pragma unroll
                for (int r = 0; r < 16; ++r) { p[0][r] = 0.f; p[1][r] = 0.f; }
            }
#pragma unroll
            for (int ds = 0; ds < 4; ++ds) {
                const int coff = ((ds * 2 + hi) ^ key) * 16;
                const bf16x8 k0 = *(const bf16x8*)(ldsK + r32 * 128 + coff);
                const bf16x8 k1 = *(const bf16x8*)(ldsK + (32 + r32) * 128 + coff);
                p[0] = MFMA32(k0, qf[ds], p[0]);
                p[1] = MFMA32(k1, qf[ds], p[1]);
            }
            const int key0 = kt * 64 + 4 * hi;
            if (MODE == A_FOX || MODE == A_SEL || MODE == A_WIN || MODE == A_SWA || MODE == A_CMP || MODE == A_DSA) {
                if (MODE == A_CMP || kt * 64 + 63 > u.tq - r32) {
#pragma unroll
                    for (int sub = 0; sub < 2; ++sub)
#pragma unroll
                        for (int r = 0; r < 16; ++r) { const int kk = key0 + 32 * sub + (r & 3) + 8 * (r >> 2); if (kk > u.tq) p[sub][r] = -INFINITY; }
                }
            }
            if (MODE == A_WIN || MODE == A_SWA) {
                if (kt * 64 <= u.tq - r32 + 31 - u.window) {
#pragma unroll
                    for (int sub = 0; sub < 2; ++sub)
#pragma unroll
                        for (int r = 0; r < 16; ++r) { const int kk = key0 + 32 * sub + (r & 3) + 8 * (r >> 2); if (kk <= u.tq - u.window) p[sub][r] = -INFINITY; }
                }
            }
            if (MODE == A_SEL) {
                if (!((u.selm >> kt) & 1u)) {
#pragma unroll
                    for (int r = 0; r < 16; ++r) { p[0][r] = -INFINITY; p[1][r] = -INFINITY; }
                }
            }
            if (MODE == A_DSA) {
                const unsigned w0 = dm.x >> (4 * hi), w1 = dm.y >> (4 * hi);
#pragma unroll
                for (int r = 0; r < 16; ++r) {
                    const unsigned bit = 1u << ((r & 3) + 8 * (r >> 2));
                    if (!(w0 & bit)) p[0][r] = -INFINITY;
                    if (!(w1 & bit)) p[1][r] = -INFINITY;
                }
            }
            float mloc = p[0][0];
#pragma unroll
            for (int r = 1; r < 16; ++r) mloc = fmaxf(mloc, p[0][r]);
#pragma unroll
            for (int r = 0; r < 16; ++r) mloc = fmaxf(mloc, p[1][r]);
            mloc = hswap_max(mloc);
            if (__any(mloc > m + 8.f)) {
                const float mn = fmaxf(m, mloc);
                const float alpha = __builtin_amdgcn_exp2f(m - mn);
                l *= alpha;
#pragma unroll
                for (int r = 0; r < 16; ++r) { o[0][r] *= alpha; o[1][r] *= alpha; }
                m = mn;
            }
            float ls = 0.f;
#pragma unroll
            for (int sub = 0; sub < 2; ++sub)
#pragma unroll
                for (int r = 0; r < 16; ++r) { const float e = __builtin_amdgcn_exp2f(p[sub][r] - m); p[sub][r] = e; ls += e; }
            l += ls;
#pragma unroll
            for (int ks = 0; ks < 4; ++ks) {
                const int sub = ks >> 1, rb = 8 * (ks & 1);
                u32x4 pw;
                pw.x = cvtpk(p[sub][rb + 0], p[sub][rb + 1]); pw.y = cvtpk(p[sub][rb + 2], p[sub][rb + 3]);
                pw.z = cvtpk(p[sub][rb + 4], p[sub][rb + 5]); pw.w = cvtpk(p[sub][rb + 6], p[sub][rb + 7]);
                const bf16x8 pf = __builtin_bit_cast(bf16x8, pw);
                const int coff = ((ks * 2 + hi) ^ key) * 16;
                const bf16x8 v0 = *(const bf16x8*)(ldsV + r32 * 128 + coff);
                const bf16x8 v1 = *(const bf16x8*)(ldsV + (32 + r32) * 128 + coff);
                o[0] = MFMA32(v0, pf, o[0]);
                o[1] = MFMA32(v1, pf, o[1]);
            }
        }
    }
    __syncthreads();
    m_out = m; l_out = hswap_sum(l);
}

__device__ __forceinline__ void st_o(bf16_t* obase, long row, int col0, const f32x16 (&o)[2], float sc, int hi) {
#pragma unroll
    for (int dh = 0; dh < 2; ++dh) {
        bf16_t* dst = obase + ((long)((col0 >> 5) + dh) * T_ + row) * 32 + 4 * hi;
#pragma unroll
        for (int rg = 0; rg < 4; ++rg)
            st4(dst + 8 * rg, o[dh][rg * 4 + 0] * sc, o[dh][rg * 4 + 1] * sc, o[dh][rg * 4 + 2] * sc, o[dh][rg * 4 + 3] * sc);
    }
}
__device__ __forceinline__ void unit_fox(const Params& p, int unit, char* lds) {
    const int tid = otid(), lane = tid & 63, w = tid >> 6, r32 = lane & 31, hi = lane >> 5;
    const int qb = unit & 15, h = (unit >> 4) & 3, b = unit >> 6;
    const int q0 = qb * 128 + w * 32;
    AttnDesc u{};
    const long row = (long)b * S_ + q0 + r32;
    u.q = p.qb() + row * 256 + h * 64;
    u.k = p.kb() + (long)b * S_ * 256 + h * 64; u.ldk = 256;
    u.vt = p.vbT() + ((long)(b * 4 + h) * 64) * S_; u.ldvt = S_;
    u.kt_lo = 0; u.kt_hi = (qb * 128 + 127) >> 6; u.wkt_lo = 0; u.wkt_hi = (q0 + 31) >> 6;
    u.tq = q0 + r32;
    u.kbias = p.kbias() + (long)(b * 4 + h) * S_;
    f32x16 o[2]; float m, l;
    attn_core<A_FOX>(u, o, m, l, lds);
    st_o(p.o(), row, 256 + h * 64, o, 1.f / l, hi);
}
__device__ __forceinline__ void phase_fox(const Params& p, int bid, int nblk, char* lds) {
    for (int i = bid; i < B_ * 4 * 16; i += nblk) unit_fox(p, ((i & 31) << 4) | (15 - (i >> 5)), lds);
}
__device__ __forceinline__ void phase_cumsum(const Params& p, int bid, int nblk, int single = -1) {
    const int tid = otid(), lane = tid & 63, w = tid >> 6;
    for (int seq_ = bid * 4 + w; seq_ < (single >= 0 ? bid * 4 + w + 1 : B_ * 4); seq_ += nblk * 4) {
        const int seq = single >= 0 ? single * 4 + w : seq_;
        const int b = seq >> 2, h = seq & 3;
        float v[32]; float tot = 0.f;
#pragma unroll
        for (int i = 0; i < 32; ++i) { v[i] = p.logf()[((long)b * S_ + lane * 32 + i) * 4 + h]; tot += v[i]; }
        float inc = tot;
#pragma unroll
        for (int o = 1; o < 64; o <<= 1) { float t = __shfl_up(inc, o); if (lane >= o) inc += t; }
        float run = inc - tot;
#pragma unroll
        for (int i = 0; i < 32; ++i) { run += v[i]; p.kbias()[(long)(b * 4 + h) * S_ + lane * 32 + i] = -run * LOG2E; }
    }
}

__device__ __forceinline__ void unit_swa(const Params& p, int l, int unit, char* lds) {
    const int tid = otid(), lane = tid & 63, w = tid >> 6, r32 = lane & 31, hi = lane >> 5;
    const int qb = unit & 31, kvh = (unit >> 5) & 1, b = unit >> 6;
    const int h = kvh * 2 + (w & 1);
    const int q0 = qb * 64 + 32 * (w >> 1);
    AttnDesc u{};
    const long row = (long)b * S_ + q0 + r32;
    u.q = p.qd() + row * 256 + h * 64;
    u.k = p.kd() + (long)b * S_ * 128 + kvh * 64; u.ldk = 128;
    u.vt = p.vdT() + ((long)(b * 2 + kvh) * 64) * S_; u.ldvt = S_;
    int lo = qb * 64 - 127; if (lo < 0) lo = 0;
    u.kt_lo = lo >> 6; u.kt_hi = qb;
    int wlo = q0 - 127; if (wlo < 0) wlo = 0;
    u.wkt_lo = wlo >> 6; u.wkt_hi = (q0 + 31) >> 6;
    u.tq = q0 + r32; u.window = 128;
    f32x16 o[2]; float m, lsum;
    attn_core<A_SWA>(u, o, m, lsum, lds);
    const float sk = p.swa_sinks[l * 4 + h] * LOG2E;
    const float mn = fmaxf(m, sk); const float a = __builtin_amdgcn_exp2f(m - mn);
    st_o(p.o(), row, 768 + h * 64, o, a / (lsum * a + __builtin_amdgcn_exp2f(sk - mn)), hi);
}
__device__ __forceinline__ void phase_swa(const Params& p, int l, int bid, int nblk, char* lds) {
    for (int unit = bid; unit < B_ * 2 * 32; unit += nblk) unit_swa(p, l, unit, lds);
}
__device__ __forceinline__ void unit_win(const Params& p, int unit, char* lds) {
    const int tid = otid(), lane = tid & 63, w = tid >> 6, r32 = lane & 31, hi = lane >> 5;
    const int qb = unit & 63, b = unit >> 6;
    const int h = w, q0 = qb * 32;
    AttnDesc u{};
    const long row = (long)b * S_ + q0 + r32;
    u.q = p.qa() + row * 256 + h * 64;
    u.k = p.kwin() + (long)b * S_ * 64; u.ldk = 64;
    u.vt = p.vwinT() + ((long)b * 64) * S_; u.ldvt = S_;
    int lo = q0 - 511; if (lo < 0) lo = 0;
    u.kt_lo = lo >> 6; u.kt_hi = (q0 + 31) >> 6; u.wkt_lo = u.kt_lo; u.wkt_hi = u.kt_hi;
    u.tq = q0 + r32; u.window = 512;
    f32x16 o[2]; float m, lsum;
    attn_core<A_WIN>(u, o, m, lsum, lds);
    const float sc = p.ga()[row * 12 + h * 3 + 2] / lsum;
    float* dst = p.owin() + row * 256 + h * 64;
#pragma unroll
    for (int dh = 0; dh < 2; ++dh)
#pragma unroll
        for (int rg = 0; rg < 4; ++rg) {
            f32x4 v = {o[dh][rg * 4 + 0] * sc, o[dh][rg * 4 + 1] * sc, o[dh][rg * 4 + 2] * sc, o[dh][rg * 4 + 3] * sc};
            *(f32x4*)(dst + dh * 32 + 8 * rg + 4 * hi) = v;
        }
}
__device__ __forceinline__ void phase_win(const Params& p, int bid, int nblk, char* lds) {
    for (int unit = bid; unit < B_ * 64; unit += nblk) unit_win(p, unit, lds);
}
__device__ __forceinline__ void unit_sel(const Params& p, int unit, char* lds) {
    const int tid = otid(), lane = tid & 63, w = tid >> 6, r32 = lane & 31, hi = lane >> 5;
    const int qb = unit & 63, b = unit >> 6;
    const int h = w, q0 = qb * 32;
    AttnDesc u{};
    const long row = (long)b * S_ + q0 + r32;
    u.q = p.qa() + row * 256 + h * 64;
    u.k = p.ksel() + (long)b * S_ * 64; u.ldk = 64;
    u.vt = p.vselT() + ((long)b * 64) * S_; u.ldvt = S_;
    u.kt_lo = 0; u.kt_hi = (q0 + 31) >> 6; u.wkt_lo = 0; u.wkt_hi = u.kt_hi;
    u.tq = q0 + r32;
    u.selm = p.selmask()[row];
    unsigned orv = u.selm;
#pragma unroll
    for (int o_ = 32; o_ > 0; o_ >>= 1) orv |= (unsigned)__shfl_xor((int)orv, o_);
    u.tilemask = (unsigned)__builtin_amdgcn_readfirstlane((int)orv);
    f32x16 o[2]; float m, lsum;
    attn_core<A_SEL>(u, o, m, lsum, lds);
    const float sc = p.ga()[row * 12 + h * 3 + 1] / lsum;
    const float* oc = p.ocmp() + row * 256 + h * 64; const float* ow = p.owin() + row * 256 + h * 64;
#pragma unroll
    for (int dh = 0; dh < 2; ++dh)
#pragma unroll
        for (int rg = 0; rg < 4; ++rg) {
            const int c = dh * 32 + 8 * rg + 4 * hi;
            const f32x4 a = *(const f32x4*)(oc + c), bb = *(const f32x4*)(ow + c);
            bf16_t* dst = p.o() + ((long)(h * 2 + dh) * T_ + row) * 32 - dh * 32;
            st4(dst + c, o[dh][rg * 4 + 0] * sc + a[0] + bb[0], o[dh][rg * 4 + 1] * sc + a[1] + bb[1], o[dh][rg * 4 + 2] * sc + a[2] + bb[2],
                o[dh][rg * 4 + 3] * sc + a[3] + bb[3]);
        }
}
__device__ __forceinline__ void phase_sel(const Params& p, int bid, int nblk, char* lds) {
    for (int i = bid; i < B_ * 64; i += nblk) unit_sel(p, ((i & 7) << 6) | (63 - (i >> 3)), lds);
}
__device__ __forceinline__ void unit_dsa(const Params& p, int unit, char* lds) {
    const int tid = otid(), lane = tid & 63, w = tid >> 6, r32 = lane & 31, hi = lane >> 5;
    const int qb = unit & 15, h = (unit >> 4) & 3, b = unit >> 6;
    const int q0 = qb * 128 + w * 32;
    AttnDesc u{};
    const long row = (long)b * S_ + q0 + r32;
    u.q = p.qc() + row * 256 + h * 64;
    u.k = p.kcc() + (long)b * S_ * 256 + h * 64; u.ldk = 256;
    u.vt = p.vcT() + ((long)(b * 4 + h) * 64) * S_; u.ldvt = S_;
    u.kt_lo = 0; u.kt_hi = (qb * 128 + 127) >> 6; u.wkt_lo = 0; u.wkt_hi = (q0 + 31) >> 6;
    u.tq = q0 + r32;
    u.dmask = p.dmask() + row * 64;
    f32x16 o[2]; float m, lsum;
    attn_core<A_DSA>(u, o, m, lsum, lds);
    st_o(p.o(), row, 512 + h * 64, o, 1.f / lsum, hi);
}
__device__ __forceinline__ void phase_dsa(const Params& p, int bid, int nblk, char* lds) {
    for (int i = bid; i < B_ * 4 * 16; i += nblk) unit_dsa(p, ((i & 31) << 4) | (15 - (i >> 5)), lds);
}
__device__ __forceinline__ void phase_kvc(const Params& p, int l, int bid, int nblk, char* lds, int single = -1) {
    const int tid = otid(), lane = tid & 63, w = tid >> 6, r32 = lane & 31;
    const int wm = w & 1, wn = w >> 1;
    float* rsv = (float*)(lds + LDS_AUX);
    for (int unit_ = bid; unit_ < (single >= 0 ? bid + 1 : (T_ / 128) * 4); unit_ += nblk) {
        const int unit = single >= 0 ? single : unit_;
        const int tn = unit & 3, tm = unit >> 2;
        const int m0 = tm * 128;
        __syncthreads();
        {
            const int row = tid >> 1, half = tid & 1;
            const bf16_t* src = p.ckv() + (long)(m0 + row) * 128 + half * 64;
            float ss = 0.f;
#pragma unroll
            for (int i = 0; i < 8; ++i) {
                u32x4 v = *(const u32x4*)(src + i * 8);
#pragma unroll
                for (int j = 0; j < 4; ++j) { float a = __uint_as_float(v[j] << 16), b2 = __uint_as_float(v[j] & 0xffff0000u); ss += a * a + b2 * b2; }
            }
            ss += __shfl_xor(ss, 1);
            if (half == 0) rsv[row] = rsqrtf(ss / 128.f + 1e-6f);
        }
        f32x16 acc[2][2];
#pragma unroll
        for (int a = 0; a < 2; ++a)
#pragma unroll
            for (int b2 = 0; b2 < 2; ++b2)
#pragma unroll
                for (int r = 0; r < 16; ++r) acc[a][b2][r] = 0.f;
        const bf16_t* A = p.ckv() + (long)m0 * 128;
        const bf16_t* Bt = p.Wukv() + ((long)l * 512 + tn * 128) * 128;
        gemm_glds<BMODE_BF16_NK>(acc, [&](int r) { return A + (long)r * 128; }, [&](int r) { return Bt + (long)r * 128; }, 128, lds);
#pragma unroll
        for (int mi = 0; mi < 2; ++mi) {
            const float rs = rsv[wm * 64 + mi * 32 + r32];
#pragma unroll
            for (int ni = 0; ni < 2; ++ni)
#pragma unroll
                for (int r = 0; r < 16; ++r) acc[ni][mi][r] *= rs;
        }
        const int g = tn * 2 + wn;
        if (g < 4) epi_tok(acc, m0 + wm * 64, 1, 1.f, p.kcc(), 256, g * 64, p.cs(), p.sn());
        else epi_vt(acc, m0 + wm * 64, p.vcT(), 4, g - 4);
    }
}

#define SC_PER_B 2162688
__device__ __forceinline__ long sc_row_off(int b, int t) { const int qt = t >> 6; return (long)b * SC_PER_B + 2048L * qt * (qt + 1) + (long)(t & 63) * (qt + 1) * 64; }
__device__ __forceinline__ void idx_unit(const Params& p, int b, int qt, int kt0, int kt1, char* lds) {
    const int tid = otid(), lane = tid & 63, w = tid >> 6, r32 = lane & 31, hi = lane >> 5;
    const int qg = w & 1, ksub = w >> 1;
    const int lrow = tid >> 3, lch = tid & 7;
    if (kt1 <= kt0) return;
    const int t = qt * 64 + 32 * qg + r32; const long row = (long)b * S_ + t;
    bf16x8 qf[4][4];
#pragma unroll
    for (int h = 0; h < 4; ++h)
#pragma unroll
        for (int ds = 0; ds < 4; ++ds) qf[h][ds] = *(const bf16x8*)(p.qi() + row * 256 + h * 64 + ds * 16 + hi * 8);
    const f32x4 wv = *(const f32x4*)(p.wi() + row * 4);
    float* dst = p.sc() + sc_row_off(b, t) + 32 * ksub + 4 * hi;
    const bf16_t* kbase = p.ki() + (long)b * S_ * 64;
    u32x4 rk[2];
#pragma unroll
    for (int i = 0; i < 2; ++i) rk[i] = *(const u32x4*)(kbase + (long)(kt0 * 64 + lrow + 32 * i) * 64 + lch * 8);
    for (int kt = kt0; kt < kt1; ++kt) {
        __syncthreads();
#pragma unroll
        for (int i = 0; i < 2; ++i) *(u32x4*)(lds + (lrow + 32 * i) * TSTR + lch * 16) = rk[i];
        __syncthreads();
        if (kt + 1 < kt1) {
#pragma unroll
            for (int i = 0; i < 2; ++i) rk[i] = *(const u32x4*)(kbase + (long)((kt + 1) * 64 + lrow + 32 * i) * 64 + lch * 8);
        }
        bf16x8 kf[4];
#pragma unroll
        for (int ds = 0; ds < 4; ++ds) kf[ds] = *(const bf16x8*)(lds + (32 * ksub + r32) * TSTR + ds * 32 + hi * 16);
        f32x16 score;
#pragma unroll
        for (int r = 0; r < 16; ++r) score[r] = 0.f;
#pragma unroll
        for (int h = 0; h < 4; ++h) {
            f32x16 sacc;
#pragma unroll
            for (int r = 0; r < 16; ++r) sacc[r] = 0.f;
#pragma unroll
            for (int ds = 0; ds < 4; ++ds) sacc = MFMA32(kf[ds], qf[h][ds], sacc);
#pragma unroll
            for (int r = 0; r < 16; ++r) score[r] += wv[h] * fmaxf(sacc[r], 0.f);
        }
#pragma unroll
        for (int rg = 0; rg < 4; ++rg) {
            f32x4 v = {score[rg * 4 + 0], score[rg * 4 + 1], score[rg * 4 + 2], score[rg * 4 + 3]};
            *(f32x4*)(dst + kt * 64 + 8 * rg) = v;
        }
    }
    __syncthreads();
}
__device__ __forceinline__ void idx_pair(const Params& p, int pi, char* lds) {
    const int part = pi & 3, j = (pi >> 2) % 14, b = pi / 56;
    const int qa = 4 + j, qb = 31 - j;
    idx_unit(p, b, qb, ((qb + 1) * part) >> 2, ((qb + 1) * (part + 1)) >> 2, lds);
    idx_unit(p, b, qa, ((qa + 1) * part) >> 2, ((qa + 1) * (part + 1)) >> 2, lds);
}
__device__ __forceinline__ int wave_sum_i(int v) {
    v += __builtin_amdgcn_update_dpp(0, v, 0xB1, 0xF, 0xF, true);
    v += __builtin_amdgcn_update_dpp(0, v, 0x4E, 0xF, 0xF, true);
    v += __builtin_amdgcn_update_dpp(0, v, 0x141, 0xF, 0xF, true);
    v += __builtin_amdgcn_update_dpp(0, v, 0x140, 0xF, 0xF, true);
    return __builtin_amdgcn_readlane(v, 0) + __builtin_amdgcn_readlane(v, 16) + __builtin_amdgcn_readlane(v, 32) + __builtin_amdgcn_readlane(v, 48);
}
__device__ __forceinline__ void phase_dsel(const Params& p, int bid, int nblk, char* lds, int single = -1) {
    const int tid = otid(), lane = tid & 63, w = tid >> 6;
    float* wl = (float*)lds + w * 2304;
    for (int rowid_ = bid * 4 + w; rowid_ < (single >= 0 ? (bid * 4 + w) + 8 * nblk * 4 : T_); rowid_ += nblk * 4) {
        const int rowid = single >= 0 ? ((single & 7) * S_ + 32 * (63 - (single >> 3)) + ((rowid_ - (bid * 4 + w)) / (nblk * 4)) * 4 + w) : rowid_;
        const int b = rowid / S_, t = rowid % S_;
        unsigned word;
        if (t < 256) {
            const int lo = 32 * lane;
            word = (lo + 31 <= t) ? 0xffffffffu : (lo <= t ? ((1u << (t - lo + 1)) - 1u) : 0u);
        } else {
            const float* base = p.sc() + sc_row_off(b, t);
            const int rowlen = ((t >> 6) + 1) * 64;
#pragma unroll
            for (int i = 0; i < 8; ++i) {
                const int e = i * 256 + 4 * lane;
                if (e < rowlen) *(f32x4*)(wl + e + 4 * (e >> 5)) = *(const f32x4*)(base + e);
            }
            __builtin_amdgcn_s_waitcnt(0xc07f);
            unsigned u[32];
            if (32 * lane <= t) {
#pragma unroll
                for (int i = 0; i < 8; ++i) {
                    f32x4 v = *(const f32x4*)(wl + 36 * lane + 4 * i);
#pragma unroll
                    for (int j = 0; j < 4; ++j) {
                        unsigned bits = __float_as_uint(v[j]);
                        unsigned x = bits ^ ((bits >> 31) ? 0xffffffffu : 0x80000000u);
                        u[31 - (4 * i + j)] = (32 * lane + 4 * i + j <= t) ? x : 0u;
                    }
                }
            } else {
#pragma unroll
                for (int i = 0; i < 32; ++i) u[i] = 0u;
            }
            __builtin_amdgcn_s_waitcnt(0xc07f);
    { const unsigned t_ = (u[0] ^ (u[16] >> 16)) & 0x0000ffffu; u[0] ^= t_; u[16] ^= (t_ << 16); }
    { const unsigned t_ = (u[1] ^ (u[17] >> 16)) & 0x0000ffffu; u[1] ^= t_; u[17] ^= (t_ << 16); }
    { const unsigned t_ = (u[2] ^ (u[18] >> 16)) & 0x0000ffffu; u[2] ^= t_; u[18] ^= (t_ << 16); }
    { const unsigned t_ = (u[3] ^ (u[19] >> 16)) & 0x0000ffffu; u[3] ^= t_; u[19] ^= (t_ << 16); }
    { const unsigned t_ = (u[4] ^ (u[20] >> 16)) & 0x0000ffffu; u[4] ^= t_; u[20] ^= (t_ << 16); }
    { const unsigned t_ = (u[5] ^ (u[21] >> 16)) & 0x0000ffffu; u[5] ^= t_; u[21] ^= (t_ << 16); }
    { const unsigned t_ = (u[6] ^ (u[22] >> 16)) & 0x0000ffffu; u[6] ^= t_; u[22] ^= (t_ << 16); }
    { const unsigned t_ = (u[7] ^ (u[23] >> 16)) & 0x0000ffffu; u[7] ^= t_; u[23] ^= (t_ << 16); }
    { const unsigned t_ = (u[8] ^ (u[24] >> 16)) & 0x0000ffffu; u[8] ^= t_; u[24] ^= (t_ << 16); }
    { const unsigned t_ = (u[9] ^ (u[25] >> 16)) & 0x0000ffffu; u[9] ^= t_; u[25] ^= (t_ << 16); }
    { const unsigned t_ = (u[10] ^ (u[26] >> 16)) & 0x0000ffffu; u[10] ^= t_; u[26] ^= (t_ << 16); }
    { const unsigned t_ = (u[11] ^ (u[27] >> 16)) & 0x0000ffffu; u[11] ^= t_; u[27] ^= (t_ << 16); }
    { const unsigned t_ = (u[12] ^ (u[28] >> 16)) & 0x0000ffffu; u[12] ^= t_; u[28] ^= (t_ << 16); }
    { const unsigned t_ = (u[13] ^ (u[29] >> 16)) & 0x0000ffffu; u[13] ^= t_; u[29] ^= (t_ << 16); }
    { const unsigned t_ = (u[14] ^ (u[30] >> 16)) & 0x0000ffffu; u[14] ^= t_; u[30] ^= (t_ << 16); }
    { const unsigned t_ = (u[15] ^ (u[31] >> 16)) & 0x0000ffffu; u[15] ^= t_; u[31] ^= (t_ << 16); }
    { const unsigned t_ = (u[0] ^ (u[8] >> 8)) & 0x00ff00ffu; u[0] ^= t_; u[8] ^= (t_ << 8); }
    { const unsigned t_ = (u[1] ^ (u[9] >> 8)) & 0x00ff00ffu; u[1] ^= t_; u[9] ^= (t_ << 8); }
    { const unsigned t_ = (u[2] ^ (u[10] >> 8)) & 0x00ff00ffu; u[2] ^= t_; u[10] ^= (t_ << 8); }
    { const unsigned t_ = (u[3] ^ (u[11] >> 8)) & 0x00ff00ffu; u[3] ^= t_; u[11] ^= (t_ << 8); }
    { const unsigned t_ = (u[4] ^ (u[12] >> 8)) & 0x00ff00ffu; u[4] ^= t_; u[12] ^= (t_ << 8); }
    { const unsigned t_ = (u[5] ^ (u[13] >> 8)) & 0x00ff00ffu; u[5] ^= t_; u[13] ^= (t_ << 8); }
    { const unsigned t_ = (u[6] ^ (u[14] >> 8)) & 0x00ff00ffu; u[6] ^= t_; u[14] ^= (t_ << 8); }
    { const unsigned t_ = (u[7] ^ (u[15] >> 8)) & 0x00ff00ffu; u[7] ^= t_; u[15] ^= (t_ << 8); }
    { const unsigned t_ = (u[16] ^ (u[24] >> 8)) & 0x00ff00ffu; u[16] ^= t_; u[24] ^= (t_ << 8); }
    { const unsigned t_ = (u[17] ^ (u[25] >> 8)) & 0x00ff00ffu; u[17] ^= t_; u[25] ^= (t_ << 8); }
    { const unsigned t_ = (u[18] ^ (u[26] >> 8)) & 0x00ff00ffu; u[18] ^= t_; u[26] ^= (t_ << 8); }
    { const unsigned t_ = (u[19] ^ (u[27] >> 8)) & 0x00ff00ffu; u[19] ^= t_; u[27] ^= (t_ << 8); }
    { const unsigned t_ = (u[20] ^ (u[28] >> 8)) & 0x00ff00ffu; u[20] ^= t_; u[28] ^= (t_ << 8); }
    { const unsigned t_ = (u[21] ^ (u[29] >> 8)) & 0x00ff00ffu; u[21] ^= t_; u[29] ^= (t_ << 8); }
    { const unsigned t_ = (u[22] ^ (u[30] >> 8)) & 0x00ff00ffu; u[22] ^= t_; u[30] ^= (t_ << 8); }
    { const unsigned t_ = (u[23] ^ (u[31] >> 8)) & 0x00ff00ffu; u[23] ^= t_; u[31] ^= (t_ << 8); }
    { const unsigned t_ = (u[0] ^ (u[4] >> 4)) & 0x0f0f0f0fu; u[0] ^= t_; u[4] ^= (t_ << 4); }
    { const unsigned t_ = (u[1] ^ (u[5] >> 4)) & 0x0f0f0f0fu; u[1] ^= t_; u[5] ^= (t_ << 4); }
    { const unsigned t_ = (u[2] ^ (u[6] >> 4)) & 0x0f0f0f0fu; u[2] ^= t_; u[6] ^= (t_ << 4); }
    { const unsigned t_ = (u[3] ^ (u[7] >> 4)) & 0x0f0f0f0fu; u[3] ^= t_; u[7] ^= (t_ << 4); }
    { const unsigned t_ = (u[8] ^ (u[12] >> 4)) & 0x0f0f0f0fu; u[8] ^= t_; u[12] ^= (t_ << 4); }
    { const unsigned t_ = (u[9] ^ (u[13] >> 4)) & 0x0f0f0f0fu; u[9] ^= t_; u[13] ^= (t_ << 4); }
    { const unsigned t_ = (u[10] ^ (u[14] >> 4)) & 0x0f0f0f0fu; u[10] ^= t_; u[14] ^= (t_ << 4); }
    { const unsigned t_ = (u[11] ^ (u[15] >> 4)) & 0x0f0f0f0fu; u[11] ^= t_; u[15] ^= (t_ << 4); }
    { const unsigned t_ = (u[16] ^ (u[20] >> 4)) & 0x0f0f0f0fu; u[16] ^= t_; u[20] ^= (t_ << 4); }
    { const unsigned t_ = (u[17] ^ (u[21] >> 4)) & 0x0f0f0f0fu; u[17] ^= t_; u[21] ^= (t_ << 4); }
    { const unsigned t_ = (u[18] ^ (u[22] >> 4)) & 0x0f0f0f0fu; u[18] ^= t_; u[22] ^= (t_ << 4); }
    { const unsigned t_ = (u[19] ^ (u[23] >> 4)) & 0x0f0f0f0fu; u[19] ^= t_; u[23] ^= (t_ << 4); }
    { const unsigned t_ = (u[24] ^ (u[28] >> 4)) & 0x0f0f0f0fu; u[24] ^= t_; u[28] ^= (t_ << 4); }
    { const unsigned t_ = (u[25] ^ (u[29] >> 4)) & 0x0f0f0f0fu; u[25] ^= t_; u[29] ^= (t_ << 4); }
    { const unsigned t_ = (u[26] ^ (u[30] >> 4)) & 0x0f0f0f0fu; u[26] ^= t_; u[30] ^= (t_ << 4); }
    { const unsigned t_ = (u[27] ^ (u[31] >> 4)) & 0x0f0f0f0fu; u[27] ^= t_; u[31] ^= (t_ << 4); }
    { const unsigned t_ = (u[0] ^ (u[2] >> 2)) & 0x33333333u; u[0] ^= t_; u[2] ^= (t_ << 2); }
    { const unsigned t_ = (u[1] ^ (u[3] >> 2)) & 0x33333333u; u[1] ^= t_; u[3] ^= (t_ << 2); }
    { const unsigned t_ = (u[4] ^ (u[6] >> 2)) & 0x33333333u; u[4] ^= t_; u[6] ^= (t_ << 2); }
    { const unsigned t_ = (u[5] ^ (u[7] >> 2)) & 0x33333333u; u[5] ^= t_; u[7] ^= (t_ << 2); }
    { const unsigned t_ = (u[8] ^ (u[10] >> 2)) & 0x33333333u; u[8] ^= t_; u[10] ^= (t_ << 2); }
    { const unsigned t_ = (u[9] ^ (u[11] >> 2)) & 0x33333333u; u[9] ^= t_; u[11] ^= (t_ << 2); }
    { const unsigned t_ = (u[12] ^ (u[14] >> 2)) & 0x33333333u; u[12] ^= t_; u[14] ^= (t_ << 2); }
    { const unsigned t_ = (u[13] ^ (u[15] >> 2)) & 0x33333333u; u[13] ^= t_; u[15] ^= (t_ << 2); }
    { const unsigned t_ = (u[16] ^ (u[18] >> 2)) & 0x33333333u; u[16] ^= t_; u[18] ^= (t_ << 2); }
    { const unsigned t_ = (u[17] ^ (u[19] >> 2)) & 0x33333333u; u[17] ^= t_; u[19] ^= (t_ << 2); }
    { const unsigned t_ = (u[20] ^ (u[22] >> 2)) & 0x33333333u; u[20] ^= t_; u[22] ^= (t_ << 2); }
    { const unsigned t_ = (u[21] ^ (u[23] >> 2)) & 0x33333333u; u[21] ^= t_; u[23] ^= (t_ << 2); }
    { const unsigned t_ = (u[24] ^ (u[26] >> 2)) & 0x33333333u; u[24] ^= t_; u[26] ^= (t_ << 2); }
    { const unsigned t_ = (u[25] ^ (u[27] >> 2)) & 0x33333333u; u[25] ^= t_; u[27] ^= (t_ << 2); }
    { const unsigned t_ = (u[28] ^ (u[30] >> 2)) & 0x33333333u; u[28] ^= t_; u[30] ^= (t_ << 2); }
    { const unsigned t_ = (u[29] ^ (u[31] >> 2)) & 0x33333333u; u[29] ^= t_; u[31] ^= (t_ << 2); }
    { const unsigned t_ = (u[0] ^ (u[1] >> 1)) & 0x55555555u; u[0] ^= t_; u[1] ^= (t_ << 1); }
    { const unsigned t_ = (u[2] ^ (u[3] >> 1)) & 0x55555555u; u[2] ^= t_; u[3] ^= (t_ << 1); }
    { const unsigned t_ = (u[4] ^ (u[5] >> 1)) & 0x55555555u; u[4] ^= t_; u[5] ^= (t_ << 1); }
    { const unsigned t_ = (u[6] ^ (u[7] >> 1)) & 0x55555555u; u[6] ^= t_; u[7] ^= (t_ << 1); }
    { const unsigned t_ = (u[8] ^ (u[9] >> 1)) & 0x55555555u; u[8] ^= t_; u[9] ^= (t_ << 1); }
    { const unsigned t_ = (u[10] ^ (u[11] >> 1)) & 0x55555555u; u[10] ^= t_; u[11] ^= (t_ << 1); }
    { const unsigned t_ = (u[12] ^ (u[13] >> 1)) & 0x55555555u; u[12] ^= t_; u[13] ^= (t_ << 1); }
    { const unsigned t_ = (u[14] ^ (u[15] >> 1)) & 0x55555555u; u[14] ^= t_; u[15] ^= (t_ << 1); }
    { const unsigned t_ = (u[16] ^ (u[17] >> 1)) & 0x55555555u; u[16] ^= t_; u[17] ^= (t_ << 1); }
    { const unsigned t_ = (u[18] ^ (u[19] >> 1)) & 0x55555555u; u[18] ^= t_; u[19] ^= (t_ << 1); }
    { const unsigned t_ = (u[20] ^ (u[21] >> 1)) & 0x55555555u; u[20] ^= t_; u[21] ^= (t_ << 1); }
    { const unsigned t_ = (u[22] ^ (u[23] >> 1)) & 0x55555555u; u[22] ^= t_; u[23] ^= (t_ << 1); }
    { const unsigned t_ = (u[24] ^ (u[25] >> 1)) & 0x55555555u; u[24] ^= t_; u[25] ^= (t_ << 1); }
    { const unsigned t_ = (u[26] ^ (u[27] >> 1)) & 0x55555555u; u[26] ^= t_; u[27] ^= (t_ << 1); }
    { const unsigned t_ = (u[28] ^ (u[29] >> 1)) & 0x55555555u; u[28] ^= t_; u[29] ^= (t_ << 1); }
    { const unsigned t_ = (u[30] ^ (u[31] >> 1)) & 0x55555555u; u[30] ^= t_; u[31] ^= (t_ << 1); }
            unsigned gtm = 0u, eqm = 0xffffffffu; int cgt = 0; bool exact = false;
#pragma unroll
            for (int bit = 31; bit >= 0; --bit) {
                if (!exact) {
                    const unsigned m1 = eqm & u[31 - bit];
                    const int c = cgt + wave_sum_i(__builtin_popcount(m1));
                    if (c >= 256) { eqm = m1; if (c == 256) { exact = true; gtm |= m1; eqm = 0u; } }
                    else { gtm |= m1; eqm &= ~u[31 - bit]; cgt = c; }
                }
            }
            const unsigned gt = gtm, eq = eqm;
            unsigned take = 0u;
            if (!exact) {
                const int need = 256 - cgt;
                const int e = __builtin_popcount(eq);
                int inc = e;
#pragma unroll
                for (int o_ = 1; o_ < 64; o_ <<= 1) { int tt = __shfl_up(inc, o_); if (lane >= o_) inc += tt; }
                int k = need - (inc - e); if (k > e) k = e;
                unsigned x = eq;
                while (k > 0) { unsigned low = x & (0u - x); take |= low; x ^= low; --k; }
            }
            word = gt | take;
        }
        p.dmask()[(long)rowid * 64 + lane] = word;
    }
}
#define HSTR 528
__device__ __forceinline__ float gelu_tanh_f(float x) {
    const float u = 0.7978845608028654f * (x + 0.044715f * x * x * x);
    const float e = __expf(2.f * u);
    const float th = 1.f - 2.f / (e + 1.f);
    return 0.5f * x * (1.f + th);
}
#define CSTG 18432
__device__ __forceinline__ void phase_compress(const Params& p, int l, int bid, int nblk, char* lds, int single = -1) {
    const int tid = otid(), lane = tid & 63, w = tid >> 6, r32 = lane & 31, hi = lane >> 5;
    const unsigned lds0 = (unsigned)(uintptr_t)lds;
    for (int unit_ = bid; unit_ < (single >= 0 ? bid + 1 : 64); unit_ += nblk) {
        const int unit = single >= 0 ? single : unit_;
        const int kv = unit & 1, rt = unit >> 1;
        const bf16_t* src = kv ? p.vcmp() : p.kcmp();
        const bf16_t* Bt = p.W1t() + (long)(l * 2 + kv) * 256 * 2048;
        const int lrow = lane >> 2, lch = ((lane & 3) ^ ((lane >> 4) & 3)) * 8;
        const bf16_t* ap = nullptr;
        if (w < 2) { int R = rt * 32 + 16 * w + lrow; if (R > 1015) R = 1015; const int b = R / NCMP, c = R % NCMP; ap = src + ((long)b * S_ + 16 * c) * 64 + lch; }
        const bf16_t* bp[4];
#pragma unroll
        for (int i = 0; i < 4; ++i) bp[i] = Bt + (long)(64 * w + 16 * i + lrow) * 2048 + lch;
        auto issue = [&](int s_, int stg) {
            const unsigned base = lds0 + stg * CSTG;
            if (w < 2) glds16(ap + s_ * 32, (unsigned)__builtin_amdgcn_readfirstlane(base + (16 * w) * 64));
#pragma unroll
            for (int i = 0; i < 4; ++i) glds16(bp[i] + s_ * 32, (unsigned)__builtin_amdgcn_readfirstlane(base + 2048 + (64 * w + 16 * i) * 64));
        };
        f32x16 acc[2];
#pragma unroll
        for (int r = 0; r < 16; ++r) { acc[0][r] = 0.f; acc[1][r] = 0.f; }
        const int n = 2048 / 32;
        issue(0, 0); issue(1, 1);
        const int key = (r32 >> 2) & 3;
        int stg = 0;
        for (int s_ = 0; s_ < n; ++s_) {
            if (s_ + 1 < n) { if (w < 2) asm volatile("s_waitcnt vmcnt(5) lgkmcnt(0)\n\ts_barrier" ::: "memory"); else asm volatile("s_waitcnt vmcnt(4) lgkmcnt(0)\n\ts_barrier" ::: "memory"); }
            else asm volatile("s_waitcnt vmcnt(0) lgkmcnt(0)\n\ts_barrier" ::: "memory");
            if (s_ + 2 < n) { int st2 = stg + 2; if (st2 >= 3) st2 -= 3; issue(s_ + 2, st2); }
            const char* bufA = lds + stg * CSTG; const char* bufB = bufA + 2048;
#pragma unroll
            for (int ks = 0; ks < 2; ++ks) {
                const int coff = (((ks * 2 + hi) ^ key) * 16);
                const bf16x8 af = *(const bf16x8*)(bufA + r32 * 64 + coff);
#pragma unroll
                for (int ni = 0; ni < 2; ++ni) acc[ni] = MFMA32(*(const bf16x8*)(bufB + (w * 64 + ni * 32 + r32) * 64 + coff), af, acc[ni]);
            }
            if (++stg == 3) stg = 0;
        }
        __syncthreads();
        const float* peb = p.peb() + (l * 2 + kv) * 256;
#pragma unroll
        for (int ni = 0; ni < 2; ++ni)
#pragma unroll
            for (int rg = 0; rg < 4; ++rg) {
                const int nn = w * 64 + ni * 32 + 8 * rg + 4 * hi;
                const f32x4 bv = *(const f32x4*)(peb + nn);
                u32x2 v;
                v.x = cvtpk(gelu_tanh_f(acc[ni][rg * 4 + 0] + bv[0]), gelu_tanh_f(acc[ni][rg * 4 + 1] + bv[1]));
                v.y = cvtpk(gelu_tanh_f(acc[ni][rg * 4 + 2] + bv[2]), gelu_tanh_f(acc[ni][rg * 4 + 3] + bv[3]));
                *(u32x2*)(lds + r32 * HSTR + nn * 2) = v;
            }
        __syncthreads();
        if (w < 2) {
            const int ni2 = w;
            const bf16_t* W2 = p.W2t() + (long)(l * 2 + kv) * 64 * 256 + (long)(ni2 * 32 + r32) * 256 + hi * 8;
            f32x16 a2;
#pragma unroll
            for (int r = 0; r < 16; ++r) a2[r] = 0.f;
#pragma unroll
            for (int ks = 0; ks < 16; ++ks) {
                const bf16x8 bf = *(const bf16x8*)(W2 + ks * 16);
                const bf16x8 af = *(const bf16x8*)(lds + r32 * HSTR + ks * 32 + hi * 16);
                a2 = MFMA32(bf, af, a2);
            }
            const int R = rt * 32 + r32;
            if (R < 1016) {
                const int b = R / NCMP, c = R % NCMP;
                if (kv == 0) {
#pragma unroll
                    for (int rg = 0; rg < 4; ++rg) st4(p.kcb() + ((long)b * 128 + c) * 64 + ni2 * 32 + 8 * rg + 4 * hi, a2[rg * 4 + 0], a2[rg * 4 + 1], a2[rg * 4 + 2], a2[rg * 4 + 3]);
                } else {
#pragma unroll
                    for (int r = 0; r < 16; ++r) p.vcbT()[((long)b * 64 + ni2 * 32 + crow(r, hi)) * 128 + vtpos(c)] = f2bf(a2[r]);
                }
            }
        }
        __syncthreads();
    }
}
__device__ __forceinline__ void phase_cmp(const Params& p, int bid, int nblk, char* lds, int single = -1) {
    const int tid = otid(), lane = tid & 63, w = tid >> 6, r32 = lane & 31, hi = lane >> 5;
    float* slab = (float*)(lds + 40960);
    for (int unit_ = bid; unit_ < (single >= 0 ? bid + 1 : B_ * 64); unit_ += nblk) {
        const int unit = single >= 0 ? single : unit_;
        const int qb = unit & 63, b = unit >> 6;
        const int h = w, q0 = qb * 32;
        AttnDesc u{};
        const int t = q0 + r32; const long row = (long)b * S_ + t;
        u.q = p.qa() + row * 256 + h * 64;
        u.k = p.kcb() + (long)b * 128 * 64; u.ldk = 64;
        u.vt = p.vcbT() + (long)b * 64 * 128; u.ldvt = 128;
        int lim = (t - 31) >> 4; if (lim > 126) lim = 126;
        int maxlim = (q0 + 31 - 31) >> 4; if (maxlim > 126) maxlim = 126;
        u.kt_lo = 0; u.kt_hi = (maxlim >= 64) ? 1 : 0; u.wkt_lo = 0; u.wkt_hi = u.kt_hi;
        u.tq = lim;
        f32x16 o[2]; float m, lsum;
        attn_core<A_CMP>(u, o, m, lsum, lds);
        const float inv = (lsum > 0.f) ? 1.f / lsum : 0.f;
        {
            const float sc = p.ga()[row * 12 + h * 3 + 0] * inv;
            float* dst = p.ocmp() + row * 256 + h * 64;
#pragma unroll
            for (int dh = 0; dh < 2; ++dh)
#pragma unroll
                for (int rg = 0; rg < 4; ++rg) {
                    f32x4 v = {o[dh][rg * 4 + 0] * sc, o[dh][rg * 4 + 1] * sc, o[dh][rg * 4 + 2] * sc, o[dh][rg * 4 + 3] * sc};
                    *(f32x4*)(dst + dh * 32 + 8 * rg + 4 * hi) = v;
                }
        }
        {
            const int lrow = tid >> 3, lch = tid & 7;
#pragma unroll
            for (int i = 0; i < 4; ++i) *(u32x4*)(lds + (lrow + 32 * i) * TSTR + lch * 16) = *(const u32x4*)(u.k + (long)(lrow + 32 * i) * 64 + lch * 8);
        }
        __syncthreads();
        bf16x8 qf[4];
#pragma unroll
        for (int ds = 0; ds < 4; ++ds) qf[ds] = *(const bf16x8*)(u.q + ds * 16 + hi * 8);
        float G[16], Lst[16];
#pragma unroll
        for (int s4 = 0; s4 < 4; ++s4) {
            f32x16 sa;
#pragma unroll
            for (int r = 0; r < 16; ++r) sa[r] = 0.f;
#pragma unroll
            for (int ds = 0; ds < 4; ++ds) sa = MFMA32(*(const bf16x8*)(lds + (32 * s4 + r32) * TSTR + ds * 32 + hi * 16), qf[ds], sa);
#pragma unroll
            for (int rg = 0; rg < 4; ++rg) {
                float g = 0.f, last = 0.f;
#pragma unroll
                for (int j = 0; j < 4; ++j) {
                    const int c = 32 * s4 + 8 * rg + 4 * hi + j;
                    const float pn = (c <= lim) ? __builtin_amdgcn_exp2f(sa[rg * 4 + j] - m) * inv : 0.f;
                    g += pn; last = pn;
                }
                G[s4 * 4 + rg] = g; Lst[s4 * 4 + rg] = last;
            }
        }
        float* myslab = slab + (h * 32 + r32) * 33;
#pragma unroll
        for (int i = 0; i < 16; ++i) { const int jj = 8 * (i >> 2) + 2 * (i & 3) + hi; myslab[jj] = G[i]; }
        __builtin_amdgcn_s_waitcnt(0xc07f);
#pragma unroll
        for (int i = 0; i < 16; ++i) { const int jj = 8 * (i >> 2) + 2 * (i & 3) + hi; if (jj + 1 < 32) atomicAdd(&myslab[jj + 1], Lst[i]); }
        __syncthreads();
        {
            const int j = lane & 31, half = lane >> 5;
#pragma unroll
            for (int i = 0; i < 4; ++i) {
                const int q = w * 8 + i * 2 + half; const int tt = q0 + q; const int cur = tt >> 6;
                float a = slab[(0 * 32 + q) * 33 + j] + slab[(1 * 32 + q) * 33 + j] + slab[(2 * 32 + q) * 33 + j] + slab[(3 * 32 + q) * 33 + j];
                if (j == 0 || j == cur || j == cur - 1) a = 1e4f;
                if (j > cur) a = -1e4f;
                int rank = 0;
#pragma unroll
                for (int j2 = 0; j2 < 32; ++j2) { const float uu = __shfl(a, j2 + 32 * half); rank += ((uu > a) || (uu == a && j2 < j)) ? 1 : 0; }
                const unsigned long long bal = __ballot(rank < 16);
                if (j == 0) p.selmask()[(long)b * S_ + tt] = (unsigned)(bal >> (32 * half));
            }
        }
        __syncthreads();
    }
}

__device__ __forceinline__ void phase_merge(const Params& p, int l, int bid, int nblk, char* lds) {
    const int tid = otid(), lane = tid & 63, w = tid >> 6, r32 = lane & 31, hi = lane >> 5;
    const int wm = w & 1, wn = w >> 1;
    for (int it = 0;; ++it) {
        int tm, tn; bool done;
        if (!raster_tile(it, bid, nblk, T_ / 128, 8, tm, tn, done)) { if (done) break; continue; }
        const int m0 = tm * 128, n0 = tn * 128;
        f32x16 acc[2][2], tot[2][2];
#pragma unroll
        for (int a = 0; a < 2; ++a)
#pragma unroll
            for (int b2 = 0; b2 < 2; ++b2)
#pragma unroll
                for (int r = 0; r < 16; ++r) { acc[a][b2][r] = 0.f; tot[a][b2][r] = 0.f; }
        const bf16_t* A = p.o() + (long)m0 * 32;
        const bf16_t* Bt = p.Wbt() + (long)l * 1024 * 1024 + (long)n0 * 32;
        u32x4 gq[2][2][2];
        auto loadg = [&](int i) {
#pragma unroll
            for (int mi = 0; mi < 2; ++mi)
#pragma unroll
                for (int ni = 0; ni < 2; ++ni) {
                    const long blk = (long)(((m0 + wm * 64) >> 5) + mi) * 128 + ((i * 1024 + n0 + wn * 64) >> 5) + ni;
                    const bf16_t* gp = p.gates() + blk * 1024 + lane * 8;
                    gq[mi][ni][0] = *(const u32x4*)gp; gq[mi][ni][1] = *(const u32x4*)(gp + 512);
                }
        };
        loadg(0);
        auto hook = [&](int kt) {
            if ((kt & 7) == 7) {
                const int i = kt >> 3;
#pragma unroll
                for (int mi = 0; mi < 2; ++mi) {
#pragma unroll
                    for (int ni = 0; ni < 2; ++ni) {
#pragma unroll
                        for (int hf = 0; hf < 2; ++hf) {
                            const u32x4 gv = gq[mi][ni][hf];
#pragma unroll
                            for (int j = 0; j < 4; ++j) {
                                tot[ni][mi][hf * 8 + 2 * j] += acc[ni][mi][hf * 8 + 2 * j] * __uint_as_float(gv[j] << 16);
                                tot[ni][mi][hf * 8 + 2 * j + 1] += acc[ni][mi][hf * 8 + 2 * j + 1] * __uint_as_float(gv[j] & 0xffff0000u);
                                acc[ni][mi][hf * 8 + 2 * j] = 0.f; acc[ni][mi][hf * 8 + 2 * j + 1] = 0.f;
                            }
                        }
                    }
                }
                if (i + 1 < 4) loadg(i + 1);
            }
        };
        gemm_mid(acc, A, [&](int r) { return r * 32; }, Bt, [&](int r) { return r * 32; }, 1024, lds, (long)T_ * 32, (long)1024 * 32, hook);
#pragma unroll
        for (int mi = 0; mi < 2; ++mi) {
            const long mrow = m0 + wm * 64 + mi * 32 + r32;
#pragma unroll
            for (int ni = 0; ni < 2; ++ni) {
                bf16_t* dst = p.merged() + ((long)((n0 + wn * 64 + ni * 32) >> 5) * T_ + mrow) * 32 + 4 * hi;
#pragma unroll
                for (int rg = 0; rg < 4; ++rg) st4(dst + 8 * rg, tot[ni][mi][rg * 4 + 0], tot[ni][mi][rg * 4 + 1], tot[ni][mi][rg * 4 + 2], tot[ni][mi][rg * 4 + 3]);
            }
        }
    }
}
__device__ __forceinline__ void phase_outproj(const Params& p, int l, int bid, int nblk, char* lds) {
    const int tid = otid(), lane = tid & 63, w = tid >> 6, r32 = lane & 31, hi = lane >> 5;
    const int wm = w & 1, wn = w >> 1;
    for (int it = 0;; ++it) {
        int tm, tn; bool done;
        if (!raster_tile(it, bid, nblk, T_ / 256, 8, tm, tn, done)) { if (done) break; continue; }
        const int m0 = tm * 256, n0 = tn * 128;
        f32x16 accb[2][2][2];
#pragma unroll
        for (int c = 0; c < 2; ++c)
#pragma unroll
            for (int a = 0; a < 2; ++a)
#pragma unroll
                for (int b2 = 0; b2 < 2; ++b2)
#pragma unroll
                    for (int r = 0; r < 16; ++r) accb[c][a][b2][r] = 0.f;
        const bf16_t* A = p.merged() + (long)m0 * 32;
        const bf16_t* Bt = p.Wot() + (long)l * 1024 * 1024 + (long)n0 * 32;
        gemm_big_issue01(A, 32, Bt, 32, lds, (long)T_ * 32, (long)1024 * 32);
        gemm_big(accb, A, 32, Bt, 32, 1024, lds, (long)T_ * 32, (long)1024 * 32);
#pragma unroll
        for (int mh = 0; mh < 2; ++mh)
#pragma unroll
            for (int mi = 0; mi < 2; ++mi) {
                const long eo = (long)(m0 + wm * 128 + mh * 64 + mi * 32 + r32) * D_ + n0 + wn * 64 + 4 * hi;
                float* dst = p.h() + eo;
                const float* rsrc = (l == 0 ? p.x : (const float*)p.h()) + eo;
#pragma unroll
                for (int ni = 0; ni < 2; ++ni)
#pragma unroll
                    for (int rg = 0; rg < 4; ++rg) {
                        f32x4 v = *(const f32x4*)(rsrc + ni * 32 + 8 * rg);
                        v[0] += accb[mh][ni][mi][rg * 4 + 0]; v[1] += accb[mh][ni][mi][rg * 4 + 1]; v[2] += accb[mh][ni][mi][rg * 4 + 2]; v[3] += accb[mh][ni][mi][rg * 4 + 3];
                        *(f32x4*)(dst + ni * 32 + 8 * rg) = v;
                    }
            }
    }
}
__device__ __forceinline__ void phase_router(const Params& p, int l, int bid, int nblk, char* lds) {
    const int tid = otid(), lane = tid & 63, w = tid >> 6;
    const int ti = lane & 15, kq = lane >> 4;
    const int kh = w & 1, tw = w >> 1;
    float* xch = (float*)lds + tw * (21 * 64);
    char* xsv = lds + 10752 + w * 16384;
    float* lgw = (float*)xsv;
    const float* Wr = p.Wrt() + (long)l * 80 * 1024;
    const bool baff = (nblk == 512);
    for (int task_ = bid * 2; task_ < T_ / 16; task_ += nblk * 2) {
        const int task = baff ? ((bid & 7) * 128 + (bid >> 3) * 2 + tw) : (task_ + tw);
        const int t0 = task * 16;
        const float* xr = p.h() + (long)(t0 + ti) * D_ + 4 * kq + kh * 512;
        f32x4 acc[5];
#pragma unroll
        for (int nt = 0; nt < 5; ++nt) acc[nt] = (f32x4){0.f, 0.f, 0.f, 0.f};
        float ss = 0.f;
        const float* xr8 = p.h() + (long)(t0 + ti) * D_ + 8 * kq + kh * 512;
        const bf16_t* whp = (const bf16_t*)p.Wrt() + (long)l * 80 * 1024 + (long)ti * 1024 + kh * 512 + 8 * kq;
        const bf16_t* wlp = whp + 2 * 80 * 1024;
        typedef f32x4 f4_;
        f4_ xa[4][2]; bf16x8 wh_[3][5], wl_[3][5];
#define RT_LOADX(slot, c) do { xa[slot][0] = *(const f4_*)(xr8 + (c) * 32); xa[slot][1] = *(const f4_*)(xr8 + (c) * 32 + 4); } while (0)
#define RT_LOADW(set, c) do { \
            _Pragma("unroll") for (int nt = 0; nt < 5; ++nt) { wh_[set][nt] = *(const bf16x8*)(whp + (long)nt * 16 * 1024 + (c) * 32); wl_[set][nt] = *(const bf16x8*)(wlp + (long)nt * 16 * 1024 + (c) * 32); } } while (0)
#define RT_MMA(set, slot, cidx) do { \
            float xv[8] = {xa[slot][0][0], xa[slot][0][1], xa[slot][0][2], xa[slot][0][3], xa[slot][1][0], xa[slot][1][1], xa[slot][1][2], xa[slot][1][3]}; \
            if ((cidx) + 4 < 16) RT_LOADX(slot, (cidx) + 4); \
            u32x4 ph, pl; \
            _Pragma("unroll") for (int j = 0; j < 4; ++j) { \
                ss += xv[2 * j] * xv[2 * j] + xv[2 * j + 1] * xv[2 * j + 1]; \
                const unsigned hw = cvtpk(xv[2 * j], xv[2 * j + 1]); ph[j] = hw; \
                pl[j] = cvtpk(xv[2 * j] - __uint_as_float(hw << 16), xv[2 * j + 1] - __uint_as_float(hw & 0xffff0000u)); } \
            *(u32x4*)(xsv + (cidx) * 1024 + lane * 16) = ph; \
            const bf16x8 xh = __builtin_bit_cast(bf16x8, ph), xl = __builtin_bit_cast(bf16x8, pl); \
            _Pragma("unroll") for (int nt = 0; nt < 5; ++nt) acc[nt] = __builtin_amdgcn_mfma_f32_16x16x32_bf16(xh, wh_[set][nt], acc[nt], 0, 0, 0); \
            _Pragma("unroll") for (int nt = 0; nt < 5; ++nt) acc[nt] = __builtin_amdgcn_mfma_f32_16x16x32_bf16(xh, wl_[set][nt], acc[nt], 0, 0, 0); \
            _Pragma("unroll") for (int nt = 0; nt < 5; ++nt) acc[nt] = __builtin_amdgcn_mfma_f32_16x16x32_bf16(xl, wh_[set][nt], acc[nt], 0, 0, 0); } while (0)
        RT_LOADX(0, 0); RT_LOADX(1, 1); RT_LOADX(2, 2); RT_LOADX(3, 3);
        RT_LOADW(0, 0); RT_LOADW(1, 1);
        RT_LOADW(2, 2); RT_MMA(0, 0, 0);
        RT_LOADW(0, 3); RT_MMA(1, 1, 1);
        RT_LOADW(1, 4); RT_MMA(2, 2, 2);
        RT_LOADW(2, 5); RT_MMA(0, 3, 3);
        RT_LOADW(0, 6); RT_MMA(1, 0, 4);
        RT_LOADW(1, 7); RT_MMA(2, 1, 5);
        RT_LOADW(2, 8); RT_MMA(0, 2, 6);
        RT_LOADW(0, 9); RT_MMA(1, 3, 7);
        RT_LOADW(1, 10); RT_MMA(2, 0, 8);
        RT_LOADW(2, 11); RT_MMA(0, 1, 9);
        RT_LOADW(0, 12); RT_MMA(1, 2, 10);
        RT_LOADW(1, 13); RT_MMA(2, 3, 11);
        RT_LOADW(2, 14); RT_MMA(0, 0, 12);
        RT_LOADW(0, 15); RT_MMA(1, 1, 13);
        RT_MMA(2, 2, 14);
        RT_MMA(0, 3, 15);
#undef RT_LOADX
#undef RT_LOADW
#undef RT_MMA
        ss += __shfl_xor(ss, 16); ss += __shfl_xor(ss, 32);
        __syncthreads();
        if (kh == 1) {
#pragma unroll
            for (int nt = 0; nt < 5; ++nt)
#pragma unroll
                for (int r = 0; r < 4; ++r) xch[(nt * 4 + r) * 64 + lane] = acc[nt][r];
            xch[20 * 64 + lane] = ss;
        }
        __syncthreads();
        float ss_other;
        if (kh == 0) {
#pragma unroll
            for (int nt = 0; nt < 5; ++nt)
#pragma unroll
                for (int r = 0; r < 4; ++r) acc[nt][r] += xch[(nt * 4 + r) * 64 + lane];
            ss_other = xch[20 * 64 + lane];
        }
        __syncthreads();
        if (kh == 0) xch[20 * 64 + lane] = ss;
        __syncthreads();
        if (kh == 1) ss_other = xch[20 * 64 + lane];
        ss += ss_other;
        const float rs = rsqrtf(ss / (float)D_ + 1e-6f);
#pragma unroll 4
        for (int c = 0; c < 16; ++c) {
            const float* gp = p.ffn_norm + l * D_ + kh * 512 + c * 32 + 8 * kq;
            const f32x4 g0 = *(const f32x4*)gp, g1 = *(const f32x4*)(gp + 4);
            const u32x4 xs = *(const u32x4*)(xsv + c * 1024 + lane * 16);
            u32x4 ov;
            ov.x = cvtpk(__uint_as_float(xs.x << 16) * rs * g0[0], __uint_as_float(xs.x & 0xffff0000u) * rs * g0[1]);
            ov.y = cvtpk(__uint_as_float(xs.y << 16) * rs * g0[2], __uint_as_float(xs.y & 0xffff0000u) * rs * g0[3]);
            ov.z = cvtpk(__uint_as_float(xs.z << 16) * rs * g1[0], __uint_as_float(xs.z & 0xffff0000u) * rs * g1[1]);
            ov.w = cvtpk(__uint_as_float(xs.w << 16) * rs * g1[2], __uint_as_float(xs.w & 0xffff0000u) * rs * g1[3]);
            *(u32x4*)(p.hn() + (long)(t0 + ti) * D_ + kh * 512 + c * 32 + 8 * kq) = ov;
        }
        if (kh == 0) {
#pragma unroll
        for (int reg = 0; reg < 4; ++reg) {
            const int tok = 4 * kq + reg;
            const float rst = __shfl(rs, tok);
#pragma unroll
            for (int nt = 0; nt < 5; ++nt) lgw[tok * 81 + nt * 16 + ti] = acc[nt][reg] * rst;
        }
        __builtin_amdgcn_s_waitcnt(0xc07f);
        if (lane < 16) {
            const float* lg = lgw + lane * 81;
            float g[8]; float mx = -1e30f; int gi = 0;
#pragma unroll
            for (int i = 0; i < 8; ++i) { g[i] = lg[i] + p.moe_b_group[l * 8 + i]; if (g[i] > mx) { mx = g[i]; gi = i; } }
            float den = 0.f;
#pragma unroll
            for (int i = 0; i < 8; ++i) den += expf(g[i] - mx);
            const float pg = 1.f / den;
            float v0 = -1e30f, v1 = -1e30f; int i0 = 0, i1 = 0;
            float ev[8];
#pragma unroll
            for (int i = 0; i < 8; ++i) ev[i] = lg[8 + gi * 8 + i] + p.moe_b_expert[l * 64 + gi * 8 + i];
#pragma unroll
            for (int i = 0; i < 8; ++i) { const float e = ev[i]; if (e > v0) { v1 = v0; i1 = i0; v0 = e; i0 = i; } else if (e > v1) { v1 = e; i1 = i; } }
            const float x = expf(v1 - v0);
            const float w0 = pg / (1.f + x), w1 = pg * x / (1.f + x);
            const int t = t0 + lane;
            const int e0 = gi * 8 + i0, e1 = gi * 8 + i1;
            unsigned* cnt = p.ecnt() + l * 64 * 64;
            const unsigned p0 = atomicAdd(&cnt[e0 * 64], 1u);
            const unsigned p1 = atomicAdd(&cnt[e1 * 64 + 32], 1u);
            p.elist()[(long)e0 * T_ + p0] = t * 2;
            p.elist()[(long)e1 * T_ + (T_ - 1 - p1)] = t * 2 + 1;
            p.slotw()[t * 2] = w0; p.slotw()[t * 2 + 1] = w1;
        }
        __builtin_amdgcn_s_waitcnt(0xc07f);
        }
    }
}
__device__ __forceinline__ int moe_tiles(const Params& p, int l, int* tstart  ) {
    int* texp = tstart + 384;
    __syncthreads();
    const int t = otid();
    if (t < 64) {
        const int nt = (int)((p.ecnt()[(l * 64 + t) * 64] + p.ecnt()[(l * 64 + t) * 64 + 32] + 127u) >> 7);
        int inc = nt;
#pragma unroll
        for (int o = 1; o < 64; o <<= 1) { const int v = __shfl_up(inc, o); if (t >= o) inc += v; }
        tstart[t] = inc - nt;
        if (t == 63) tstart[64] = inc;
        for (int i = inc - nt; i < inc; ++i) texp[i] = t;
        int* tlist = tstart + 384 + 328;
        const int par = t & 1;
        int incp = par ? (nt << 16) : nt;
#pragma unroll
        for (int o = 1; o < 64; o <<= 1) { const int v = __shfl_up(incp, o); if (t >= o) incp += v; }
        const int pre = (par ? (incp >> 16) : (incp & 0xffff)) - nt;
        for (int i = 0; i < nt; ++i) tlist[par * 328 + pre + i] = inc - nt + i;
        if (t == 63) { tstart[66] = incp & 0xffff; tstart[67] = incp >> 16; }
    }
    __syncthreads();
    return tstart[64];
}
__device__ __forceinline__ int moe_find(const int* tstart, int ti) { return tstart[384 + ti]; }
__device__ __forceinline__ void phase_moe_up(const Params& p, int l, int bid, int nblk, char* lds) {
    const int tid = otid(), lane = tid & 63, w = tid >> 6, r32 = lane & 31, hi = lane >> 5;
    const int wm = w & 1, wn = w >> 1;
    int* tstart = (int*)(lds + LDS_AUX + 512);
    const int ntl = moe_tiles(p, l, tstart);
    const int srow_ = 8 * w + (lane >> 3);
    auto fetch = [&](int unit, int& e, int& rt, int& cnt, int (&as)[4]) {
        const int ti = unit >> 2;
        e = moe_find(tstart, ti); rt = ti - tstart[e];
        const int cntA = (int)p.ecnt()[(l * 64 + e) * 64]; cnt = cntA + (int)p.ecnt()[(l * 64 + e) * 64 + 32];
        const int* lst = p.elist() + (long)e * T_;
#pragma unroll
        for (int i = 0; i < 4; ++i) { int rr = rt * 128 + 32 * i + srow_; if (rr >= cnt) rr = 0; as[i] = lst[rr < cntA ? rr : T_ - 1 - (rr - cntA)]; }
    };
    const int nt = bid & 3, par = (bid >> 2) & 1, qstep = nblk >> 3;
    const int* tlist = tstart + 384 + 328 + par * 328;
    const int nq = tstart[66 + par];
    (void)ntl;
    int e = 0, rt = 0, cnt = 0, aslot[4] = {0, 0, 0, 0};
    if ((bid >> 3) < nq) fetch(tlist[bid >> 3] * 4, e, rt, cnt, aslot);
    for (int q = bid >> 3; q < nq; q += qstep) {
        const int ti = tlist[q];
        int e2 = 0, rt2 = 0, cnt2 = 0, aslot2[4] = {0, 0, 0, 0};
        if (q + qstep < nq) fetch(tlist[q + qstep] * 4, e2, rt2, cnt2, aslot2);
        f32x16 acc[2][2];
#pragma unroll
        for (int a = 0; a < 2; ++a)
#pragma unroll
            for (int b2 = 0; b2 < 2; ++b2)
#pragma unroll
                for (int r = 0; r < 16; ++r) acc[a][b2][r] = 0.f;
        const float* wgate = p.moe_w_gate + ((long)l * 64 + e) * 1024 * 256;
        const float* wup = p.moe_w_up + ((long)l * 64 + e) * 1024 * 256;
        gemm_glds<BMODE_F32_KN>(acc,
            [&](int r) { const int i = r >> 5; const int sl_ = i == 0 ? aslot[0] : i == 1 ? aslot[1] : i == 2 ? aslot[2] : aslot[3]; return p.hn() + (long)(sl_ >> 1) * D_; },
            [&](int nb, int& ld) { ld = 256; const int col = nt * 64 + (nb >> 6) * 32 + (nb & 31); return ((nb & 32) ? wup : wgate) + col; },
            1024, lds);
#pragma unroll
        for (int mi = 0; mi < 2; ++mi) {
            bf16_t* dst = p.hid() + ((long)ti * 128 + wm * 64 + mi * 32 + r32) * 256 + nt * 64 + wn * 32 + 4 * hi;
#pragma unroll
            for (int rg = 0; rg < 4; ++rg) {
                float v[4];
#pragma unroll
                for (int j = 0; j < 4; ++j) { const float g = acc[0][mi][rg * 4 + j], uu = acc[1][mi][rg * 4 + j]; v[j] = g / (1.f + __expf(-g)) * uu; }
                st4(dst + 8 * rg, v[0], v[1], v[2], v[3]);
            }
        }
        e = e2; rt = rt2; cnt = cnt2;
#pragma unroll
        for (int i = 0; i < 4; ++i) aslot[i] = aslot2[i];
    }
}
__device__ __forceinline__ void phase_moe_down(const Params& p, int l, int bid, int nblk, char* lds) {
    const int tid = otid(), lane = tid & 63, w = tid >> 6, r32 = lane & 31, hi = lane >> 5;
    const int wm = w & 1, wn = w >> 1;
    int* tstart = (int*)(lds + LDS_AUX + 512);
    const int ntl = moe_tiles(p, l, tstart);
    for (int unit = bid; unit < ntl * 8; unit += nblk) {
        const int nt = unit & 7, ti = unit >> 3;
        const int e = moe_find(tstart, ti); const int rt = ti - tstart[e];
        const int cntA = (int)p.ecnt()[(l * 64 + e) * 64]; const int cnt = cntA + (int)p.ecnt()[(l * 64 + e) * 64 + 32];
        const int* lst = p.elist() + (long)e * T_;
        f32x16 acc[2][2];
#pragma unroll
        for (int a = 0; a < 2; ++a)
#pragma unroll
            for (int b2 = 0; b2 < 2; ++b2)
#pragma unroll
                for (int r = 0; r < 16; ++r) acc[a][b2][r] = 0.f;
        const bf16_t* A = p.hid() + (long)ti * 128 * 256;
        const float* wd = p.moe_w_down + ((long)l * 64 + e) * 256 * 1024 + nt * 128;
        int eslot[2]; float ewgt[2];
#pragma unroll
        for (int mi = 0; mi < 2; ++mi) {
            const int rr = rt * 128 + wm * 64 + mi * 32 + r32;
            eslot[mi] = (rr < cnt) ? lst[rr < cntA ? rr : T_ - 1 - (rr - cntA)] : 0; ewgt[mi] = p.slotw()[eslot[mi]];
        }
        gemm_glds<BMODE_F32_KN>(acc, [&](int r) { return A + (long)r * 256; }, [&](int nb, int& ld) { ld = 1024; return wd + nb; }, 256, lds);
#pragma unroll
        for (int mi = 0; mi < 2; ++mi) {
            const int rr = rt * 128 + wm * 64 + mi * 32 + r32;
            if (rr < cnt) {
                const int slot = eslot[mi]; const float wgt = ewgt[mi];
                bf16_t* dst = p.y() + (long)slot * D_ + nt * 128 + wn * 64 + 4 * hi;
#pragma unroll
                for (int ni = 0; ni < 2; ++ni)
#pragma unroll
                    for (int rg = 0; rg < 4; ++rg)
                        st4(dst + ni * 32 + 8 * rg, acc[ni][mi][rg * 4 + 0] * wgt, acc[ni][mi][rg * 4 + 1] * wgt, acc[ni][mi][rg * 4 + 2] * wgt, acc[ni][mi][rg * 4 + 3] * wgt);
            }
        }
    }
}
__device__ __forceinline__ void phase_combine(const Params& p, int lnext, int bid, int nblk) {
    const int tid = otid(), lane = tid & 63, w = tid >> 6;
    float* hb = p.h(); const bf16_t* yb = p.y(); bf16_t* hnb = p.hn();
    const bool baff = (nblk == 512);
    for (int row0_ = (bid * 4 + w) * 2; row0_ < T_; row0_ += nblk * 8) {
        const int row0 = baff ? ((bid & 7) * S_ + (row0_ / (nblk * 8)) * 512 + ((bid >> 3) * 4 + w) * 2) : row0_;
        f32x4 v[2][4]; float ss[2] = {0.f, 0.f};
        u32x2 ya[2][4], yc[2][4];
#pragma unroll
        for (int r = 0; r < 2; ++r)
#pragma unroll
            for (int i = 0; i < 4; ++i) {
                const int c = i * 256 + lane * 4; const long row = row0 + r;
                v[r][i] = *(const f32x4*)(hb + row * D_ + c);
                ya[r][i] = *(const u32x2*)(yb + (row * 2) * D_ + c); yc[r][i] = *(const u32x2*)(yb + (row * 2 + 1) * D_ + c);
            }
#pragma unroll
        for (int r = 0; r < 2; ++r) {
#pragma unroll
            for (int i = 0; i < 4; ++i) {
                const u32x2 a = ya[r][i], b2 = yc[r][i];
                v[r][i][0] += __uint_as_float(a.x << 16) + __uint_as_float(b2.x << 16);
                v[r][i][1] += __uint_as_float(a.x & 0xffff0000u) + __uint_as_float(b2.x & 0xffff0000u);
                v[r][i][2] += __uint_as_float(a.y << 16) + __uint_as_float(b2.y << 16);
                v[r][i][3] += __uint_as_float(a.y & 0xffff0000u) + __uint_as_float(b2.y & 0xffff0000u);
                ss[r] += v[r][i][0] * v[r][i][0] + v[r][i][1] * v[r][i][1] + v[r][i][2] * v[r][i][2] + v[r][i][3] * v[r][i][3];
            }
            for (int o_ = 32; o_ > 0; o_ >>= 1) ss[r] += __shfl_xor(ss[r], o_);
        }
#pragma unroll
        for (int r = 0; r < 2; ++r) {
            const float rs = rsqrtf(ss[r] / (float)D_ + 1e-6f); const long row = row0 + r;
#pragma unroll
            for (int i = 0; i < 4; ++i) {
                const int c = i * 256 + lane * 4;
                if (lnext < 2) {
                    const f32x4 g = *(const f32x4*)(p.attn_norm + lnext * D_ + c);
                    *(f32x4*)(hb + row * D_ + c) = v[r][i];
                    st4(hnb + hn_panel_off(row, c), v[r][i][0] * rs * g[0], v[r][i][1] * rs * g[1], v[r][i][2] * rs * g[2], v[r][i][3] * rs * g[3]);
                } else {
                    const f32x4 g = *(const f32x4*)(p.final_norm + c);
                    f32x4 ov = {v[r][i][0] * rs * g[0], v[r][i][1] * rs * g[1], v[r][i][2] * rs * g[2], v[r][i][3] * rs * g[3]};
                    *(f32x4*)(p.out + row * D_ + c) = ov;
                }
            }
        }
    }
}

__device__ __forceinline__ const Params& opq(const Params& p) { return p; }
__device__ __forceinline__ int next_item(unsigned* ctr, int* slot) {
    __syncthreads();
    if (otid() == 0) *slot = (int)atomicAdd(ctr, 1u);
    __syncthreads();
    return *slot;
}
__device__ __forceinline__ void phase_x1(const Params& p, int l, char* lds, unsigned* ctr, int bid) {
    int* slot = (int*)(lds + LDS_AUX + 1000);
    const int b = bid & 7;
    constexpr int N_CP = 8, N_IDX = 76, N_WIN = 64, N_SWA = 64, N_KVC = 64, N_CS = 1;
    constexpr int E0 = N_CP, E1 = E0 + N_IDX, E2 = E1 + N_WIN, E3 = E2 + N_SWA, E4 = E3 + N_KVC, E5 = E4 + N_CS;
    for (int first = 1;; first = 0) {
        const int it = first ? (bid >> 3) : next_item(ctr + b, slot);
        if (it >= E5) break;
        if (it < E0) phase_compress(p, l, 0, 1, lds, ((b * 4 + (it >> 1)) << 1) | (it & 1));
        else if (it < E1) {
            const int j = it - E0; int qt, pc, np;
            if (j < 32) { qt = 31 - (j >> 2); pc = j & 3; np = 4; }
            else if (j < 56) { qt = 23 - (j - 32) / 3; pc = (j - 32) % 3; np = 3; }
            else if (j < 72) { qt = 15 - ((j - 56) >> 1); pc = (j - 56) & 1; np = 2; }
            else { qt = 7 - (j - 72); pc = 0; np = 1; }
            idx_unit(p, b, qt, ((qt + 1) * pc) / np, ((qt + 1) * (pc + 1)) / np, lds);
        }
        else if (it < E2) unit_win(p, (b << 6) | (63 - (it - E1)), lds);
        else if (it < E3) unit_swa(p, l, (b << 6) | (it - E2), lds);
        else if (it < E4) phase_kvc(p, l, 0, 1, lds, b * 64 + (it - E3));
        else phase_cumsum(p, 0, 1, b);
    }
}
__device__ __forceinline__ void phase_x2(const Params& p, char* lds, unsigned* ctr, int bid) {
    int* slot = (int*)(lds + LDS_AUX + 1000);
    const int b = bid & 7;
    constexpr int N_FOX = 4 * 16, N_CMP = 64, N_DS = 64;
    for (int first = 1;; first = 0) {
        const int it = first ? (bid >> 3) : next_item(ctr + b, slot);
        if (it >= N_FOX + N_CMP + N_DS) break;
        if (it < N_FOX) { const int qb = 15 - (it >> 2), h = it & 3; unit_fox(p, ((b * 4 + h) << 4) | qb, lds); }
        else if (it < N_FOX + N_DS) phase_dsel(p, 0, 1, lds, ((it - N_FOX) << 3) | b);
        else phase_cmp(p, 0, 1, lds, (b << 6) | (it - N_FOX - N_DS));
    }
}
__device__ __forceinline__ void phase_x3(const Params& p, char* lds, unsigned* ctr, int bid) {
    int* slot = (int*)(lds + LDS_AUX + 1000);
    const int b = bid & 7;
    for (int first = 1;; first = 0) {
        const int it = first ? (bid >> 3) : next_item(ctr + b, slot);
        if (it >= 16 * 8) break;
        const int g = it >> 3, j = it & 7;
        if (j < 4) unit_dsa(p, ((b * 4 + j) << 4) | (15 - g), lds);
        else unit_sel(p, (b << 6) | (63 - (g * 4 + (j - 4))), lds);
    }
}
#if DIAG_K >= 0
#define TS(i) do { if (blockIdx.x == 0 && threadIdx.x == 0) tsv[i] = __builtin_amdgcn_s_memrealtime(); } while (0)
#else
#define TS(i) do {} while (0)
#endif
__global__ __launch_bounds__(256, 2) void k_mega(Params pk) {
    __shared__ __attribute__((aligned(16))) char lds[LDS_AUX + 6144];
    __shared__ uint4 xbw;
    __shared__ Params sp;
    if (threadIdx.x == 0) sp = pk;
    const Params& p = sp;
#if DIAG_K >= 0
    __shared__ unsigned long long tsv[32];
#endif
    cg::grid_group grid = cg::this_grid();
    const int bid = blockIdx.x, nblk = gridDim.x;
    if (threadIdx.x == 0) xbw = make_uint4(0u, 0u, 0u, 0u);
    __syncthreads();
    (void)xcd_barrier_post((unsigned*)(pk.ws + OFF_bar), (volatile LAS unsigned*)&xbw);
    auto rot = [&](int off) { return osgpr((bid + off) % nblk); };
    TS(0);
    phase_prep(opq(p), osgpr(bid), nblk, lds, 7);
    phase_norm(opq(p), 0, osgpr(bid), nblk);
    if (pk.ws == nullptr) grid.sync();
    xcd_barrier2(p.ws + OFF_bar, (volatile LAS unsigned*)&xbw);
    TS(1);
    if (bid >= nblk - 4) {
        const int o_ = (bid - (nblk - 4)) * 256 + (int)threadIdx.x;
        const float* pp = p.pebp() + (long)(o_ >> 8) * 32 * 256 + (o_ & 255);
        float a = 0.f;
#pragma unroll
        for (int kt = 0; kt < 32; ++kt) a += pp[kt * 256];
        p.peb()[o_] = a;
    }
    for (int l = 0; l < 2; ++l) {
        phase_inproj(opq(p), l, osgpr(bid), nblk, lds);
        xcd_barrier2(p.ws + OFF_bar, (volatile LAS unsigned*)&xbw);
        TS(2 + 10 * l);
        unsigned* ctrs = (unsigned*)(p.ws + OFF_bar) + 3600 + l * 32;
        phase_x1(p, l, lds, ctrs + 0, bid);
        xcd_barrier2(p.ws + OFF_bar, (volatile LAS unsigned*)&xbw);
        TS(3 + 10 * l);
        phase_x2(p, lds, ctrs + 8, bid);
        xcd_barrier2(p.ws + OFF_bar, (volatile LAS unsigned*)&xbw);
        TS(4 + 10 * l);
        phase_x3(p, lds, ctrs + 16, bid);
        xcd_barrier2(p.ws + OFF_bar, (volatile LAS unsigned*)&xbw);
        TS(5 + 10 * l);
        phase_merge(opq(p), l, osgpr(bid), nblk, lds);
        xcd_barrier2(p.ws + OFF_bar, (volatile LAS unsigned*)&xbw);
        TS(6 + 10 * l);
        phase_outproj(opq(p), l, osgpr(bid), nblk, lds);
        xcd_barrier2(p.ws + OFF_bar, (volatile LAS unsigned*)&xbw);
        TS(7 + 10 * l);
        phase_router(opq(p), l, osgpr(bid), nblk, lds);
        xcd_barrier2(p.ws + OFF_bar, (volatile LAS unsigned*)&xbw);
        TS(8 + 10 * l);
        phase_moe_up(opq(p), l, osgpr(bid), nblk, lds);
        xcd_barrier2(p.ws + OFF_bar, (volatile LAS unsigned*)&xbw);
        TS(9 + 10 * l);
        phase_moe_down(opq(p), l, osgpr(bid), nblk, lds);
#ifdef SHADOW_VAR
        if (l == 1) {
            xcd_barrier2(p.ws + OFF_bar, (volatile LAS unsigned*)&xbw);
            TS(21);
            phase_inproj<SHADOW_VAR>(opq(p), 1, osgpr(bid), nblk, lds);
            xcd_barrier2(p.ws + OFF_bar, (volatile LAS unsigned*)&xbw);
            TS(22);
        }
#endif
#if DIAG_K >= 0
        if (l == 1 && blockIdx.x == 0 && threadIdx.x == 0) {
            tsv[20] = __builtin_amdgcn_s_memrealtime();
            const float tot = (float)(tsv[20] - tsv[0]);
#ifdef SHADOW_VAR
            const float f = (float)(tsv[DIAG_K + 1] - tsv[DIAG_K]) / 100000.f;
#else
            const float f = (float)(tsv[DIAG_K + 1] - tsv[DIAG_K]) / tot;
#endif
            *(float*)(p.ws + OFF_bar + 3500 * 4) = f;
        }
#endif
        xcd_barrier2(p.ws + OFF_bar, (volatile LAS unsigned*)&xbw);
        TS(10 + 10 * l);
        phase_combine(opq(p), l + 1, osgpr(bid), nblk);
        if (l == 0) { xcd_barrier2(p.ws + OFF_bar, (volatile LAS unsigned*)&xbw); TS(11); }
    }
}

extern "C" void kernel_launch(void* const* d_in, const int* in_sizes, int n_in, void* d_out, int out_size, void* d_ws, size_t ws_size,
                              hipStream_t stream) {
    Params p{};
    p.x = (const float*)d_in[0]; p.positions = (const int*)d_in[1]; p.attn_norm = (const float*)d_in[2]; p.w_in = (const float*)d_in[3];
    p.nsa_pe_k = (const float*)d_in[4]; p.nsa_w1_k = (const float*)d_in[5]; p.nsa_w2_k = (const float*)d_in[6];
    p.nsa_pe_v = (const float*)d_in[7]; p.nsa_w1_v = (const float*)d_in[8]; p.nsa_w2_v = (const float*)d_in[9];
    p.fox_bias = (const float*)d_in[10]; p.dsa_kv_norm = (const float*)d_in[11]; p.dsa_w_ukv = (const float*)d_in[12]; p.swa_sinks = (const float*)d_in[13];
    p.w_branch = (const float*)d_in[14]; p.w_gate = (const float*)d_in[15]; p.w_out = (const float*)d_in[16]; p.ffn_norm = (const float*)d_in[17];
    p.moe_w_group = (const float*)d_in[18]; p.moe_b_group = (const float*)d_in[19]; p.moe_w_expert = (const float*)d_in[20]; p.moe_b_expert = (const float*)d_in[21];
    p.moe_w_gate = (const float*)d_in[22]; p.moe_w_up = (const float*)d_in[23]; p.moe_w_down = (const float*)d_in[24]; p.final_norm = (const float*)d_in[25];
    p.out = (float*)d_out;

    p.ws = (char*)d_ws;

    hipMemsetAsync(p.ws + OFF_bar, 0, XCD_BAR_WORDS * 4, stream);
    static int grid_blocks = 0;
    if (!grid_blocks) {
        int dev = 0, cus = 0, per_cu = 0;
        hipGetDevice(&dev);
        hipDeviceGetAttribute(&cus, hipDeviceAttributeMultiprocessorCount, dev);
        hipOccupancyMaxActiveBlocksPerMultiprocessor(&per_cu, k_mega, 256, 0);
        if (per_cu > 2) per_cu = 2;
        if (per_cu < 1) per_cu = 1;
        grid_blocks = cus * per_cu;
    }
    void* args[] = {(void*)&p};
    hipLaunchCooperativeKernel((void*)k_mega, dim3(grid_blocks), dim3(256), args, 0, stream);
}
```
